# Optimizing an MI355X kernel written in HIP

```python
import math
import jax, jax.numpy as jnp
from jax import lax
import numpy as np

D_MODEL = 1024
BATCH = 8
SEQ = 4096
DEPTH = 2

HEAD_DIM = 64
FOX_HEADS = 8
FOX_WIDTH = FOX_HEADS * HEAD_DIM
MLA_HEADS = 4
MLA_NOPE = 128
MLA_ROPE = 64
MLA_QK = MLA_NOPE + MLA_ROPE
MLA_V = 128
MLA_Q_RANK = 256
MLA_KV_RANK = 128
MLA_WIDTH = MLA_HEADS * MLA_V
MOBA_HEADS = 8
MOBA_WIDTH = MOBA_HEADS * HEAD_DIM
MOBA_BLOCK = 256
MOBA_TOPK = 3
MOBA_Q_CHUNK = 32
D_MIX = FOX_WIDTH + MLA_WIDTH + MOBA_WIDTH
Q_BLOCK = 128
ROPE_THETA = 10000.0
EPS = 1e-6
IN_SIZES = (FOX_WIDTH, FOX_WIDTH, FOX_WIDTH, FOX_HEADS, FOX_WIDTH,
            MLA_Q_RANK, MLA_KV_RANK, MLA_ROPE, MLA_WIDTH,
            MOBA_WIDTH, MOBA_WIDTH, MOBA_WIDTH, MOBA_WIDTH)
D_IN = sum(IN_SIZES)

kernel_name = "hybrid_fox_mla_moba_parallel_heads"


def rmsnorm(x, g):
    xf = x.astype(jnp.float32)
    y = xf * lax.rsqrt(jnp.mean(xf * xf, axis=-1, keepdims=True) + EPS)
    return (y * g.astype(jnp.float32)).astype(x.dtype)


def rope_tables(S):
    inv = ROPE_THETA ** (-jnp.arange(0, MLA_ROPE, 2, dtype=jnp.float32) / MLA_ROPE)
    ang = jnp.arange(S, dtype=jnp.float32)[:, None] * inv[None, :]
    ang = jnp.concatenate([ang, ang], axis=-1)
    return jnp.cos(ang), jnp.sin(ang)


def apply_rope(x, cos, sin):
    x1, x2 = jnp.split(x, 2, axis=-1)
    rot = jnp.concatenate([-x2, x1], axis=-1)
    return (x * cos + rot * sin).astype(x.dtype)


def causal_block_sweep(qh, kh, vh, decay=None):
    B, H, S, Dk = qh.shape
    scale = Dk ** -0.5
    kpos = jnp.arange(S)

    def one_block(i):
        start = i * Q_BLOCK
        qb = lax.dynamic_slice_in_dim(qh, start, Q_BLOCK, axis=2)
        s = jnp.einsum('bhqd,bhkd->bhqk', qb, kh, preferred_element_type=jnp.float32) * scale
        if decay is not None:
            db = lax.dynamic_slice_in_dim(decay, start, Q_BLOCK, axis=2)
            s = s + (db[..., :, None] - decay[..., None, :])
        qpos = start + jnp.arange(Q_BLOCK)
        s = jnp.where(qpos[:, None] >= kpos[None, :], s, -jnp.inf)
        p = jax.nn.softmax(s, axis=-1)
        return jnp.einsum('bhqk,bhkd->bhqd', p.astype(vh.dtype), vh)

    out = lax.map(one_block, jnp.arange(S // Q_BLOCK))
    Dv = out.shape[-1]
    return out.transpose(1, 0, 3, 2, 4).reshape(B, S, H * Dv)


def fox_attention(q, k, v, f_logit, b_f):
    B, S, _ = q.shape
    shp = (B, S, FOX_HEADS, HEAD_DIM)
    qh = q.reshape(shp).transpose(0, 2, 1, 3)
    kh = k.reshape(shp).transpose(0, 2, 1, 3)
    vh = v.reshape(shp).transpose(0, 2, 1, 3)
    log_f = jax.nn.log_sigmoid((f_logit + b_f).astype(jnp.float32))
    c = jnp.cumsum(log_f, axis=1).transpose(0, 2, 1)
    return causal_block_sweep(qh, kh, vh, decay=c)


def mla_attention(cq, ckv, kr, g_q, w_uq, g_kv, w_ukv, cos, sin):
    B, S, _ = cq.shape
    q = (rmsnorm(cq, g_q) @ w_uq).reshape(B, S, MLA_HEADS, MLA_QK)
    q_nope, q_rope = q[..., :MLA_NOPE], q[..., MLA_NOPE:]
    q = jnp.concatenate([q_nope, apply_rope(q_rope, cos[:, None, :], sin[:, None, :])], axis=-1)
    kv = (rmsnorm(ckv, g_kv) @ w_ukv).reshape(B, S, MLA_HEADS, MLA_NOPE + MLA_V)
    k_nope, v = kv[..., :MLA_NOPE], kv[..., MLA_NOPE:]
    k_rope = apply_rope(kr, cos, sin)
    k = jnp.concatenate([k_nope, jnp.broadcast_to(k_rope[:, :, None, :], (B, S, MLA_HEADS, MLA_ROPE)).astype(k_nope.dtype)], axis=-1)
    return causal_block_sweep(q.transpose(0, 2, 1, 3), k.transpose(0, 2, 1, 3), v.transpose(0, 2, 1, 3))


def moba_attention(q, k, v, slopes):
    B, S, _ = q.shape
    H, D, BLK = MOBA_HEADS, HEAD_DIM, MOBA_BLOCK
    shp = (B, S, H, D)
    qh = q.reshape(shp).transpose(0, 2, 1, 3)
    kh = k.reshape(shp).transpose(0, 2, 1, 3)
    vh = v.reshape(shp).transpose(0, 2, 1, 3)
    nb = -(-S // BLK)
    pad = nb * BLK - S
    kb = jnp.pad(kh, ((0, 0), (0, 0), (0, pad), (0, 0))).reshape(B, H, nb, BLK, D)
    vb = jnp.pad(vh, ((0, 0), (0, 0), (0, pad), (0, 0))).reshape(B, H, nb, BLK, D)
    kmean = jnp.mean(kb.astype(jnp.float32), axis=3)
    topk = min(MOBA_TOPK, nb)
    scale = D ** -0.5
    key_off = jnp.arange(BLK)
    bi = jnp.arange(B)[:, None, None, None]
    hi = jnp.arange(H)[None, :, None, None]
    m = slopes.astype(jnp.float32)

    def one_chunk(i):
        start = i * MOBA_Q_CHUNK
        qc = lax.dynamic_slice_in_dim(qh, start, MOBA_Q_CHUNK, axis=2)
        qpos = start + jnp.arange(MOBA_Q_CHUNK)
        cur = start // BLK
        gate = jnp.einsum('bhqd,bhnd->bhqn', qc.astype(jnp.float32), kmean)
        gate = jnp.where(jnp.arange(nb) < cur, gate, -jnp.inf)
        _, sel = lax.top_k(gate, topk)
        valid = sel < cur
        ks = kb[bi, hi, sel]
        vs = vb[bi, hi, sel]
        s_sel = jnp.einsum('bhqd,bhqnkd->bhqnk', qc, ks, preferred_element_type=jnp.float32) * scale
        kpos_sel = sel[..., None] * BLK + key_off
        dist_sel = (qpos[None, None, :, None, None] - kpos_sel).astype(jnp.float32)
        s_sel = s_sel - m[None, :, None, None, None] * dist_sel
        s_sel = jnp.where(valid[..., None], s_sel, -jnp.inf).reshape(B, H, MOBA_Q_CHUNK, topk * BLK)
        ko = lax.dynamic_index_in_dim(kb, cur, axis=2, keepdims=False)
        vo = lax.dynamic_index_in_dim(vb, cur, axis=2, keepdims=False)
        kpos_own = cur * BLK + key_off
        dist_own = (qpos[:, None] - kpos_own[None, :]).astype(jnp.float32)
        s_own = jnp.einsum('bhqd,bhkd->bhqk', qc, ko, preferred_element_type=jnp.float32) * scale
        s_own = s_own - m[None, :, None, None] * dist_own
        s_own = jnp.where(dist_own >= 0, s_own, -jnp.inf)
        p = jax.nn.softmax(jnp.concatenate([s_sel, s_own], axis=-1), axis=-1)
        p_sel = p[..., :topk * BLK].reshape(B, H, MOBA_Q_CHUNK, topk, BLK).astype(vs.dtype)
        p_own = p[..., topk * BLK:].astype(vo.dtype)
        return (jnp.einsum('bhqnk,bhqnkd->bhqd', p_sel, vs)
                + jnp.einsum('bhqk,bhkd->bhqd', p_own, vo))

    out = lax.map(one_chunk, jnp.arange(S // MOBA_Q_CHUNK))
    return out.transpose(1, 0, 3, 2, 4).reshape(B, S, H * D)


def hybrid_layer(x, ln_g, w_in, b_f, g_q, w_uq, g_kv, w_ukv, out_g, w_out, cos, sin, slopes):
    h = rmsnorm(x, ln_g)
    proj = h @ w_in
    cuts, acc = [], 0
    for sz in IN_SIZES[:-1]:
        acc += sz
        cuts.append(acc)
    (fq, fk, fv, ff, fz, cq, ckv, kr, mz, bq, bk, bv, bz) = jnp.split(proj, cuts, axis=-1)
    y_a = fox_attention(fq, fk, fv, ff, b_f)
    y_b = mla_attention(cq, ckv, kr, g_q, w_uq, g_kv, w_ukv, cos, sin)
    y_c = moba_attention(bq, bk, bv, slopes)
    g_a, g_b, g_c = jnp.split(out_g, [FOX_WIDTH, FOX_WIDTH + MLA_WIDTH])
    y = jnp.concatenate([rmsnorm(y_a, g_a) * jax.nn.silu(fz),
                         rmsnorm(y_b, g_b) * jax.nn.silu(mz),
                         rmsnorm(y_c, g_c) * jax.nn.silu(bz)], axis=-1)
    return x + y @ w_out


def setup_inputs(seed: int = 0) -> dict:
    key = jax.random.key(seed)
    ks = jax.random.split(key, 12)
    f32 = jnp.float32
    nrm = lambda k, shp: jax.random.normal(k, shp, dtype=f32)
    return {
        "x": nrm(ks[0], (BATCH, SEQ, D_MODEL)),
        "ln_g": 1.0 + 0.02 * nrm(ks[1], (DEPTH, D_MODEL)),
        "w_in": nrm(ks[2], (DEPTH, D_MODEL, D_IN)) * D_MODEL ** -0.5,
        "fox_b_f": 2.0 + 0.5 * nrm(ks[3], (DEPTH, FOX_HEADS)),
        "mla_q_g": 1.0 + 0.02 * nrm(ks[4], (DEPTH, MLA_Q_RANK)),
        "mla_w_uq": nrm(ks[5], (DEPTH, MLA_Q_RANK, MLA_HEADS * MLA_QK)) * MLA_Q_RANK ** -0.5,
        "mla_kv_g": 1.0 + 0.02 * nrm(ks[6], (DEPTH, MLA_KV_RANK)),
        "mla_w_ukv": nrm(ks[7], (DEPTH, MLA_KV_RANK, MLA_HEADS * (MLA_NOPE + MLA_V))) * MLA_KV_RANK ** -0.5,
        "out_g": 1.0 + 0.02 * nrm(ks[8], (DEPTH, D_MIX)),
        "w_out": nrm(ks[9], (DEPTH, D_MIX, D_MODEL)) * D_MIX ** -0.5,
        "final_g": 1.0 + 0.02 * nrm(ks[10], (D_MODEL,)),
    }


def reference(x, ln_g, w_in, fox_b_f, mla_q_g, mla_w_uq, mla_kv_g, mla_w_ukv, out_g, w_out, final_g):
    S = x.shape[1]
    cos, sin = rope_tables(S)
    slopes = 2.0 ** (-8.0 * jnp.arange(1, MOBA_HEADS + 1, dtype=jnp.float32) / MOBA_HEADS)
    for l in range(DEPTH):
        x = hybrid_layer(x, ln_g[l], w_in[l], fox_b_f[l], mla_q_g[l], mla_w_uq[l],
                         mla_kv_g[l], mla_w_ukv[l], out_g[l], w_out[l], cos, sin, slopes)
    return rmsnorm(x, final_g)
```

```cpp
#include <hip/hip_runtime.h>
#include <hip/hip_cooperative_groups.h>
#include <cstdio>
#include <cstdint>
#include <cmath>
namespace cg = cooperative_groups;

#define LAS __attribute__((address_space(3)))
typedef unsigned short bf16_t;
typedef short bf16x8 __attribute__((ext_vector_type(8)));
typedef short s16x4 __attribute__((ext_vector_type(4)));
typedef float f32x4 __attribute__((ext_vector_type(4)));
typedef float f32x2 __attribute__((ext_vector_type(2)));
typedef float f32x16 __attribute__((ext_vector_type(16)));
typedef unsigned u32x4 __attribute__((ext_vector_type(4)));
typedef unsigned u32x2 __attribute__((ext_vector_type(2)));

constexpr int BATCH = 8, SEQ = 4096, T = BATCH * SEQ, DM = 1024, DEPTH = 2;
constexpr int D_IN = 5064, NIN = 5120, DMIX = 1536;
constexpr float EPS = 1e-6f, LOG2E = 1.4426950408889634f;
constexpr float C2_64 = 0.125f * LOG2E;
constexpr float C2_192 = 0.07216878364870323f * LOG2E;
constexpr int NWAVES = 8, NTHREADS = 512;

constexpr size_t MiB = 1u << 20;
constexpr size_t WS_CTL = 0, CTL_ZERO_BYTES = 1 * MiB;
constexpr size_t WS_SSX = 1 * MiB;
constexpr size_t WS_KRF = 3 * MiB;
constexpr size_t WS_FFL = 11 * MiB;
constexpr size_t WS_RSCQ = 12 * MiB;
constexpr size_t WS_RSCKV = 12 * MiB + 256 * 1024;
constexpr size_t WS_RSX = 12 * MiB + 512 * 1024;
constexpr size_t WS_KPART = 13 * MiB;
constexpr size_t WS_BIASF = 14 * MiB;
constexpr size_t WS_SEL = 15 * MiB;
constexpr size_t WS_SSQA = 16 * MiB;
constexpr size_t WS_SSQB = 17 * MiB;
constexpr size_t WS_SSQC = 18 * MiB;
constexpr size_t WS_ROPE = 19 * MiB;
constexpr size_t WS_W = 24 * MiB, W_LAYER = 14 * MiB;
constexpr size_t W_IN_OFF = 0, W_UQ_OFF = 10 * MiB, W_UKV_OFF = 10 * MiB + 512 * 1024, W_OUT_OFF = 11 * MiB;
constexpr size_t WS_QG = 56 * MiB;
constexpr size_t WS_GATE = 152 * MiB;
constexpr size_t WS_FK = 248 * MiB, WS_FV = 280 * MiB, WS_BK = 312 * MiB, WS_BV = 344 * MiB;
constexpr size_t WS_R2 = 376 * MiB;
constexpr size_t WS_XB = WS_R2, WS_QM = WS_R2, WS_KM = WS_R2 + 48 * MiB, WS_VM = WS_R2 + 96 * MiB;
constexpr size_t WS_END = 504 * MiB;
constexpr int CW_QCTR = 64;

constexpr int RING_BYTES = 131072, MISC_OFF = RING_BYTES + 256, SIDE_OFF = RING_BYTES + 1024  , LDS_BYTES = 147456;

__device__ __forceinline__ unsigned cvt_pk_bf16(float lo, float hi) { unsigned r; asm volatile("v_cvt_pk_bf16_f32 %0, %1, %2" : "=v"(r) : "v"(lo), "v"(hi)); return r; }
__device__ __forceinline__ float bf2f(unsigned short b) { return __uint_as_float(((unsigned)b) << 16); }
__device__ __forceinline__ void store8_bf16(bf16_t* p, f32x4 a, f32x4 b) {
    u32x4 w; w.x = cvt_pk_bf16(a[0], a[1]); w.y = cvt_pk_bf16(a[2], a[3]); w.z = cvt_pk_bf16(b[0], b[1]); w.w = cvt_pk_bf16(b[2], b[3]); *(u32x4*)p = w; }
__device__ __forceinline__ float silu_f(float v) { return v * __builtin_amdgcn_rcpf(1.0f + __builtin_amdgcn_exp2f(-v * LOG2E)); }
__device__ __forceinline__ f32x4 silu4(f32x4 v) { f32x4 o; o[0] = silu_f(v[0]); o[1] = silu_f(v[1]); o[2] = silu_f(v[2]); o[3] = silu_f(v[3]); return o; }
__device__ __forceinline__ float wave_sum(float v) {
#pragma unroll
    for (int o = 1; o < 64; o <<= 1) v += __shfl_xor(v, o);
    return v;
}
__device__ __forceinline__ float sum4(f32x4 a) { return (a[0] + a[1]) + (a[2] + a[3]); }
__device__ __forceinline__ float dot4(f32x4 a) { return (a[0] * a[0] + a[1] * a[1]) + (a[2] * a[2] + a[3] * a[3]); }

namespace pg8 {
constexpr int BM = 256, BK = 64, HALF = 128, HTB = HALF * BK * 2, STAGE_BYTES = 8 * HTB, NXCD = 8, WGM = 8;
__host__ __device__ __forceinline__ int lds_byte(int r, int c) { const int st = (r >> 4) * 2 + (c >> 5), rr = r & 15, cc = c & 31, ob = rr * 64 + cc * 2; return st * 1024 + (ob ^ (((ob >> 9) & 1) << 5)); }
__host__ __device__ __forceinline__ void stage_rc(int b, int& R, int& C) { const int st = b / 1024, sb = b % 1024, swz = sb ^ (((sb >> 9) & 1) << 5); R = (st >> 1) * 16 + swz / 64; C = (st & 1) * 32 + (swz % 64) / 2; }
__host__ __device__ __forceinline__ int perm32(int rho) { const int n = rho >> 4, i = rho & 15; return 8 * (i >> 2) + 4 * n + (i & 3); }

struct Unit { int pm, pn; };
struct Gemm { const bf16_t* A; const bf16_t* Bt; int M, N, K, lda; };

struct StaticOrder {
    int nM, nN, nwg, G, c;
    __host__ __device__ void init(int M, int N, int G_, int c_) { nM = M / BM; nN = N / BM; nwg = nM * nN; G = G_; c = c_; }
    __host__ __device__ bool next(int i, Unit& u) const {
        const long L = (long)i * G + c; if (L >= nwg) return false;
        int wgid = (int)L; { const int q = nwg / NXCD, r = nwg % NXCD, xcd = wgid % NXCD, off = wgid / NXCD; wgid = (xcd < r ? xcd * (q + 1) : r * (q + 1) + (xcd - r) * q) + off; }
        const int nig = WGM * nN, gid = wgid / nig, fm = gid * WGM, gsz = (nM - fm) < WGM ? (nM - fm) : WGM;
        u.pm = fm + ((wgid % nig) % gsz); u.pn = (wgid % nig) / gsz; return true;
    }
};

template <class Epi, bool ALIGN_EPI>
__device__ __forceinline__ void gemm_phase(LAS unsigned char* lds, const Gemm g, const StaticOrder& S, const Epi& E) {
    int tid_ = threadIdx.x; asm volatile("" : "+v"(tid_));
    const int tid = tid_, wid = __builtin_amdgcn_readfirstlane(tid >> 6), lane = tid & 63, wr = wid >> 2, wc = wid & 3, fr = lane & 15, fq = lane >> 4;
    const int K = g.K, nt = K / BK, lda = g.lda;
    unsigned voffA[2], voffB[2];
#pragma unroll
    for (int i = 0; i < 2; ++i) { int R, C; stage_rc(tid * 16 + i * 8192, R, C); const int Rb = Epi::PERM ? ((R & ~31) + perm32(R & 31)) : R;
        voffA[i] = (unsigned)(R * lda + C) * 2u; voffB[i] = (unsigned)(Rb * K + C) * 2u; }
    const size_t kstep = (size_t)(BK * 2);
    const size_t hstepA = (size_t)HALF * lda * 2, hstepB = (size_t)HALF * K * 2;
    const size_t tstepA = 2 * hstepA, tstepB = 2 * hstepB;
    const unsigned ldsw = (unsigned)wid * 1024u;
    const int aoff = lds_byte(wr * 64 + fr, fq * 8), boff = lds_byte(wc * 32 + fr, fq * 8);
#define PG8_SA(b, h) (((b) * 2 + (h)) * HTB)
#define PG8_SB(b, h) ((4 + (b) * 2 + (h)) * HTB)
#define PG8_STAGE(bufoff, gbase, voff) do { _Pragma("unroll") for (int _i = 0; _i < 2; ++_i) \
        __builtin_amdgcn_global_load_lds((const unsigned*)((const char*)(gbase) + (voff)[_i]), (LAS unsigned*)(lds + (bufoff) + ldsw + _i * 8192), 16, 0, 0); } while (0)
#define PG8_LDA(dst, b, h) do { _Pragma("unroll") for (int m = 0; m < 4; ++m) _Pragma("unroll") for (int k = 0; k < 2; ++k) dst[m][k] = *(const LAS bf16x8*)(lds + PG8_SA(b, h) + aoff + m * 2048 + k * 1024); } while (0)
#define PG8_LDB(dst, b, h) do { _Pragma("unroll") for (int n = 0; n < 2; ++n) _Pragma("unroll") for (int k = 0; k < 2; ++k) dst[n][k] = *(const LAS bf16x8*)(lds + PG8_SB(b, h) + boff + n * 2048 + k * 1024); } while (0)
#define PG8_MMA(ai, bj, At, Bt) do { __builtin_amdgcn_s_setprio(1); _Pragma("unroll") for (int m = 0; m < 4; ++m) _Pragma("unroll") for (int n = 0; n < 2; ++n) _Pragma("unroll") for (int k = 0; k < 2; ++k) \
        acc[ai][bj][m][n] = __builtin_amdgcn_mfma_f32_16x16x32_bf16(Bt[n][k], At[m][k], acc[ai][bj][m][n], 0, 0, 0); __builtin_amdgcn_s_setprio(0); } while (0)
#define PG8_WAIT_V(n) asm volatile("s_waitcnt vmcnt(" #n ")" ::: "memory")
#define PG8_WAIT_L(n) asm volatile("s_waitcnt lgkmcnt(" #n ")" ::: "memory")
#define PG8_BAR __builtin_amdgcn_s_barrier()
#define PG8_SCHED __builtin_amdgcn_sched_barrier(0)
    Unit cur, nxt; int ui = 0;
    if (!S.next(0, cur)) return;
    f32x4 acc[2][2][4][2];
#pragma unroll
    for (int a = 0; a < 2; ++a)
#pragma unroll
        for (int b = 0; b < 2; ++b)
#pragma unroll
            for (int m = 0; m < 4; ++m)
#pragma unroll
                for (int n = 0; n < 2; ++n) acc[a][b][m][n] = (f32x4){0.f, 0.f, 0.f, 0.f};
    bf16x8 At[4][2], B0[2][2], B1[2][2];
    const char* cA = (const char*)g.A + (size_t)cur.pm * tstepA; const char* cB = (const char*)g.Bt + (size_t)cur.pn * tstepB;
    PG8_STAGE(PG8_SB(0, 0), cB, voffB); PG8_STAGE(PG8_SB(0, 1), cB + hstepB, voffB); PG8_STAGE(PG8_SA(0, 0), cA, voffA); PG8_STAGE(PG8_SA(0, 1), cA + hstepA, voffA);
    if (wr == 1) PG8_BAR;
    PG8_WAIT_V(2); PG8_BAR;
    PG8_STAGE(PG8_SB(1, 0), cB + kstep, voffB); PG8_STAGE(PG8_SA(1, 0), cA + kstep, voffA); PG8_STAGE(PG8_SB(1, 1), cB + hstepB + kstep, voffB);
    PG8_WAIT_V(6); PG8_BAR;
    for (;;) {
        const bool has_next = S.next(ui + 1, nxt);
        const char* nA = has_next ? (const char*)g.A + (size_t)nxt.pm * tstepA : cA; const char* nB = has_next ? (const char*)g.Bt + (size_t)nxt.pn * tstepB : cB;
#pragma unroll 1
        for (int t = 0; t < nt; t += 2) {
            const bool last = (t == nt - 2);
            const char* a1 = cA + (size_t)(t + 1) * kstep;
            const char* a2 = last ? nA : cA + (size_t)(t + 2) * kstep; const char* b2 = last ? nB : cB + (size_t)(t + 2) * kstep;
            const char* a3 = a2 + kstep; const char* b3 = b2 + kstep;
            PG8_LDB(B0, 0, 0); PG8_LDB(B1, 0, 1); PG8_SCHED; PG8_LDA(At, 0, 0); PG8_STAGE(PG8_SA(1, 1), a1 + hstepA, voffA);
            PG8_WAIT_V(8); PG8_WAIT_L(0); PG8_BAR; PG8_MMA(0, 0, At, B0); PG8_MMA(0, 1, At, B1); PG8_BAR; PG8_SCHED;
            PG8_LDA(At, 0, 1); PG8_STAGE(PG8_SB(0, 0), b2, voffB); PG8_STAGE(PG8_SB(0, 1), b2 + hstepB, voffB); PG8_STAGE(PG8_SA(0, 0), a2, voffA);
            PG8_WAIT_V(8); PG8_WAIT_L(0); PG8_BAR; PG8_MMA(1, 0, At, B0); PG8_MMA(1, 1, At, B1); PG8_BAR; PG8_SCHED;
            PG8_LDB(B0, 1, 0); PG8_LDB(B1, 1, 1); PG8_SCHED; PG8_LDA(At, 1, 0); PG8_STAGE(PG8_SA(0, 1), a2 + hstepA, voffA);
            PG8_WAIT_V(8); PG8_WAIT_L(0); PG8_BAR; PG8_MMA(0, 0, At, B0); PG8_MMA(0, 1, At, B1); PG8_BAR; PG8_SCHED;
            PG8_LDA(At, 1, 1); PG8_STAGE(PG8_SB(1, 0), b3, voffB); PG8_STAGE(PG8_SB(1, 1), b3 + hstepB, voffB); PG8_STAGE(PG8_SA(1, 0), a3, voffA);
            PG8_WAIT_V(8); PG8_WAIT_L(0); PG8_BAR; PG8_MMA(1, 0, At, B0); PG8_MMA(1, 1, At, B1); PG8_BAR; PG8_SCHED;
        }
        if constexpr (ALIGN_EPI) { if (wr == 0) PG8_BAR; }
        E(acc, cur, wr, wc, fr, fq);
        if (!has_next) break;
#pragma unroll
        for (int a = 0; a < 2; ++a)
#pragma unroll
            for (int b = 0; b < 2; ++b)
#pragma unroll
                for (int m = 0; m < 4; ++m)
#pragma unroll
                    for (int n = 0; n < 2; ++n) acc[a][b][m][n] = (f32x4){0.f, 0.f, 0.f, 0.f};
        cur = nxt; cA = nA; cB = nB; ++ui;
        if constexpr (ALIGN_EPI) { if (wr == 1) PG8_BAR; }
    }
    PG8_WAIT_V(0);
    if constexpr (!ALIGN_EPI) { if (wr == 0) PG8_BAR; }
    PG8_BAR;
#undef PG8_SA
#undef PG8_SB
#undef PG8_STAGE
#undef PG8_LDA
#undef PG8_LDB
#undef PG8_MMA
#undef PG8_WAIT_V
#undef PG8_WAIT_L
#undef PG8_BAR
#undef PG8_SCHED
}
}

struct EpiA {
    static constexpr bool PERM = true;
    unsigned char* ws; LAS float* side;
    __device__ __forceinline__ void operator()(const f32x4 (&acc)[2][2][4][2], const pg8::Unit& u, int wr, int wc, int fr, int fq) const {
        const float* RSX = (const float*)(ws + WS_RSX);
        float rs[2][4];
#pragma unroll
        for (int ai = 0; ai < 2; ++ai)
#pragma unroll
            for (int m = 0; m < 4; ++m) rs[ai][m] = RSX[u.pm * 256 + ai * 128 + wr * 64 + m * 16 + fr];
        const int pn = u.pn, cw = wc * 32 + 8 * fq;
        bf16_t* dst; int pitch, coff, mode;
        if (pn < 2)       { dst = (bf16_t*)(ws + WS_QG);   pitch = 1536; coff = pn * 256;               mode = 1; }
        else if (pn < 4)  { dst = (bf16_t*)(ws + WS_FK);   pitch = 512;  coff = (pn - 2) * 256;         mode = 0; }
        else if (pn < 6)  { dst = (bf16_t*)(ws + WS_FV);   pitch = 512;  coff = (pn - 4) * 256;         mode = 0; }
        else if (pn < 8)  { dst = (bf16_t*)(ws + WS_GATE); pitch = 1536; coff = (pn - 6) * 256;         mode = 2; }
        else if (pn == 8) { dst = (bf16_t*)(ws + WS_QG);   pitch = 1536; coff = 512;                    mode = 0; }
        else if (pn == 9) { dst = (bf16_t*)(ws + WS_QG);   pitch = 1536; coff = 768;                    mode = 0; }
        else if (pn < 12) { dst = (bf16_t*)(ws + WS_GATE); pitch = 1536; coff = 512 + (pn - 10) * 256;  mode = 2; }
        else if (pn < 14) { dst = (bf16_t*)(ws + WS_QG);   pitch = 1536; coff = 1024 + (pn - 12) * 256; mode = 1; }
        else if (pn < 16) { dst = (bf16_t*)(ws + WS_BK);   pitch = 512;  coff = (pn - 14) * 256;        mode = 0; }
        else if (pn < 18) { dst = (bf16_t*)(ws + WS_BV);   pitch = 512;  coff = (pn - 16) * 256;        mode = 0; }
        else              { dst = (bf16_t*)(ws + WS_GATE); pitch = 1536; coff = 1024 + (pn - 18) * 256; mode = 2; }
        const float msc = (mode == 1) ? C2_64 : 1.0f;
#pragma unroll
        for (int ai = 0; ai < 2; ++ai)
#pragma unroll
            for (int m = 0; m < 4; ++m) { const int row = u.pm * 256 + ai * 128 + wr * 64 + m * 16 + fr; bf16_t* rowp = dst + (size_t)row * pitch + coff + cw; const float sc = rs[ai][m] * msc;
#pragma unroll
                for (int bj = 0; bj < 2; ++bj) { f32x4 v0 = acc[ai][bj][m][0] * sc, v1 = acc[ai][bj][m][1] * sc;
                    if (mode == 2) { v0 = silu4(v0); v1 = silu4(v1); }
                    store8_bf16(rowp + bj * 128, v0, v1); } }
        if (pn == 8 || pn == 9) {
#pragma unroll
            for (int ai = 0; ai < 2; ++ai)
#pragma unroll
                for (int m = 0; m < 4; ++m) { const int rl = ai * 128 + wr * 64 + m * 16 + fr; const float sc = rs[ai][m];
                    float s = dot4(acc[ai][0][m][0] * sc) + dot4(acc[ai][0][m][1] * sc);
                    if (pn == 8) s += dot4(acc[ai][1][m][0] * sc) + dot4(acc[ai][1][m][1] * sc);
                    s += __shfl_xor(s, 16); s += __shfl_xor(s, 32);
                    if (fq == 0) side[rl * 4 + wc] = s; }
            asm volatile("s_waitcnt lgkmcnt(0)" ::: "memory"); __builtin_amdgcn_s_barrier(); asm volatile("" ::: "memory");
            if (threadIdx.x < 256) { const int rl = threadIdx.x; const f32x4 v = *(const LAS f32x4*)(side + rl * 4);
                float* RS = (float*)(ws + (pn == 8 ? WS_RSCQ : WS_RSCKV)); RS[u.pm * 256 + rl] = rsqrtf(sum4(v) * (pn == 8 ? 1.0f / 256.0f : 1.0f / 128.0f) + EPS); }
        }
        if (pn == 9) {
            float* KRF = (float*)(ws + WS_KRF); float* FFL = (float*)(ws + WS_FFL);
#pragma unroll
            for (int ai = 0; ai < 2; ++ai)
#pragma unroll
                for (int m = 0; m < 4; ++m) { const int row = u.pm * 256 + ai * 128 + wr * 64 + m * 16 + fr; const float sc = rs[ai][m];
                    const f32x4 v0 = acc[ai][1][m][0] * sc, v1 = acc[ai][1][m][1] * sc;
                    if (wc < 2) { float* p = KRF + (size_t)row * 64 + cw; *(f32x4*)p = v0; *(f32x4*)(p + 4) = v1; }
                    else if (wc == 2 && fq == 0) { float* p = FFL + (size_t)row * 8; *(f32x4*)p = v0; *(f32x4*)(p + 4) = v1; } }
        }
        if (pn == 14 || pn == 15) {
            float* KP = (float*)(ws + WS_KPART) + ((size_t)(u.pm * 2 + wr)) * 512 + (pn - 14) * 256;
#pragma unroll
            for (int bj = 0; bj < 2; ++bj)
#pragma unroll
                for (int n = 0; n < 2; ++n) { f32x4 s = (f32x4){0.f, 0.f, 0.f, 0.f};
#pragma unroll
                    for (int ai = 0; ai < 2; ++ai)
#pragma unroll
                        for (int m = 0; m < 4; ++m) s += acc[ai][bj][m][n] * rs[ai][m];
#pragma unroll
                    for (int o = 1; o < 16; o <<= 1) { s[0] += __shfl_xor(s[0], o); s[1] += __shfl_xor(s[1], o); s[2] += __shfl_xor(s[2], o); s[3] += __shfl_xor(s[3], o); }
                    if (fr == 0) *(f32x4*)(KP + bj * 128 + cw + 4 * n) = s; }
        }
    }
};

struct EpiQ {
    static constexpr bool PERM = true;
    unsigned char* ws;
    __device__ __forceinline__ void operator()(const f32x4 (&acc)[2][2][4][2], const pg8::Unit& u, int wr, int wc, int fr, int fq) const {
        const float* RS = (const float*)(ws + WS_RSCQ); bf16_t* QM = (bf16_t*)(ws + WS_QM);
        const float* COS = (const float*)(ws + WS_ROPE); const float* SIN = COS + SEQ * 32;
        const int pn = u.pn, cw = wc * 32 + 8 * fq;
#pragma unroll
        for (int ai = 0; ai < 2; ++ai)
#pragma unroll
            for (int m = 0; m < 4; ++m) { const int row = u.pm * 256 + ai * 128 + wr * 64 + m * 16 + fr;
                const float sc = RS[row] * C2_192;
                if (pn < 2) {
#pragma unroll
                    for (int bj = 0; bj < 2; ++bj) { const int head = pn * 2 + bj; store8_bf16(QM + (size_t)row * 768 + head * 192 + cw, acc[ai][bj][m][0] * sc, acc[ai][bj][m][1] * sc); }
                } else {
                    const int tpos = row & (SEQ - 1); const float* cp = COS + (size_t)tpos * 32 + 8 * fq; const float* sp = SIN + (size_t)tpos * 32 + 8 * fq;
                    const f32x4 c0 = *(const f32x4*)cp, c1 = *(const f32x4*)(cp + 4), s0 = *(const f32x4*)sp, s1 = *(const f32x4*)(sp + 4);
                    const f32x4 x10 = acc[ai][0][m][0] * sc, x11 = acc[ai][0][m][1] * sc, x20 = acc[ai][1][m][0] * sc, x21 = acc[ai][1][m][1] * sc;
                    bf16_t* p = QM + (size_t)row * 768 + wc * 192 + 128 + 8 * fq;
                    store8_bf16(p, x10 * c0 - x20 * s0, x11 * c1 - x21 * s1);
                    store8_bf16(p + 32, x20 * c0 + x10 * s0, x21 * c1 + x11 * s1);
                    if (m & 1) asm volatile("" ::: "memory");
                } }
    }
};
struct EpiKV {
    static constexpr bool PERM = true;
    unsigned char* ws;
    __device__ __forceinline__ void operator()(const f32x4 (&acc)[2][2][4][2], const pg8::Unit& u, int wr, int wc, int fr, int fq) const {
        const float* RS = (const float*)(ws + WS_RSCKV);
        const int pn = u.pn, cw = wc * 32 + 8 * fq;
        bf16_t* base = (pn < 2) ? (bf16_t*)(ws + WS_KM) + (pn * 2) * 192 + cw : (bf16_t*)(ws + WS_VM) + (pn - 2) * 256 + cw;
        const int pitch = (pn < 2) ? 768 : 512, bjs = (pn < 2) ? 192 : 128;
#pragma unroll
        for (int ai = 0; ai < 2; ++ai)
#pragma unroll
            for (int m = 0; m < 4; ++m) { const int row = u.pm * 256 + ai * 128 + wr * 64 + m * 16 + fr; const float sc = RS[row]; bf16_t* rowp = base + (size_t)row * pitch;
#pragma unroll
                for (int bj = 0; bj < 2; ++bj) store8_bf16(rowp + bj * bjs, acc[ai][bj][m][0] * sc, acc[ai][bj][m][1] * sc); }
    }
};
struct EpiC {
    static constexpr bool PERM = false;
    const float* xin; float* xout; unsigned char* ws; int last;
    __device__ __forceinline__ void operator()(const f32x4 (&acc)[2][2][4][2], const pg8::Unit& u, int wr, int wc, int fr, int fq) const {
        bf16_t* XB = (bf16_t*)(ws + WS_XB); float* SSX = (float*)(ws + WS_SSX);
#pragma unroll
        for (int ai = 0; ai < 2; ++ai)
#pragma unroll
            for (int m = 0; m < 4; ++m) { const int row = u.pm * 256 + ai * 128 + wr * 64 + m * 16 + fr; const size_t off = (size_t)row * DM + u.pn * 256 + wc * 32 + 4 * fq; float ss = 0.f;
#pragma unroll
                for (int bj = 0; bj < 2; ++bj)
#pragma unroll
                    for (int n = 0; n < 2; ++n) { const size_t o = off + bj * 128 + n * 16; const f32x4 v = acc[ai][bj][m][n] + *(const f32x4*)(xin + o); *(f32x4*)(xout + o) = v; ss += dot4(v);
                        if (!last) { u32x2 w; w.x = cvt_pk_bf16(v[0], v[1]); w.y = cvt_pk_bf16(v[2], v[3]); *(u32x2*)(XB + o) = w; } }
                if (!last) { ss += __shfl_xor(ss, 16); ss += __shfl_xor(ss, 32); if (fq == 0) SSX[(size_t)row * 16 + u.pn * 4 + wc] = ss; } }
    }
};

#define SBAR() __builtin_amdgcn_sched_barrier(0)
__device__ __forceinline__ int crow(int r, int hi) { return (r & 3) + 8 * (r >> 2) + 4 * hi; }
template <int OFF> __device__ __forceinline__ s16x4 tr_read(int vb) { s16x4 r; asm volatile("ds_read_b64_tr_b16 %0, %1 offset:%2" : "=&v"(r) : "v"(vb), "i"(OFF) : "memory"); return r; }
__device__ __forceinline__ int v_rd_base(int lane) { return ((lane & 3) << 3) | (((lane >> 2) & 3) << 6) | (((lane >> 4) & 1) << 5) | (((lane >> 5) & 1) << 8); }
template <int NCB> __device__ __forceinline__ int v_st(int k, int c) { const int kk = (k & ~0xC) | ((k & 4) << 1) | ((k & 8) >> 1); return ((kk >> 3) * NCB + (c >> 5)) * 512 + ((kk & 7) * 32 + (c & 31)) * 2; }
template <int NCB, int D0> __device__ __forceinline__ void pv_one(f32x16& od, int vb, bf16x8 pa0, bf16x8 pa1, bf16x8 pa2, bf16x8 pa3) {
#define VOFF(ks, half) (((2 * (ks) + (half)) * NCB + D0) * 512)
    const s16x4 l0 = tr_read<VOFF(0, 0)>(vb), h0 = tr_read<VOFF(0, 1)>(vb), l1 = tr_read<VOFF(1, 0)>(vb), h1 = tr_read<VOFF(1, 1)>(vb);
    const s16x4 l2 = tr_read<VOFF(2, 0)>(vb), h2 = tr_read<VOFF(2, 1)>(vb), l3 = tr_read<VOFF(3, 0)>(vb), h3 = tr_read<VOFF(3, 1)>(vb);
#undef VOFF
    asm volatile("s_waitcnt lgkmcnt(0)" ::: "memory"); SBAR();
#define PK(L, H) (bf16x8){L[0], L[1], L[2], L[3], H[0], H[1], H[2], H[3]}
    od = __builtin_amdgcn_mfma_f32_32x32x16_bf16(pa0, PK(l0, h0), od, 0, 0, 0);
    od = __builtin_amdgcn_mfma_f32_32x32x16_bf16(pa1, PK(l1, h1), od, 0, 0, 0);
    od = __builtin_amdgcn_mfma_f32_32x32x16_bf16(pa2, PK(l2, h2), od, 0, 0, 0);
    od = __builtin_amdgcn_mfma_f32_32x32x16_bf16(pa3, PK(l3, h3), od, 0, 0, 0);
#undef PK
}
struct AttnP {
    const bf16_t* Q; int ldq;
    const bf16_t* K; int ldk;
    const bf16_t* V; int ldv;
    bf16_t* O; int ldo;
    const bf16_t* G; int ldg;
    float* SSQ; int nh;
    const float* bias;
    const unsigned* sel;
};
template <int DK, int DV, int MODE>
__device__ __forceinline__ void attn_unit(const AttnP& P, int b, int h, int qb, char* lds) {
    constexpr int NKL = DK / 64, NVL = DV / 64, NCB = DV / 32, ND0 = DK / 16, KB = 64 * DK * 2, VB = 64 * DV * 2;
    constexpr float THR = 8.0f;
    int tid_ = threadIdx.x; asm volatile("" : "+v"(tid_));
    const int tid = tid_, lane = tid & 63, r32 = lane & 31, hi = lane >> 5; const int wid = __builtin_amdgcn_readfirstlane(tid >> 6);
    char* Kl = lds; char* Vl = lds + 2 * KB; float* wsf = (float*)(lds + 2 * KB + 2 * VB) + wid * 64;
    const int q0 = qb * 256; const size_t row0 = (size_t)b * SEQ;
    const int qrow = q0 + wid * 32 + r32;
    const int qlast = q0 + wid * 32 + 31;
    bf16x8 qr[ND0];
    { const bf16_t* Qw = P.Q + (row0 + qrow) * P.ldq + h * DK + hi * 8;
#pragma unroll
      for (int d0 = 0; d0 < ND0; ++d0) qr[d0] = *(const bf16x8*)(Qw + d0 * 16); }
    const int sr = tid >> 3, sc = (tid & 7) * 8;
    const bf16_t* Kg = P.K + (row0 + sr) * P.ldk + h * DK + sc;
    const bf16_t* Vg = P.V + (row0 + sr) * P.ldv + h * DV + sc;
    const int vb0 = (int)(uintptr_t)Vl + v_rd_base(lane);
    const int NT = 4 * (qb + 1);
    unsigned selw = 0u; float alpha_b = 0.f;
    if (MODE == 2) { selw = P.sel[(row0 + qrow) * 8 + h]; alpha_b = LOG2E * __builtin_amdgcn_exp2f(-(float)(h + 1)); }
    const float* biasp = (MODE == 0) ? P.bias + (size_t)(b * 8 + h) * SEQ + 4 * hi : nullptr;
#define KEY0(j) ((MODE == 2) ? (((j) < 4) ? q0 + 64 * (j) : 64 * ((j) - 4)) : 64 * (j))
    bf16x8 ks[NKL], vs[NVL];
#define SLOAD(k0) do { _Pragma("unroll") for (int i_ = 0; i_ < NKL; ++i_) ks[i_] = *(const bf16x8*)(Kg + (size_t)(k0) * P.ldk + 64 * i_); \
                       _Pragma("unroll") for (int i_ = 0; i_ < NVL; ++i_) vs[i_] = *(const bf16x8*)(Vg + (size_t)(k0) * P.ldv + 64 * i_); } while (0)
#define SWRITE(bsel) do { _Pragma("unroll") for (int i_ = 0; i_ < NKL; ++i_) *(bf16x8*)(Kl + (bsel) * KB + sr * (DK * 2) + ((((sc + 64 * i_) * 2)) ^ ((sr & 7) << 4))) = ks[i_]; \
                          _Pragma("unroll") for (int i_ = 0; i_ < NVL; ++i_) *(bf16x8*)(Vl + (bsel) * VB + v_st<NCB>(sr, sc + 64 * i_)) = vs[i_]; } while (0)
    float m_reg = -1e30f, l_reg = 0.f; f32x16 o[NCB];
#pragma unroll
    for (int d = 0; d < NCB; ++d) o[d] = f32x16{};
    SLOAD(KEY0(0)); SWRITE(0);
    for (int j = 0; j < NT; ++j) {
        __syncthreads();
        const int key0 = KEY0(j); const int bsel = j & 1;
        if (j + 1 < NT) SLOAD(KEY0(j + 1));
        bool active = true;
        if (MODE == 2 && j >= 4) { active = __any((int)((selw >> ((j - 4) >> 2)) & 1u)); }
        else { active = key0 <= qlast; }
        if (active) {
            f32x16 p0 = f32x16{}, p1 = f32x16{};
            const char* Kb = Kl + bsel * KB;
#pragma unroll
            for (int d0 = 0; d0 < ND0; ++d0) { const int cb = (d0 * 16 + hi * 8) * 2;
                const bf16x8 b0 = *(const bf16x8*)(Kb + r32 * (DK * 2) + (cb ^ ((r32 & 7) << 4)));
                const bf16x8 b1 = *(const bf16x8*)(Kb + (32 + r32) * (DK * 2) + (cb ^ ((r32 & 7) << 4)));
                p0 = __builtin_amdgcn_mfma_f32_32x32x16_bf16(b0, qr[d0], p0, 0, 0, 0);
                p1 = __builtin_amdgcn_mfma_f32_32x32x16_bf16(b1, qr[d0], p1, 0, 0, 0); }
            if (MODE == 0) {
#pragma unroll
                for (int g = 0; g < 4; ++g) { const f32x4 b0 = *(const f32x4*)(biasp + key0 + 8 * g), b1 = *(const f32x4*)(biasp + key0 + 32 + 8 * g);
#pragma unroll
                    for (int i = 0; i < 4; ++i) { p0[4 * g + i] += b0[i]; p1[4 * g + i] += b1[i]; } }
            }
            if (MODE == 2) { const float kb = (float)(key0 - q0 + 4 * hi);
#pragma unroll
                for (int r = 0; r < 16; ++r) { const float kk = kb + (float)((r & 3) + 8 * (r >> 2)); p0[r] = __builtin_fmaf(alpha_b, kk, p0[r]); p1[r] = __builtin_fmaf(alpha_b, kk + 32.0f, p1[r]); } }
            if (MODE == 2 && j >= 4) { if (!((selw >> ((j - 4) >> 2)) & 1u)) {
#pragma unroll
                for (int r = 0; r < 16; ++r) { p0[r] = -INFINITY; p1[r] = -INFINITY; } } }
            else if (key0 + 63 > q0 + wid * 32) { const int kb = key0 + 4 * hi;
#pragma unroll
                for (int r = 0; r < 16; ++r) { const int kv = kb + (r & 3) + 8 * (r >> 2); if (kv > qrow) p0[r] = -INFINITY; if (kv + 32 > qrow) p1[r] = -INFINITY; } }
            float pmax = p0[0];
#pragma unroll
            for (int r = 1; r < 16; ++r) pmax = fmaxf(pmax, p0[r]);
#pragma unroll
            for (int r = 0; r < 16; ++r) pmax = fmaxf(pmax, p1[r]);
            { auto rr = __builtin_amdgcn_permlane32_swap(__float_as_uint(pmax), __float_as_uint(pmax), false, false); pmax = fmaxf(__uint_as_float(rr[0]), __uint_as_float(rr[1])); }
            if (!__all(pmax - m_reg <= THR)) {
                const float mn = fmaxf(m_reg, pmax); const float al = __builtin_amdgcn_exp2f(m_reg - mn); m_reg = mn; l_reg *= al;
                if (hi == 0) wsf[r32] = al; asm volatile("s_waitcnt lgkmcnt(0)" ::: "memory");
#pragma unroll
                for (int r = 0; r < 16; ++r) { const float a = wsf[crow(r, hi)];
#pragma unroll
                    for (int d = 0; d < NCB; ++d) o[d][r] *= a; }
            }
            float ps = 0.f;
#pragma unroll
            for (int r = 0; r < 16; ++r) { p0[r] = __builtin_amdgcn_exp2f(p0[r] - m_reg); p1[r] = __builtin_amdgcn_exp2f(p1[r] - m_reg); ps += p0[r] + p1[r]; }
            { auto rr = __builtin_amdgcn_permlane32_swap(__float_as_uint(ps), __float_as_uint(ps), false, false); ps = __uint_as_float(rr[0]) + __uint_as_float(rr[1]); }
            l_reg += ps;
            bf16x8 pa0, pa1, pa2, pa3;
#define PK4(Pv, BASE, OUT) do { unsigned a0 = cvt_pk_bf16(Pv[BASE + 0], Pv[BASE + 1]), a1 = cvt_pk_bf16(Pv[BASE + 2], Pv[BASE + 3]); \
    unsigned b0_ = cvt_pk_bf16(Pv[BASE + 4], Pv[BASE + 5]), b1_ = cvt_pk_bf16(Pv[BASE + 6], Pv[BASE + 7]); \
    auto r0 = __builtin_amdgcn_permlane32_swap(a0, b0_, false, false); auto r1 = __builtin_amdgcn_permlane32_swap(a1, b1_, false, false); \
    u32x4 w = {r0[0], r1[0], r0[1], r1[1]}; OUT = *reinterpret_cast<bf16x8*>(&w); } while (0)
            PK4(p0, 0, pa0); PK4(p0, 8, pa1); PK4(p1, 0, pa2); PK4(p1, 8, pa3);
#undef PK4
            const int vb = vb0 + bsel * VB;
            pv_one<NCB, 0>(o[0], vb, pa0, pa1, pa2, pa3); pv_one<NCB, 1>(o[1], vb, pa0, pa1, pa2, pa3);
            if constexpr (NCB == 4) { pv_one<NCB, 2>(o[2], vb, pa0, pa1, pa2, pa3); pv_one<NCB, 3>(o[3], vb, pa0, pa1, pa2, pa3); }
        }
        if (j + 1 < NT) SWRITE((j + 1) & 1);
    }
    if (hi == 0) wsf[32 + r32] = l_reg; asm volatile("s_waitcnt lgkmcnt(0)" ::: "memory");
    const size_t orow0 = row0 + q0 + wid * 32;
#pragma unroll
    for (int r = 0; r < 16; ++r) { const int orow = crow(r, hi); const float rl = __builtin_amdgcn_rcpf(wsf[32 + orow]); float ss = 0.f;
        float y[NCB];
#pragma unroll
        for (int d = 0; d < NCB; ++d) { y[d] = o[d][r] * rl; ss += y[d] * y[d]; }
#pragma unroll
        for (int sh = 1; sh < 32; sh <<= 1) ss += __shfl_xor(ss, sh);
        if (r32 == 0) P.SSQ[(orow0 + orow) * P.nh + h] = ss;
#pragma unroll
        for (int d = 0; d < NCB; ++d) { const size_t gi = (orow0 + orow) * P.ldg + h * DV + d * 32 + r32; const float gt = bf2f(P.G[gi]);
            const size_t oi = (orow0 + orow) * P.ldo + h * DV + d * 32 + r32; P.O[oi] = (bf16_t)(cvt_pk_bf16(y[d] * gt, 0.f) & 0xffffu); } }
    __syncthreads();
#undef KEY0
#undef SLOAD
#undef SWRITE
}

struct UTab { unsigned short v[2560]; };
constexpr UTab make_utab() {
    UTab t{}; int k = 0;
    for (int c = 80; c >= 1; --c) {
        if (c % 5 == 0 && c / 5 <= 16) { const int qb = c / 5 - 1; for (int b = 0; b < 8; ++b) for (int h = 0; h < 4; ++h) t.v[k++] = (unsigned short)((1 << 12) | (b << 8) | (h << 4) | qb); }
        if (c % 2 == 0 && c / 2 <= 16) { const int qb = c / 2 - 1; for (int ty = 0; ty <= 2; ty += 2) for (int b = 0; b < 8; ++b) for (int h = 0; h < 8; ++h) t.v[k++] = (unsigned short)((ty << 12) | (b << 8) | (h << 4) | qb); }
    }
    return t;
}
__device__ const UTab g_utab = make_utab();
constexpr int N_ATT_UNITS = 2560;

struct Args { const float* in[11]; float* out; unsigned char* ws; int ph_lo, ph_hi, coop, pad; };
#ifndef PHM
#define PHM 127
#endif
#ifndef B1M
#define B1M 31
#endif
constexpr int NPHASES = 13;

__device__ __forceinline__ int src_in(int n) {
    const int t = n >> 8, j = n & 255;
    if (t < 6) return n;
    if (t < 8) return 1544 + (n - 1536);
    if (t == 8) return 2056 + j;
    if (t == 9) return j < 128 ? 2312 + j : (j < 192 ? 2440 + (j - 128) : (j < 200 ? 1536 + (j - 192) : -1));
    if (t < 12) return 2504 + (n - 2560);
    return 3016 + (n - 3072);
}
__device__ __forceinline__ int src_uq(int n) {
    if (n < 512) return (n >> 7) * 192 + (n & 127);
    const int p = n - 512; return p < 128 ? (p >> 5) * 192 + 128 + (p & 31) : ((p - 128) >> 5) * 192 + 160 + ((p - 128) & 31);
}
__device__ __forceinline__ int src_ukv(int n) {
    return n < 512 ? (n >> 7) * 256 + (n & 127) : ((n - 512) >> 7) * 256 + 128 + ((n - 512) & 127);
}
__device__ __forceinline__ void transpose_item(const float* W, int Ksrc, int Nsrc, const float* gain, bf16_t* WT, int Kdst, int mat, LAS float* scr, int kb, int nb, int lane) {
    const int k0 = 64 * kb, n0 = 32 * nb; const int nn = n0 + (lane & 31);
    const int sc = (mat == 0) ? src_in(nn) : (mat == 1) ? src_uq(nn) : (mat == 2) ? src_ukv(nn) : nn;
#pragma unroll 8
    for (int i = 0; i < 32; ++i) { const int kk = 2 * i + (lane >> 5); const int k = k0 + kk;
        float v = 0.f; if (sc >= 0 && k < Ksrc) v = W[(size_t)k * Nsrc + sc] * gain[k];
        scr[kk * 33 + (lane & 31)] = v; }
    asm volatile("s_waitcnt lgkmcnt(0)" ::: "memory");
    const int c = lane & 7;
#pragma unroll
    for (int j = 0; j < 4; ++j) { const int n = (lane >> 3) + 8 * j; const LAS float* s = scr + (8 * c) * 33 + n;
        u32x4 o; o.x = cvt_pk_bf16(s[0 * 33], s[1 * 33]); o.y = cvt_pk_bf16(s[2 * 33], s[3 * 33]); o.z = cvt_pk_bf16(s[4 * 33], s[5 * 33]); o.w = cvt_pk_bf16(s[6 * 33], s[7 * 33]);
        *(u32x4*)(WT + (size_t)(n0 + n) * Kdst + k0 + 8 * c) = o; }
    asm volatile("s_waitcnt lgkmcnt(0)" ::: "memory");
}

__device__ __forceinline__ float log_sigmoid_f(float x) { return fminf(x, 0.f) - log1pf(expf(-fabsf(x))); }

__device__ __forceinline__ void phase_p0(const Args& args, const int layer, LAS unsigned char* lds, unsigned char* lds_raw, const int G, const int bid) {
    unsigned char* ws = args.ws; asm volatile("" : "+s"(ws));
    int tid = threadIdx.x; asm volatile("" : "+v"(tid));
    const int lane = tid & 63, wave = __builtin_amdgcn_readfirstlane(tid >> 6);
    const int gw = bid * NWAVES + wave, NGW = G * NWAVES;
    unsigned char* wl = ws + WS_W + (size_t)layer * W_LAYER;
    (void)lane; (void)gw; (void)NGW; (void)wl; (void)lds_raw;
            LAS float* scr = (LAS float*)(lds + wave * 16384);
            constexpr int I_IN = 16 * 160, I_UQ = 4 * 24, I_UKV = 4 * 32, I_OUT = 24 * 32, I_L = I_IN + I_UQ + I_UKV + I_OUT;
            for (int it = gw; it < 2 * I_L; it += NGW) {
                const int l = it / I_L; int r = it % I_L; unsigned char* w = ws + WS_W + (size_t)l * W_LAYER;
                if (r < I_IN) { transpose_item(args.in[2] + (size_t)l * DM * D_IN, DM, D_IN, args.in[1] + l * DM, (bf16_t*)(w + W_IN_OFF), DM, 0, scr, r / 160, r % 160, lane); continue; } r -= I_IN;
                if (r < I_UQ) { transpose_item(args.in[5] + (size_t)l * 256 * 768, 256, 768, args.in[4] + l * 256, (bf16_t*)(w + W_UQ_OFF), 256, 1, scr, r / 24, r % 24, lane); continue; } r -= I_UQ;
                if (r < I_UKV) { transpose_item(args.in[7] + (size_t)l * 128 * 1024, 128, 1024, args.in[6] + l * 128, (bf16_t*)(w + W_UKV_OFF), 256, 2, scr, r / 32, r % 32, lane); continue; } r -= I_UKV;
                transpose_item(args.in[9] + (size_t)l * DMIX * DM, DMIX, DM, args.in[8] + l * DMIX, (bf16_t*)(w + W_OUT_OFF), DMIX, 3, scr, r / 32, r % 32, lane);
            }
            { const float* x = args.in[0]; bf16_t* XB = (bf16_t*)(ws + WS_XB); float* RSX = (float*)(ws + WS_RSX);
              for (int m = gw; m < T; m += NGW) { const f32x4* xr = (const f32x4*)(x + (size_t)m * DM) + lane; f32x4 v[4]; float s = 0.f;
#pragma unroll
                  for (int j = 0; j < 4; ++j) { v[j] = xr[64 * j]; s += dot4(v[j]); }
                  s = wave_sum(s);
                  u32x2* o8 = (u32x2*)(XB + (size_t)m * DM) + lane;
#pragma unroll
                  for (int j = 0; j < 4; ++j) { u32x2 w; w.x = cvt_pk_bf16(v[j][0], v[j][1]); w.y = cvt_pk_bf16(v[j][2], v[j][3]); o8[64 * j] = w; }
                  if (lane == 0) RSX[m] = rsqrtf(s * (1.0f / 1024.0f) + EPS); } }
            { float* COS = (float*)(ws + WS_ROPE); float* SIN = COS + SEQ * 32;
              for (int i = bid * NTHREADS + tid; i < SEQ * 32; i += G * NTHREADS) { const int t = i >> 5, f = i & 31;
                  const float inv = powf(10000.0f, -(float)(2 * f) / 64.0f); const float ang = (float)t * inv;
                  COS[i] = (float)cos((double)ang); SIN[i] = (float)sin((double)ang); } }
}

__device__ __forceinline__ void phase_a(const Args& args, const int layer, LAS unsigned char* lds, unsigned char* lds_raw, const int G, const int bid) {
    unsigned char* ws = args.ws; asm volatile("" : "+s"(ws));
    int tid = threadIdx.x; asm volatile("" : "+v"(tid));
    const int lane = tid & 63, wave = __builtin_amdgcn_readfirstlane(tid >> 6);
    const int gw = bid * NWAVES + wave, NGW = G * NWAVES;
    unsigned char* wl = ws + WS_W + (size_t)layer * W_LAYER;
    (void)lane; (void)gw; (void)NGW; (void)wl; (void)lds_raw;
            pg8::Gemm g{(const bf16_t*)(ws + WS_XB), (const bf16_t*)(wl + W_IN_OFF), T, NIN, DM, DM}; pg8::StaticOrder S; S.init(T, NIN, G, bid);
            EpiA E{ws, (LAS float*)(lds + SIDE_OFF)};
            pg8::gemm_phase<EpiA, true>(lds, g, S, E);
}

__device__ __forceinline__ void phase_b1(const Args& args, const int layer, LAS unsigned char* lds, unsigned char* lds_raw, const int G, const int bid) {
    unsigned char* ws = args.ws; asm volatile("" : "+s"(ws));
    int tid = threadIdx.x; asm volatile("" : "+v"(tid));
    const int lane = tid & 63, wave = __builtin_amdgcn_readfirstlane(tid >> 6);
    const int gw = bid * NWAVES + wave, NGW = G * NWAVES;
    unsigned char* wl = ws + WS_W + (size_t)layer * W_LAYER;
    (void)lane; (void)gw; (void)NGW; (void)wl; (void)lds_raw;
            if (B1M & 1) { pg8::Gemm g{(const bf16_t*)(ws + WS_QG) + 512, (const bf16_t*)(wl + W_UQ_OFF), T, 768, 256, 1536}; pg8::StaticOrder S; S.init(T, 768, G, bid);
              EpiQ E{ws}; pg8::gemm_phase<EpiQ, true>(lds, g, S, E); }
            if (B1M & 2) { pg8::Gemm g{(const bf16_t*)(ws + WS_QG) + 768, (const bf16_t*)(wl + W_UKV_OFF), T, 1024, 256, 1536}; pg8::StaticOrder S; S.init(T, 1024, G, bid);
              EpiKV E{ws}; pg8::gemm_phase<EpiKV, true>(lds, g, S, E); }
            if (B1M & 4) { const float* KRF = (const float*)(ws + WS_KRF); bf16_t* KM = (bf16_t*)(ws + WS_KM); const float* COS = (const float*)(ws + WS_ROPE); const float* SIN = COS + SEQ * 32;
              for (int i = bid * NTHREADS + tid; i < T * 8; i += G * NTHREADS) { const int t = i >> 3, c4 = (i & 7) * 4; const int tp = t & (SEQ - 1);
                  const f32x4 x1 = *(const f32x4*)(KRF + (size_t)t * 64 + c4), x2 = *(const f32x4*)(KRF + (size_t)t * 64 + 32 + c4);
                  const f32x4 c = *(const f32x4*)(COS + tp * 32 + c4), s = *(const f32x4*)(SIN + tp * 32 + c4);
                  const f32x4 o1 = x1 * c - x2 * s, o2 = x2 * c + x1 * s;
                  u32x2 w1, w2; w1.x = cvt_pk_bf16(o1[0], o1[1]); w1.y = cvt_pk_bf16(o1[2], o1[3]); w2.x = cvt_pk_bf16(o2[0], o2[1]); w2.y = cvt_pk_bf16(o2[2], o2[3]);
#pragma unroll
                  for (int hh = 0; hh < 4; ++hh) { bf16_t* p = KM + (size_t)t * 768 + hh * 192 + 128 + c4; *(u32x2*)p = w1; *(u32x2*)(p + 32) = w2; } } }
            if (B1M & 8) { const float* FFL = (const float*)(ws + WS_FFL); float* BF = (float*)(ws + WS_BIASF); const float* bfp = args.in[3] + layer * 8;
              for (int sq = gw; sq < 64; sq += NGW) { const int b = sq >> 3, h = sq & 7; const float bb = bfp[h];
                  const float* src = FFL + ((size_t)b * SEQ + lane * 64) * 8 + h; float tot = 0.f;
                  for (int i = 0; i < 64; ++i) tot += log_sigmoid_f(src[(size_t)i * 8] + bb);
                  float incl = tot;
#pragma unroll
                  for (int o = 1; o < 64; o <<= 1) { const float n = __shfl_up(incl, o); if (lane >= o) incl += n; }
                  float run = incl - tot; float* dst = BF + (size_t)sq * SEQ + lane * 64;
                  for (int i = 0; i < 64; ++i) { run += log_sigmoid_f(src[(size_t)i * 8] + bb); dst[i] = -LOG2E * run; } } }
            if (B1M & 16) { const float* KP = (const float*)(ws + WS_KPART); const bf16_t* QG = (const bf16_t*)(ws + WS_QG); unsigned* SEL = (unsigned*)(ws + WS_SEL);
              LAS float* km = (LAS float*)lds;
              for (int job = bid; job < 512; job += G) { const int b = job >> 6, h = (job >> 3) & 7, tb = job & 7;
                  __syncthreads();
                  for (int i = tid; i < 1024; i += NTHREADS) { const int n = i >> 6, d = i & 63; const float* p = KP + ((size_t)((b * 16 + n) * 2)) * 512 + h * 64 + d; km[i] = (p[0] + p[512]) * (1.0f / 256.0f); }
                  __syncthreads();
                  const int t = tb * 512 + tid; const int cur = t >> 8; const size_t row = (size_t)b * SEQ + t;
                  float q[64];
                  { const bf16x8* qp = (const bf16x8*)(QG + row * 1536 + 1024 + h * 64);
#pragma unroll
                    for (int c = 0; c < 8; ++c) { const bf16x8 v = qp[c];
#pragma unroll
                        for (int e = 0; e < 8; ++e) q[c * 8 + e] = bf2f((unsigned short)v[e]); } }
                  float g1 = -INFINITY, g2 = -INFINITY, g3 = -INFINITY; int i1 = -1, i2 = -1, i3 = -1;
                  for (int n = 0; n < cur; ++n) { float gsum = 0.f;
#pragma unroll
                      for (int d = 0; d < 64; ++d) gsum = __builtin_fmaf(q[d], km[n * 64 + d], gsum);
                      if (gsum > g1) { g3 = g2; i3 = i2; g2 = g1; i2 = i1; g1 = gsum; i1 = n; }
                      else if (gsum > g2) { g3 = g2; i3 = i2; g2 = gsum; i2 = n; }
                      else if (gsum > g3) { g3 = gsum; i3 = n; } }
                  unsigned m = 0u; if (i1 >= 0) m |= 1u << i1; if (i2 >= 0) m |= 1u << i2; if (i3 >= 0) m |= 1u << i3;
                  SEL[row * 8 + h] = m; }
              __syncthreads(); }
}

__device__ __forceinline__ void phase_b2(const Args& args, const int layer, LAS unsigned char* lds, unsigned char* lds_raw, const int G, const int bid) {
    unsigned char* ws = args.ws; asm volatile("" : "+s"(ws));
    int tid = threadIdx.x; asm volatile("" : "+v"(tid));
    const int lane = tid & 63, wave = __builtin_amdgcn_readfirstlane(tid >> 6);
    const int gw = bid * NWAVES + wave, NGW = G * NWAVES;
    unsigned char* wl = ws + WS_W + (size_t)layer * W_LAYER;
    (void)lane; (void)gw; (void)NGW; (void)wl; (void)lds_raw;
    volatile LAS unsigned* MISC = (volatile LAS unsigned*)(lds + MISC_OFF); unsigned* ctl = (unsigned*)(ws + WS_CTL);
            unsigned* qctr = ctl + CW_QCTR * (1 + layer);
            for (;;) {
                if (tid == 0) MISC[0] = __hip_atomic_fetch_add(qctr, 1u, __ATOMIC_RELAXED, __HIP_MEMORY_SCOPE_AGENT);
                __syncthreads();
                const unsigned k = MISC[0];
                __syncthreads();
                if (k >= (unsigned)N_ATT_UNITS) break;
                const unsigned e = g_utab.v[k]; const int ty = e >> 12, b = (e >> 8) & 7, h = (e >> 4) & 7, qb = e & 15;
                if (ty == 0) { const AttnP PF{(const bf16_t*)(ws + WS_QG), 1536, (const bf16_t*)(ws + WS_FK), 512, (const bf16_t*)(ws + WS_FV), 512, (bf16_t*)(ws + WS_QG), 1536,
                                   (const bf16_t*)(ws + WS_GATE), 1536, (float*)(ws + WS_SSQA), 8, (const float*)(ws + WS_BIASF), nullptr};
                    attn_unit<64, 64, 0>(PF, b, h, qb, (char*)lds_raw); }
                else if (ty == 1) { const AttnP PM{(const bf16_t*)(ws + WS_QM), 768, (const bf16_t*)(ws + WS_KM), 768, (const bf16_t*)(ws + WS_VM), 512, (bf16_t*)(ws + WS_QG) + 512, 1536,
                                   (const bf16_t*)(ws + WS_GATE) + 512, 1536, (float*)(ws + WS_SSQB), 4, nullptr, nullptr};
                    attn_unit<192, 128, 1>(PM, b, h, qb, (char*)lds_raw); }
                else { const AttnP PB{(const bf16_t*)(ws + WS_QG) + 1024, 1536, (const bf16_t*)(ws + WS_BK), 512, (const bf16_t*)(ws + WS_BV), 512, (bf16_t*)(ws + WS_QG) + 1024, 1536,
                                   (const bf16_t*)(ws + WS_GATE) + 1024, 1536, (float*)(ws + WS_SSQC), 8, nullptr, (const unsigned*)(ws + WS_SEL)};
                    attn_unit<64, 64, 2>(PB, b, h, qb, (char*)lds_raw); }
            }
}

__device__ __forceinline__ void phase_n(const Args& args, const int layer, LAS unsigned char* lds, unsigned char* lds_raw, const int G, const int bid) {
    unsigned char* ws = args.ws; asm volatile("" : "+s"(ws));
    int tid = threadIdx.x; asm volatile("" : "+v"(tid));
    const int lane = tid & 63, wave = __builtin_amdgcn_readfirstlane(tid >> 6);
    const int gw = bid * NWAVES + wave, NGW = G * NWAVES;
    unsigned char* wl = ws + WS_W + (size_t)layer * W_LAYER;
    (void)lane; (void)gw; (void)NGW; (void)wl; (void)lds_raw;
            bf16_t* Y = (bf16_t*)(ws + WS_QG); const float* SA = (const float*)(ws + WS_SSQA); const float* SB = (const float*)(ws + WS_SSQB); const float* SC = (const float*)(ws + WS_SSQC);
            for (int m = gw; m < T; m += NGW) {
                const f32x4 a0 = *(const f32x4*)(SA + (size_t)m * 8), a1 = *(const f32x4*)(SA + (size_t)m * 8 + 4), b0 = *(const f32x4*)(SB + (size_t)m * 4);
                const f32x4 c0 = *(const f32x4*)(SC + (size_t)m * 8), c1 = *(const f32x4*)(SC + (size_t)m * 8 + 4);
                const float ra = rsqrtf((sum4(a0) + sum4(a1)) * (1.0f / 512.0f) + EPS), rb = rsqrtf(sum4(b0) * (1.0f / 512.0f) + EPS), rc = rsqrtf((sum4(c0) + sum4(c1)) * (1.0f / 512.0f) + EPS);
                u32x4* yp = (u32x4*)(Y + (size_t)m * 1536);
#pragma unroll
                for (int j = 0; j < 3; ++j) { const float r = (j == 0) ? ra : (j == 1) ? rb : rc; u32x4 v = yp[64 * j + lane]; u32x4 o;
#pragma unroll
                    for (int e = 0; e < 4; ++e) { const unsigned w = v[e]; o[e] = cvt_pk_bf16(__uint_as_float(w << 16) * r, __uint_as_float(w & 0xffff0000u) * r); }
                    yp[64 * j + lane] = o; }
            }
}

__device__ __forceinline__ void phase_c(const Args& args, const int layer, LAS unsigned char* lds, unsigned char* lds_raw, const int G, const int bid) {
    unsigned char* ws = args.ws; asm volatile("" : "+s"(ws));
    int tid = threadIdx.x; asm volatile("" : "+v"(tid));
    const int lane = tid & 63, wave = __builtin_amdgcn_readfirstlane(tid >> 6);
    const int gw = bid * NWAVES + wave, NGW = G * NWAVES;
    unsigned char* wl = ws + WS_W + (size_t)layer * W_LAYER;
    (void)lane; (void)gw; (void)NGW; (void)wl; (void)lds_raw;
            pg8::Gemm g{(const bf16_t*)(ws + WS_QG), (const bf16_t*)(wl + W_OUT_OFF), T, DM, DMIX, DMIX}; pg8::StaticOrder S; S.init(T, DM, G, bid);
            EpiC E{layer == 0 ? args.in[0] : (const float*)args.out, args.out, ws, layer == DEPTH - 1 ? 1 : 0};
            pg8::gemm_phase<EpiC, true>(lds, g, S, E);
}

__device__ __forceinline__ void phase_r(const Args& args, const int layer, LAS unsigned char* lds, unsigned char* lds_raw, const int G, const int bid) {
    unsigned char* ws = args.ws; asm volatile("" : "+s"(ws));
    int tid = threadIdx.x; asm volatile("" : "+v"(tid));
    const int lane = tid & 63, wave = __builtin_amdgcn_readfirstlane(tid >> 6);
    const int gw = bid * NWAVES + wave, NGW = G * NWAVES;
    unsigned char* wl = ws + WS_W + (size_t)layer * W_LAYER;
    (void)lane; (void)gw; (void)NGW; (void)wl; (void)lds_raw;
            const float* SSX = (const float*)(ws + WS_SSX); float* RSX = (float*)(ws + WS_RSX);
            for (int m = bid * NTHREADS + tid; m < T; m += G * NTHREADS) { const f32x4* p = (const f32x4*)(SSX + (size_t)m * 16);
                const float sm = (sum4(p[0]) + sum4(p[1])) + (sum4(p[2]) + sum4(p[3])); RSX[m] = rsqrtf(sm * (1.0f / 1024.0f) + EPS); }
}

__device__ __forceinline__ void phase_f(const Args& args, const int layer, LAS unsigned char* lds, unsigned char* lds_raw, const int G, const int bid) {
    unsigned char* ws = args.ws; asm volatile("" : "+s"(ws));
    int tid = threadIdx.x; asm volatile("" : "+v"(tid));
    const int lane = tid & 63, wave = __builtin_amdgcn_readfirstlane(tid >> 6);
    const int gw = bid * NWAVES + wave, NGW = G * NWAVES;
    unsigned char* wl = ws + WS_W + (size_t)layer * W_LAYER;
    (void)lane; (void)gw; (void)NGW; (void)wl; (void)lds_raw;
            float* X = args.out; const float* gf = args.in[10];
            for (int m = gw; m < T; m += NGW) { f32x4* xr = (f32x4*)(X + (size_t)m * DM) + lane; f32x4 v[4]; float s = 0.f;
#pragma unroll
                for (int j = 0; j < 4; ++j) { v[j] = xr[64 * j]; s += dot4(v[j]); }
                const float r = rsqrtf(wave_sum(s) * (1.0f / 1024.0f) + EPS);
#pragma unroll
                for (int j = 0; j < 4; ++j) { const f32x4 gg = *((const f32x4*)gf + 64 * j + lane); xr[64 * j] = v[j] * r * gg; } }
}

__global__ void __launch_bounds__(NTHREADS, 2) fwd_kernel(Args args) {
    extern __shared__ __attribute__((aligned(16))) unsigned char lds_raw[];
    LAS unsigned char* lds = (LAS unsigned char*)lds_raw;
    const int G = gridDim.x, bid = blockIdx.x;
    const int lo = args.ph_lo, hi = args.ph_hi;
#define IN(k) (lo <= (k) && (k) < hi)
#define SEAM(k) do { if (IN(k) && IN((k) + 1) && args.coop) cg::this_grid().sync(); } while (0)
    if (IN(0) && (PHM & 1)) phase_p0(args, 0, lds, lds_raw, G, bid);
    SEAM(0);
    if (IN(1) && (PHM & 2)) phase_a(args, 0, lds, lds_raw, G, bid);
    SEAM(1);
    if (IN(2) && (PHM & 4)) phase_b1(args, 0, lds, lds_raw, G, bid);
    SEAM(2);
    if (IN(3) && (PHM & 8)) phase_b2(args, 0, lds, lds_raw, G, bid);
    SEAM(3);
    if (IN(4) && (PHM & 16)) phase_n(args, 0, lds, lds_raw, G, bid);
    SEAM(4);
    if (IN(5) && (PHM & 32)) phase_c(args, 0, lds, lds_raw, G, bid);
    SEAM(5);
    if (IN(6)) phase_r(args, 0, lds, lds_raw, G, bid);
    SEAM(6);
    if (IN(7) && (PHM & 2)) phase_a(args, 1, lds, lds_raw, G, bid);
    SEAM(7);
    if (IN(8) && (PHM & 4)) phase_b1(args, 1, lds, lds_raw, G, bid);
    SEAM(8);
    if (IN(9) && (PHM & 8)) phase_b2(args, 1, lds, lds_raw, G, bid);
    SEAM(9);
    if (IN(10) && (PHM & 16)) phase_n(args, 1, lds, lds_raw, G, bid);
    SEAM(10);
    if (IN(11) && (PHM & 32)) phase_c(args, 1, lds, lds_raw, G, bid);
    SEAM(11);
    if (IN(12) && (PHM & 64)) phase_f(args, 0, lds, lds_raw, G, bid);
#undef IN
#undef SEAM
}

extern "C" void kernel_launch(void* const* d_in, const int* in_sizes, int n_in, void* d_out, int out_size, void* d_ws, size_t ws_size, hipStream_t stream) {
    static int grid = 0;
    if (grid == 0) {
        if (n_in != 11 || in_sizes[0] != T * DM || out_size != T * DM || ws_size < WS_END) {
            fprintf(stderr, "kernel_launch: shape mismatch (n_in %d, in0 %d, out %d, ws %zu; need ws >= %zu)\n", n_in, n_in > 0 ? in_sizes[0] : -1, out_size, ws_size, (size_t)WS_END); grid = -1; return; }
        int dev = 0, cus = 0, per_cu = 0;
        hipGetDevice(&dev); hipDeviceGetAttribute(&cus, hipDeviceAttributeMultiprocessorCount, dev);
        if (hipFuncSetAttribute((const void*)fwd_kernel, hipFuncAttributeMaxDynamicSharedMemorySize, LDS_BYTES) != hipSuccess) { fprintf(stderr, "kernel_launch: hipFuncSetAttribute failed\n"); grid = -1; return; }
        hipOccupancyMaxActiveBlocksPerMultiprocessor(&per_cu, (const void*)fwd_kernel, NTHREADS, LDS_BYTES);
        (void)hipGetLastError();
        if (per_cu < 1) { fprintf(stderr, "kernel_launch: occupancy query says %d blocks/CU\n", per_cu); per_cu = 1; }
        grid = cus * 1;
    }
    if (grid < 0) return;
    hipMemsetAsync((char*)d_ws + WS_CTL, 0, CTL_ZERO_BYTES, stream);
    Args a{};
    for (int i = 0; i < 11; ++i) a.in[i] = (const float*)d_in[i];
    a.out = (float*)d_out; a.ws = (unsigned char*)d_ws;
#ifndef ONE_LAUNCH
#define ONE_LAUNCH 1
#endif
    if (ONE_LAUNCH) {
        a.ph_lo = 0; a.ph_hi = NPHASES; a.coop = 1;
        void* kargs[] = {&a};
        hipError_t e = hipLaunchCooperativeKernel((const void*)fwd_kernel, dim3(grid), dim3(NTHREADS), kargs, LDS_BYTES, stream);
        if (e != hipSuccess) fprintf(stderr, "kernel_launch: cooperative launch failed: %s (grid %d)\n", hipGetErrorString(e), grid);
    } else {
        for (int ph = 0; ph < NPHASES; ++ph) { a.ph_lo = ph; a.ph_hi = ph + 1; a.coop = 0;
            hipLaunchKernelGGL(fwd_kernel, dim3(grid), dim3(NTHREADS), LDS_BYTES, stream, a); }
    }
}
```

```cpp
#include <hip/hip_runtime.h>
#include <hip/hip_cooperative_groups.h>
#include <cstdio>
#include <cstdint>
#include <cmath>
namespace cg = cooperative_groups;

#define LAS __attribute__((address_space(3)))
typedef unsigned short bf16_t;
typedef short bf16x8 __attribute__((ext_vector_type(8)));
typedef short s16x4 __attribute__((ext_vector_type(4)));
typedef float f32x4 __attribute__((ext_vector_type(4)));
typedef float f32x2 __attribute__((ext_vector_type(2)));
typedef float f32x16 __attribute__((ext_vector_type(16)));
typedef unsigned u32x4 __attribute__((ext_vector_type(4)));
typedef unsigned u32x2 __attribute__((ext_vector_type(2)));

constexpr int BATCH = 8, SEQ = 4096, T = BATCH * SEQ, DM = 1024, DEPTH = 2;
constexpr int D_IN = 5064, NIN = 5120, DMIX = 1536;
constexpr float EPS = 1e-6f, LOG2E = 1.4426950408889634f;
constexpr float C2_64 = 0.125f * LOG2E;
constexpr float C2_192 = 0.07216878364870323f * LOG2E;
constexpr int NWAVES = 8, NTHREADS = 512;

constexpr size_t MiB = 1u << 20;
constexpr size_t WS_CTL = 0, CTL_ZERO_BYTES = 1 * MiB;
constexpr size_t WS_SSX = 1 * MiB;
constexpr size_t WS_KRF = 3 * MiB;
constexpr size_t WS_FFL = 11 * MiB;
constexpr size_t WS_RSCQ = 12 * MiB;
constexpr size_t WS_RSCKV = 12 * MiB + 256 * 1024;
constexpr size_t WS_RSX = 12 * MiB + 512 * 1024;
constexpr size_t WS_KPART = 13 * MiB;
constexpr size_t WS_BIASF = 14 * MiB;
constexpr size_t WS_SEL = 15 * MiB;
constexpr size_t WS_SSQA = 16 * MiB;
constexpr size_t WS_SSQB = 17 * MiB;
constexpr size_t WS_SSQC = 18 * MiB;
constexpr size_t WS_ROPE = 19 * MiB;
constexpr size_t WS_W = 24 * MiB, W_LAYER = 14 * MiB;
constexpr size_t W_IN_OFF = 0, W_UQ_OFF = 10 * MiB, W_UKV_OFF = 10 * MiB + 512 * 1024, W_OUT_OFF = 11 * MiB;
constexpr size_t WS_QG = 56 * MiB;
constexpr size_t WS_GATE = 152 * MiB;
constexpr size_t WS_FK = 248 * MiB, WS_FV = 280 * MiB, WS_BK = 312 * MiB, WS_BV = 344 * MiB;
constexpr size_t WS_R2 = 376 * MiB;
constexpr size_t WS_XB = WS_R2, WS_QM = WS_R2, WS_KM = WS_R2 + 48 * MiB, WS_VM = WS_R2 + 96 * MiB;
constexpr size_t WS_END = 504 * MiB;
constexpr int CW_QCTR = 64;

constexpr int RING_BYTES = 131072, MISC_OFF = RING_BYTES + 256, SIDE_OFF = RING_BYTES + 1024  , LDS_BYTES = 147456;

__device__ __forceinline__ unsigned cvt_pk_bf16(float lo, float hi) { unsigned r; asm volatile("v_cvt_pk_bf16_f32 %0, %1, %2" : "=v"(r) : "v"(lo), "v"(hi)); return r; }
__device__ __forceinline__ float bf2f(unsigned short b) { return __uint_as_float(((unsigned)b) << 16); }
__device__ __forceinline__ void store8_bf16(bf16_t* p, f32x4 a, f32x4 b) {
    u32x4 w; w.x = cvt_pk_bf16(a[0], a[1]); w.y = cvt_pk_bf16(a[2], a[3]); w.z = cvt_pk_bf16(b[0], b[1]); w.w = cvt_pk_bf16(b[2], b[3]); *(u32x4*)p = w; }
__device__ __forceinline__ float silu_f(float v) { return v * __builtin_amdgcn_rcpf(1.0f + __builtin_amdgcn_exp2f(-v * LOG2E)); }
__device__ __forceinline__ f32x4 silu4(f32x4 v) { f32x4 o; o[0] = silu_f(v[0]); o[1] = silu_f(v[1]); o[2] = silu_f(v[2]); o[3] = silu_f(v[3]); return o; }
__device__ __forceinline__ float wave_sum(float v) {
#pragma unroll
    for (int o = 1; o < 64; o <<= 1) v += __shfl_xor(v, o);
    return v;
}
__device__ __forceinline__ float sum4(f32x4 a) { return (a[0] + a[1]) + (a[2] + a[3]); }
__device__ __forceinline__ float dot4(f32x4 a) { return (a[0] * a[0] + a[1] * a[1]) + (a[2] * a[2] + a[3] * a[3]); }

namespace pg8 {
constexpr int BM = 256, BK = 64, HALF = 128, HTB = HALF * BK * 2, STAGE_BYTES = 8 * HTB, NXCD = 8, WGM = 8;
__host__ __device__ __forceinline__ int lds_byte(int r, int c) { const int st = (r >> 4) * 2 + (c >> 5), rr = r & 15, cc = c & 31, ob = rr * 64 + cc * 2; return st * 1024 + (ob ^ (((ob >> 9) & 1) << 5)); }
__host__ __device__ __forceinline__ void stage_rc(int b, int& R, int& C) { const int st = b / 1024, sb = b % 1024, swz = sb ^ (((sb >> 9) & 1) << 5); R = (st >> 1) * 16 + swz / 64; C = (st & 1) * 32 + (swz % 64) / 2; }
__host__ __device__ __forceinline__ int perm32(int rho) { const int n = rho >> 4, i = rho & 15; return 8 * (i >> 2) + 4 * n + (i & 3); }

struct Unit { int pm, pn; };
struct Gemm { const bf16_t* A; const bf16_t* Bt; int M, N, K, lda; };

struct StaticOrder {
    int nM, nN, nwg, G, c;
    __host__ __device__ void init(int M, int N, int G_, int c_) { nM = M / BM; nN = N / BM; nwg = nM * nN; G = G_; c = c_; }
    __host__ __device__ bool next(int i, Unit& u) const {
        const long L = (long)i * G + c; if (L >= nwg) return false;
        int wgid = (int)L; { const int q = nwg / NXCD, r = nwg % NXCD, xcd = wgid % NXCD, off = wgid / NXCD; wgid = (xcd < r ? xcd * (q + 1) : r * (q + 1) + (xcd - r) * q) + off; }
        const int nig = WGM * nN, gid = wgid / nig, fm = gid * WGM, gsz = (nM - fm) < WGM ? (nM - fm) : WGM;
        u.pm = fm + ((wgid % nig) % gsz); u.pn = (wgid % nig) / gsz; return true;
    }
};

template <class Epi, bool ALIGN_EPI>
__device__ __forceinline__ void gemm_phase(LAS unsigned char* lds, const Gemm g, const StaticOrder& S, const Epi& E) {
    int tid_ = threadIdx.x; asm volatile("" : "+v"(tid_));
    const int tid = tid_, wid = __builtin_amdgcn_readfirstlane(tid >> 6), lane = tid & 63, wr = wid >> 2, wc = wid & 3, fr = lane & 15, fq = lane >> 4;
    const int K = g.K, nt = K / BK, lda = g.lda;
    unsigned voffA[2], voffB[2];
#pragma unroll
    for (int i = 0; i < 2; ++i) { int R, C; stage_rc(tid * 16 + i * 8192, R, C); const int Rb = Epi::PERM ? ((R & ~31) + perm32(R & 31)) : R;
        voffA[i] = (unsigned)(R * lda + C) * 2u; voffB[i] = (unsigned)(Rb * K + C) * 2u; }
    const size_t kstep = (size_t)(BK * 2);
    const size_t hstepA = (size_t)HALF * lda * 2, hstepB = (size_t)HALF * K * 2;
    const size_t tstepA = 2 * hstepA, tstepB = 2 * hstepB;
    const unsigned ldsw = (unsigned)wid * 1024u;
    const int aoff = lds_byte(wr * 64 + fr, fq * 8), boff = lds_byte(wc * 32 + fr, fq * 8);
#define PG8_SA(b, h) (((b) * 2 + (h)) * HTB)
#define PG8_SB(b, h) ((4 + (b) * 2 + (h)) * HTB)
#define PG8_STAGE(bufoff, gbase, voff) do { _Pragma("unroll") for (int _i = 0; _i < 2; ++_i) \
        __builtin_amdgcn_global_load_lds((const unsigned*)((const char*)(gbase) + (voff)[_i]), (LAS unsigned*)(lds + (bufoff) + ldsw + _i * 8192), 16, 0, 0); } while (0)
#define PG8_LDA(dst, b, h) do { _Pragma("unroll") for (int m = 0; m < 4; ++m) _Pragma("unroll") for (int k = 0; k < 2; ++k) dst[m][k] = *(const LAS bf16x8*)(lds + PG8_SA(b, h) + aoff + m * 2048 + k * 1024); } while (0)
#define PG8_LDB(dst, b, h) do { _Pragma("unroll") for (int n = 0; n < 2; ++n) _Pragma("unroll") for (int k = 0; k < 2; ++k) dst[n][k] = *(const LAS bf16x8*)(lds + PG8_SB(b, h) + boff + n * 2048 + k * 1024); } while (0)
#define PG8_MMA(ai, bj, At, Bt) do { __builtin_amdgcn_s_setprio(1); _Pragma("unroll") for (int m = 0; m < 4; ++m) _Pragma("unroll") for (int n = 0; n < 2; ++n) _Pragma("unroll") for (int k = 0; k < 2; ++k) \
        acc[ai][bj][m][n] = __builtin_amdgcn_mfma_f32_16x16x32_bf16(Bt[n][k], At[m][k], acc[ai][bj][m][n], 0, 0, 0); __builtin_amdgcn_s_setprio(0); } while (0)
#define PG8_WAIT_V(n) asm volatile("s_waitcnt vmcnt(" #n ")" ::: "memory")
#define PG8_WAIT_L(n) asm volatile("s_waitcnt lgkmcnt(" #n ")" ::: "memory")
#define PG8_BAR __builtin_amdgcn_s_barrier()
#define PG8_SCHED __builtin_amdgcn_sched_barrier(0)
    Unit cur, nxt; int ui = 0;
    if (!S.next(0, cur)) return;
    f32x4 acc[2][2][4][2];
#pragma unroll
    for (int a = 0; a < 2; ++a)
#pragma unroll
        for (int b = 0; b < 2; ++b)
#pragma unroll
            for (int m = 0; m < 4; ++m)
#pragma unroll
                for (int n = 0; n < 2; ++n) acc[a][b][m][n] = (f32x4){0.f, 0.f, 0.f, 0.f};
    bf16x8 At[4][2], B0[2][2], B1[2][2];
    const char* cA = (const char*)g.A + (size_t)cur.pm * tstepA; const char* cB = (const char*)g.Bt + (size_t)cur.pn * tstepB;
    PG8_STAGE(PG8_SB(0, 0), cB, voffB); PG8_STAGE(PG8_SB(0, 1), cB + hstepB, voffB); PG8_STAGE(PG8_SA(0, 0), cA, voffA); PG8_STAGE(PG8_SA(0, 1), cA + hstepA, voffA);
    if (wr == 1) PG8_BAR;
    PG8_WAIT_V(2); PG8_BAR;
    PG8_STAGE(PG8_SB(1, 0), cB + kstep, voffB); PG8_STAGE(PG8_SA(1, 0), cA + kstep, voffA); PG8_STAGE(PG8_SB(1, 1), cB + hstepB + kstep, voffB);
    PG8_WAIT_V(6); PG8_BAR;
    for (;;) {
        const bool has_next = S.next(ui + 1, nxt);
        const char* nA = has_next ? (const char*)g.A + (size_t)nxt.pm * tstepA : cA; const char* nB = has_next ? (const char*)g.Bt + (size_t)nxt.pn * tstepB : cB;
#pragma unroll 1
        for (int t = 0; t < nt; t += 2) {
            const bool last = (t == nt - 2);
            const char* a1 = cA + (size_t)(t + 1) * kstep;
            const char* a2 = last ? nA : cA + (size_t)(t + 2) * kstep; const char* b2 = last ? nB : cB + (size_t)(t + 2) * kstep;
            const char* a3 = a2 + kstep; const char* b3 = b2 + kstep;
            PG8_LDB(B0, 0, 0); PG8_LDB(B1, 0, 1); PG8_SCHED; PG8_LDA(At, 0, 0); PG8_STAGE(PG8_SA(1, 1), a1 + hstepA, voffA);
            PG8_WAIT_V(8); PG8_WAIT_L(0); PG8_BAR; PG8_MMA(0, 0, At, B0); PG8_MMA(0, 1, At, B1); PG8_BAR; PG8_SCHED;
            PG8_LDA(At, 0, 1); PG8_STAGE(PG8_SB(0, 0), b2, voffB); PG8_STAGE(PG8_SB(0, 1), b2 + hstepB, voffB); PG8_STAGE(PG8_SA(0, 0), a2, voffA);
            PG8_WAIT_V(8); PG8_WAIT_L(0); PG8_BAR; PG8_MMA(1, 0, At, B0); PG8_MMA(1, 1, At, B1); PG8_BAR; PG8_SCHED;
            PG8_LDB(B0, 1, 0); PG8_LDB(B1, 1, 1); PG8_SCHED; PG8_LDA(At, 1, 0); PG8_STAGE(PG8_SA(0, 1), a2 + hstepA, voffA);
            PG8_WAIT_V(8); PG8_WAIT_L(0); PG8_BAR; PG8_MMA(0, 0, At, B0); PG8_MMA(0, 1, At, B1); PG8_BAR; PG8_SCHED;
            PG8_LDA(At, 1, 1); PG8_STAGE(PG8_SB(1, 0), b3, voffB); PG8_STAGE(PG8_SB(1, 1), b3 + hstepB, voffB); PG8_STAGE(PG8_SA(1, 0), a3, voffA);
            PG8_WAIT_V(8); PG8_WAIT_L(0); PG8_BAR; PG8_MMA(1, 0, At, B0); PG8_MMA(1, 1, At, B1); PG8_BAR; PG8_SCHED;
        }
        if constexpr (ALIGN_EPI) { if (wr == 0) PG8_BAR; }
        E(acc, cur, wr, wc, fr, fq);
        if (!has_next) break;
#pragma unroll
        for (int a = 0; a < 2; ++a)
#pragma unroll
            for (int b = 0; b < 2; ++b)
#pragma unroll
                for (int m = 0; m < 4; ++m)
#pragma unroll
                    for (int n = 0; n < 2; ++n) acc[a][b][m][n] = (f32x4){0.f, 0.f, 0.f, 0.f};
        cur = nxt; cA = nA; cB = nB; ++ui;
        if constexpr (ALIGN_EPI) { if (wr == 1) PG8_BAR; }
    }
    PG8_WAIT_V(0);
    if constexpr (!ALIGN_EPI) { if (wr == 0) PG8_BAR; }
    PG8_BAR;
#undef PG8_SA
#undef PG8_SB
#undef PG8_STAGE
#undef PG8_LDA
#undef PG8_LDB
#undef PG8_MMA
#undef PG8_WAIT_V
#undef PG8_WAIT_L
#undef PG8_BAR
#undef PG8_SCHED
}
}

struct EpiA {
    static constexpr bool PERM = true;
    unsigned char* ws; LAS float* side;
    __device__ __forceinline__ void operator()(const f32x4 (&acc)[2][2][4][2], const pg8::Unit& u, int wr, int wc, int fr, int fq) const {
        const float* RSX = (const float*)(ws + WS_RSX);
        float rs[2][4];
#pragma unroll
        for (int ai = 0; ai < 2; ++ai)
#pragma unroll
            for (int m = 0; m < 4; ++m) rs[ai][m] = RSX[u.pm * 256 + ai * 128 + wr * 64 + m * 16 + fr];
        const int pn = u.pn, cw = wc * 32 + 8 * fq;
        bf16_t* dst; int pitch, coff, mode;
        if (pn < 2)       { dst = (bf16_t*)(ws + WS_QG);   pitch = 1536; coff = pn * 256;               mode = 1; }
        else if (pn < 4)  { dst = (bf16_t*)(ws + WS_FK);   pitch = 512;  coff = (pn - 2) * 256;         mode = 0; }
        else if (pn < 6)  { dst = (bf16_t*)(ws + WS_FV);   pitch = 512;  coff = (pn - 4) * 256;         mode = 0; }
        else if (pn < 8)  { dst = (bf16_t*)(ws + WS_GATE); pitch = 1536; coff = (pn - 6) * 256;         mode = 2; }
        else if (pn == 8) { dst = (bf16_t*)(ws + WS_QG);   pitch = 1536; coff = 512;                    mode = 0; }
        else if (pn == 9) { dst = (bf16_t*)(ws + WS_QG);   pitch = 1536; coff = 768;                    mode = 0; }
        else if (pn < 12) { dst = (bf16_t*)(ws + WS_GATE); pitch = 1536; coff = 512 + (pn - 10) * 256;  mode = 2; }
        else if (pn < 14) { dst = (bf16_t*)(ws + WS_QG);   pitch = 1536; coff = 1024 + (pn - 12) * 256; mode = 1; }
        else if (pn < 16) { dst = (bf16_t*)(ws + WS_BK);   pitch = 512;  coff = (pn - 14) * 256;        mode = 0; }
        else if (pn < 18) { dst = (bf16_t*)(ws + WS_BV);   pitch = 512;  coff = (pn - 16) * 256;        mode = 0; }
        else              { dst = (bf16_t*)(ws + WS_GATE); pitch = 1536; coff = 1024 + (pn - 18) * 256; mode = 2; }
        const float msc = (mode == 1) ? C2_64 : 1.0f;
#pragma unroll
        for (int ai = 0; ai < 2; ++ai)
#pragma unroll
            for (int m = 0; m < 4; ++m) { const int row = u.pm * 256 + ai * 128 + wr * 64 + m * 16 + fr; bf16_t* rowp = dst + (size_t)row * pitch + coff + cw; const float sc = rs[ai][m] * msc;
#pragma unroll
                for (int bj = 0; bj < 2; ++bj) { f32x4 v0 = acc[ai][bj][m][0] * sc, v1 = acc[ai][bj][m][1] * sc;
                    if (mode == 2) { v0 = silu4(v0); v1 = silu4(v1); }
                    store8_bf16(rowp + bj * 128, v0, v1); } }
        if (pn == 8 || pn == 9) {
#pragma unroll
            for (int ai = 0; ai < 2; ++ai)
#pragma unroll
                for (int m = 0; m < 4; ++m) { const int rl = ai * 128 + wr * 64 + m * 16 + fr; const float sc = rs[ai][m];
                    float s = dot4(acc[ai][0][m][0] * sc) + dot4(acc[ai][0][m][1] * sc);
                    if (pn == 8) s += dot4(acc[ai][1][m][0] * sc) + dot4(acc[ai][1][m][1] * sc);
                    s += __shfl_xor(s, 16); s += __shfl_xor(s, 32);
                    if (fq == 0) side[rl * 4 + wc] = s; }
            asm volatile("s_waitcnt lgkmcnt(0)" ::: "memory"); __builtin_amdgcn_s_barrier(); asm volatile("" ::: "memory");
            if (threadIdx.x < 256) { const int rl = threadIdx.x; const f32x4 v = *(const LAS f32x4*)(side + rl * 4);
                float* RS = (float*)(ws + (pn == 8 ? WS_RSCQ : WS_RSCKV)); RS[u.pm * 256 + rl] = rsqrtf(sum4(v) * (pn == 8 ? 1.0f / 256.0f : 1.0f / 128.0f) + EPS); }
        }
        if (pn == 9) {
            float* KRF = (float*)(ws + WS_KRF); float* FFL = (float*)(ws + WS_FFL);
#pragma unroll
            for (int ai = 0; ai < 2; ++ai)
#pragma unroll
                for (int m = 0; m < 4; ++m) { const int row = u.pm * 256 + ai * 128 + wr * 64 + m * 16 + fr; const float sc = rs[ai][m];
                    const f32x4 v0 = acc[ai][1][m][0] * sc, v1 = acc[ai][1][m][1] * sc;
                    if (wc < 2) { float* p = KRF + (size_t)row * 64 + cw; *(f32x4*)p = v0; *(f32x4*)(p + 4) = v1; }
                    else if (wc == 2 && fq == 0) { float* p = FFL + (size_t)row * 8; *(f32x4*)p = v0; *(f32x4*)(p + 4) = v1; } }
        }
        if (pn == 14 || pn == 15) {
            float* KP = (float*)(ws + WS_KPART) + ((size_t)(u.pm * 2 + wr)) * 512 + (pn - 14) * 256;
#pragma unroll
            for (int bj = 0; bj < 2; ++bj)
#pragma unroll
                for (int n = 0; n < 2; ++n) { f32x4 s = (f32x4){0.f, 0.f, 0.f, 0.f};
#pragma unroll
                    for (int ai = 0; ai < 2; ++ai)
#pragma unroll
                        for (int m = 0; m < 4; ++m) s += acc[ai][bj][m][n] * rs[ai][m];
#pragma unroll
                    for (int o = 1; o < 16; o <<= 1) { s[0] += __shfl_xor(s[0], o); s[1] += __shfl_xor(s[1], o); s[2] += __shfl_xor(s[2], o); s[3] += __shfl_xor(s[3], o); }
                    if (fr == 0) *(f32x4*)(KP + bj * 128 + cw + 4 * n) = s; }
        }
    }
};

struct EpiQ {
    static constexpr bool PERM = true;
    unsigned char* ws;
    __device__ __forceinline__ void operator()(const f32x4 (&acc)[2][2][4][2], const pg8::Unit& u, int wr, int wc, int fr, int fq) const {
        const float* RS = (const float*)(ws + WS_RSCQ); bf16_t* QM = (bf16_t*)(ws + WS_QM);
        const float* COS = (const float*)(ws + WS_ROPE); const float* SIN = COS + SEQ * 32;
        const int pn = u.pn, cw = wc * 32 + 8 * fq;
#pragma unroll
        for (int ai = 0; ai < 2; ++ai)
#pragma unroll
            for (int m = 0; m < 4; ++m) { const int row = u.pm * 256 + ai * 128 + wr * 64 + m * 16 + fr;
                const float sc = RS[row] * C2_192;
                if (pn < 2) {
#pragma unroll
                    for (int bj = 0; bj < 2; ++bj) { const int head = pn * 2 + bj; store8_bf16(QM + (size_t)row * 768 + head * 192 + cw, acc[ai][bj][m][0] * sc, acc[ai][bj][m][1] * sc); }
                } else {
                    const int tpos = row & (SEQ - 1); const float* cp = COS + (size_t)tpos * 32 + 8 * fq; const float* sp = SIN + (size_t)tpos * 32 + 8 * fq;
                    const f32x4 c0 = *(const f32x4*)cp, c1 = *(const f32x4*)(cp + 4), s0 = *(const f32x4*)sp, s1 = *(const f32x4*)(sp + 4);
                    const f32x4 x10 = acc[ai][0][m][0] * sc, x11 = acc[ai][0][m][1] * sc, x20 = acc[ai][1][m][0] * sc, x21 = acc[ai][1][m][1] * sc;
                    bf16_t* p = QM + (size_t)row * 768 + wc * 192 + 128 + 8 * fq;
                    store8_bf16(p, x10 * c0 - x20 * s0, x11 * c1 - x21 * s1);
                    store8_bf16(p + 32, x20 * c0 + x10 * s0, x21 * c1 + x11 * s1);
                    if (m & 1) asm volatile("" ::: "memory");
                } }
    }
};
struct EpiKV {
    static constexpr bool PERM = true;
    unsigned char* ws;
    __device__ __forceinline__ void operator()(const f32x4 (&acc)[2][2][4][2], const pg8::Unit& u, int wr, int wc, int fr, int fq) const {
        const float* RS = (const float*)(ws + WS_RSCKV);
        const int pn = u.pn, cw = wc * 32 + 8 * fq;
        bf16_t* base = (pn < 2) ? (bf16_t*)(ws + WS_KM) + (pn * 2) * 192 + cw : (bf16_t*)(ws + WS_VM) + (pn - 2) * 256 + cw;
        const int pitch = (pn < 2) ? 768 : 512, bjs = (pn < 2) ? 192 : 128;
#pragma unroll
        for (int ai = 0; ai < 2; ++ai)
#pragma unroll
            for (int m = 0; m < 4; ++m) { const int row = u.pm * 256 + ai * 128 + wr * 64 + m * 16 + fr; const float sc = RS[row]; bf16_t* rowp = base + (size_t)row * pitch;
#pragma unroll
                for (int bj = 0; bj < 2; ++bj) store8_bf16(rowp + bj * bjs, acc[ai][bj][m][0] * sc, acc[ai][bj][m][1] * sc); }
    }
};
struct EpiC {
    static constexpr bool PERM = false;
    const float* xin; float* xout; unsigned char* ws; int last;
    __device__ __forceinline__ void operator()(const f32x4 (&acc)[2][2][4][2], const pg8::Unit& u, int wr, int wc, int fr, int fq) const {
        bf16_t* XB = (bf16_t*)(ws + WS_XB); float* SSX = (float*)(ws + WS_SSX);
#pragma unroll
        for (int ai = 0; ai < 2; ++ai)
#pragma unroll
            for (int m = 0; m < 4; ++m) { const int row = u.pm * 256 + ai * 128 + wr * 64 + m * 16 + fr; const size_t off = (size_t)row * DM + u.pn * 256 + wc * 32 + 4 * fq; float ss = 0.f;
#pragma unroll
                for (int bj = 0; bj < 2; ++bj)
#pragma unroll
                    for (int n = 0; n < 2; ++n) { const size_t o = off + bj * 128 + n * 16; const f32x4 v = acc[ai][bj][m][n] + *(const f32x4*)(xin + o); *(f32x4*)(xout + o) = v; ss += dot4(v);
                        if (!last) { u32x2 w; w.x = cvt_pk_bf16(v[0], v[1]); w.y = cvt_pk_bf16(v[2], v[3]); *(u32x2*)(XB + o) = w; } }
                if (!last) { ss += __shfl_xor(ss, 16); ss += __shfl_xor(ss, 32); if (fq == 0) SSX[(size_t)row * 16 + u.pn * 4 + wc] = ss; } }
    }
};

#define SBAR() __builtin_amdgcn_sched_barrier(0)
__device__ __forceinline__ int crow(int r, int hi) { return (r & 3) + 8 * (r >> 2) + 4 * hi; }
template <int OFF> __device__ __forceinline__ s16x4 tr_read(int vb) { s16x4 r; asm volatile("ds_read_b64_tr_b16 %0, %1 offset:%2" : "=&v"(r) : "v"(vb), "i"(OFF) : "memory"); return r; }
__device__ __forceinline__ int v_rd_base(int lane) { return ((lane & 3) << 3) | (((lane >> 2) & 3) << 6) | (((lane >> 4) & 1) << 5) | (((lane >> 5) & 1) << 8); }
template <int NCB> __device__ __forceinline__ int v_st(int k, int c) { const int kk = (k & ~0xC) | ((k & 4) << 1) | ((k & 8) >> 1); return ((kk >> 3) * NCB + (c >> 5)) * 512 + ((kk & 7) * 32 + (c & 31)) * 2; }
template <int NCB, int D0> __device__ __forceinline__ void pv_one(f32x16& od, int vb, bf16x8 pa0, bf16x8 pa1, bf16x8 pa2, bf16x8 pa3) {
#define VOFF(ks, half) (((2 * (ks) + (half)) * NCB + D0) * 512)
    const s16x4 l0 = tr_read<VOFF(0, 0)>(vb), h0 = tr_read<VOFF(0, 1)>(vb), l1 = tr_read<VOFF(1, 0)>(vb), h1 = tr_read<VOFF(1, 1)>(vb);
    const s16x4 l2 = tr_read<VOFF(2, 0)>(vb), h2 = tr_read<VOFF(2, 1)>(vb), l3 = tr_read<VOFF(3, 0)>(vb), h3 = tr_read<VOFF(3, 1)>(vb);
#undef VOFF
    asm volatile("s_waitcnt lgkmcnt(0)" ::: "memory"); SBAR();
#define PK(L, H) (bf16x8){L[0], L[1], L[2], L[3], H[0], H[1], H[2], H[3]}
    od = __builtin_amdgcn_mfma_f32_32x32x16_bf16(pa0, PK(l0, h0), od, 0, 0, 0);
    od = __builtin_amdgcn_mfma_f32_32x32x16_bf16(pa1, PK(l1, h1), od, 0, 0, 0);
    od = __builtin_amdgcn_mfma_f32_32x32x16_bf16(pa2, PK(l2, h2), od, 0, 0, 0);
    od = __builtin_amdgcn_mfma_f32_32x32x16_bf16(pa3, PK(l3, h3), od, 0, 0, 0);
#undef PK
}
struct AttnP {
    const bf16_t* Q; int ldq;
    const bf16_t* K; int ldk;
    const bf16_t* V; int ldv;
    bf16_t* O; int ldo;
    const bf16_t* G; int ldg;
    float* SSQ; int nh;
    const float* bias;
    const unsigned* sel;
};
template <int DK, int DV, int MODE>
__device__ __forceinline__ void attn_unit(const AttnP& P, int b, int h, int qb, char* lds) {
    constexpr int NKL = DK / 64, NVL = DV / 64, NCB = DV / 32, ND0 = DK / 16, KB = 64 * DK * 2, VB = 64 * DV * 2;
    constexpr float THR = 8.0f;
    int tid_ = threadIdx.x; asm volatile("" : "+v"(tid_));
    const int tid = tid_, lane = tid & 63, r32 = lane & 31, hi = lane >> 5; const int wid = __builtin_amdgcn_readfirstlane(tid >> 6);
    char* Kl = lds; char* Vl = lds + 2 * KB; float* wsf = (float*)(lds + 2 * KB + 2 * VB) + wid * 64;
    const int q0 = qb * 256; const size_t row0 = (size_t)b * SEQ;
    const int qrow = q0 + wid * 32 + r32;
    const int qlast = q0 + wid * 32 + 31;
    bf16x8 qr[ND0];
    { const bf16_t* Qw = P.Q + (row0 + qrow) * P.ldq + h * DK + hi * 8;
#pragma unroll
      for (int d0 = 0; d0 < ND0; ++d0) qr[d0] = *(const bf16x8*)(Qw + d0 * 16); }
    const int sr = tid >> 3, sc = (tid & 7) * 8;
    const bf16_t* Kg = P.K + (row0 + sr) * P.ldk + h * DK + sc;
    const bf16_t* Vg = P.V + (row0 + sr) * P.ldv + h * DV + sc;
    const int vb0 = (int)(uintptr_t)Vl + v_rd_base(lane);
    const int NT = 4 * (qb + 1);
    unsigned selw = 0u; float alpha_b = 0.f;
    if (MODE == 2) { selw = P.sel[(row0 + qrow) * 8 + h]; alpha_b = LOG2E * __builtin_amdgcn_exp2f(-(float)(h + 1)); }
    const float* biasp = (MODE == 0) ? P.bias + (size_t)(b * 8 + h) * SEQ + 4 * hi : nullptr;
#define KEY0(j) ((MODE == 2) ? (((j) < 4) ? q0 + 64 * (j) : 64 * ((j) - 4)) : 64 * (j))
    bf16x8 ks[NKL], vs[NVL];
#define SLOAD(k0) do { _Pragma("unroll") for (int i_ = 0; i_ < NKL; ++i_) ks[i_] = *(const bf16x8*)(Kg + (size_t)(k0) * P.ldk + 64 * i_); \
                       _Pragma("unroll") for (int i_ = 0; i_ < NVL; ++i_) vs[i_] = *(const bf16x8*)(Vg + (size_t)(k0) * P.ldv + 64 * i_); } while (0)
#define SWRITE(bsel) do { _Pragma("unroll") for (int i_ = 0; i_ < NKL; ++i_) *(bf16x8*)(Kl + (bsel) * KB + sr * (DK * 2) + ((((sc + 64 * i_) * 2)) ^ ((sr & 7) << 4))) = ks[i_]; \
                          _Pragma("unroll") for (int i_ = 0; i_ < NVL; ++i_) *(bf16x8*)(Vl + (bsel) * VB + v_st<NCB>(sr, sc + 64 * i_)) = vs[i_]; } while (0)
    float m_reg = -1e30f, l_reg = 0.f; f32x16 o[NCB];
#pragma unroll
    for (int d = 0; d < NCB; ++d) o[d] = f32x16{};
    SLOAD(KEY0(0)); SWRITE(0);
    for (int j = 0; j < NT; ++j) {
        __syncthreads();
        const int key0 = KEY0(j); const int bsel = j & 1;
        if (j + 1 < NT) SLOAD(KEY0(j + 1));
        bool active = true;
        if (MODE == 2 && j >= 4) { active = __any((int)((selw >> ((j - 4) >> 2)) & 1u)); }
        else { active = key0 <= qlast; }
        if (active) {
            f32x16 p0 = f32x16{}, p1 = f32x16{};
            const char* Kb = Kl + bsel * KB;
#pragma unroll
            for (int d0 = 0; d0 < ND0; ++d0) { const int cb = (d0 * 16 + hi * 8) * 2;
                const bf16x8 b0 = *(const bf16x8*)(Kb + r32 * (DK * 2) + (cb ^ ((r32 & 7) << 4)));
                const bf16x8 b1 = *(const bf16x8*)(Kb + (32 + r32) * (DK * 2) + (cb ^ ((r32 & 7) << 4)));
                p0 = __builtin_amdgcn_mfma_f32_32x32x16_bf16(b0, qr[d0], p0, 0, 0, 0);
                p1 = __builtin_amdgcn_mfma_f32_32x32x16_bf16(b1, qr[d0], p1, 0, 0, 0); }
            if (MODE == 0) {
#pragma unroll
                for (int g = 0; g < 4; ++g) { const f32x4 b0 = *(const f32x4*)(biasp + key0 + 8 * g), b1 = *(const f32x4*)(biasp + key0 + 32 + 8 * g);
#pragma unroll
                    for (int i = 0; i < 4; ++i) { p0[4 * g + i] += b0[i]; p1[4 * g + i] += b1[i]; } }
            }
            if (MODE == 2) { const float kb = (float)(key0 - q0 + 4 * hi);
#pragma unroll
                for (int r = 0; r < 16; ++r) { const float kk = kb + (float)((r & 3) + 8 * (r >> 2)); p0[r] = __builtin_fmaf(alpha_b, kk, p0[r]); p1[r] = __builtin_fmaf(alpha_b, kk + 32.0f, p1[r]); } }
            if (MODE == 2 && j >= 4) { if (!((selw >> ((j - 4) >> 2)) & 1u)) {
#pragma unroll
                for (int r = 0; r < 16; ++r) { p0[r] = -INFINITY; p1[r] = -INFINITY; } } }
            else if (key0 + 63 > q0 + wid * 32) { const int kb = key0 + 4 * hi;
#pragma unroll
                for (int r = 0; r < 16; ++r) { const int kv = kb + (r & 3) + 8 * (r >> 2); if (kv > qrow) p0[r] = -INFINITY; if (kv + 32 > qrow) p1[r] = -INFINITY; } }
            float pmax = p0[0];
#pragma unroll
            for (int r = 1; r < 16; ++r) pmax = fmaxf(pmax, p0[r]);
#pragma unroll
            for (int r = 0; r < 16; ++r) pmax = fmaxf(pmax, p1[r]);
            { auto rr = __builtin_amdgcn_permlane32_swap(__float_as_uint(pmax), __float_as_uint(pmax), false, false); pmax = fmaxf(__uint_as_float(rr[0]), __uint_as_float(rr[1])); }
            if (!__all(pmax - m_reg <= THR)) {
                const float mn = fmaxf(m_reg, pmax); const float al = __builtin_amdgcn_exp2f(m_reg - mn); m_reg = mn; l_reg *= al;
                if (hi == 0) wsf[r32] = al; asm volatile("s_waitcnt lgkmcnt(0)" ::: "memory");
#pragma unroll
                for (int r = 0; r < 16; ++r) { const float a = wsf[crow(r, hi)];
#pragma unroll
                    for (int d = 0; d < NCB; ++d) o[d][r] *= a; }
            }
            float ps = 0.f;
#pragma unroll
            for (int r = 0; r < 16; ++r) { p0[r] = __builtin_amdgcn_exp2f(p0[r] - m_reg); p1[r] = __builtin_amdgcn_exp2f(p1[r] - m_reg); ps += p0[r] + p1[r]; }
            { auto rr = __builtin_amdgcn_permlane32_swap(__float_as_uint(ps), __float_as_uint(ps), false, false); ps = __uint_as_float(rr[0]) + __uint_as_float(rr[1]); }
            l_reg += ps;
            bf16x8 pa0, pa1, pa2, pa3;
#define PK4(Pv, BASE, OUT) do { unsigned a0 = cvt_pk_bf16(Pv[BASE + 0], Pv[BASE + 1]), a1 = cvt_pk_bf16(Pv[BASE + 2], Pv[BASE + 3]); \
    unsigned b0_ = cvt_pk_bf16(Pv[BASE + 4], Pv[BASE + 5]), b1_ = cvt_pk_bf16(Pv[BASE + 6], Pv[BASE + 7]); \
    auto r0 = __builtin_amdgcn_permlane32_swap(a0, b0_, false, false); auto r1 = __builtin_amdgcn_permlane32_swap(a1, b1_, false, false); \
    u32x4 w = {r0[0], r1[0], r0[1], r1[1]}; OUT = *reinterpret_cast<bf16x8*>(&w); } while (0)
            PK4(p0, 0, pa0); PK4(p0, 8, pa1); PK4(p1, 0, pa2); PK4(p1, 8, pa3);
#undef PK4
            const int vb = vb0 + bsel * VB;
            pv_one<NCB, 0>(o[0], vb, pa0, pa1, pa2, pa3); pv_one<NCB, 1>(o[1], vb, pa0, pa1, pa2, pa3);
            if constexpr (NCB == 4) { pv_one<NCB, 2>(o[2], vb, pa0, pa1, pa2, pa3); pv_one<NCB, 3>(o[3], vb, pa0, pa1, pa2, pa3); }
        }
        if (j + 1 < NT) SWRITE((j + 1) & 1);
    }
    if (hi == 0) wsf[32 + r32] = l_reg; asm volatile("s_waitcnt lgkmcnt(0)" ::: "memory");
    const size_t orow0 = row0 + q0 + wid * 32;
#pragma unroll
    for (int r = 0; r < 16; ++r) { const int orow = crow(r, hi); const float rl = __builtin_amdgcn_rcpf(wsf[32 + orow]); float ss = 0.f;
        float y[NCB];
#pragma unroll
        for (int d = 0; d < NCB; ++d) { y[d] = o[d][r] * rl; ss += y[d] * y[d]; }
#pragma unroll
        for (int sh = 1; sh < 32; sh <<= 1) ss += __shfl_xor(ss, sh);
        if (r32 == 0) P.SSQ[(orow0 + orow) * P.nh + h] = ss;
#pragma unroll
        for (int d = 0; d < NCB; ++d) { const size_t gi = (orow0 + orow) * P.ldg + h * DV + d * 32 + r32; const float gt = bf2f(P.G[gi]);
            const size_t oi = (orow0 + orow) * P.ldo + h * DV + d * 32 + r32; P.O[oi] = (bf16_t)(cvt_pk_bf16(y[d] * gt, 0.f) & 0xffffu); } }
    __syncthreads();
#undef KEY0
#undef SLOAD
#undef SWRITE
}


#define XB_TMO      128
#define XB_XCNT(j)  (256  + 64 * (j))
#define XB_XSUB(j)  (1280 + 64 * (j))
#define XB_XGEN(j)  (2304 + 64 * (j))
#define XB_TOP      3328
#define XB_TOPGEN   3392
#define XCD_BAR_WORDS 3456
#define XB_SPIN_CAP (1u << 18)
__device__ __forceinline__ unsigned xb_ld(unsigned* p)              { return __hip_atomic_load(p, __ATOMIC_RELAXED, __HIP_MEMORY_SCOPE_AGENT); }
__device__ __forceinline__ unsigned xb_add(unsigned* p, unsigned v) { return __hip_atomic_fetch_add(p, v, __ATOMIC_RELAXED, __HIP_MEMORY_SCOPE_AGENT); }
__device__ __forceinline__ unsigned xb_xcc_id() { return (unsigned)__builtin_amdgcn_s_getreg((3 << 11) | 20) & 0xFu; }
#define XB_SPIN(cond, bar) do { unsigned _sp = 0; while (cond) { __builtin_amdgcn_s_sleep(1); \
    if ((++_sp & 255u) == 0u) { if (xb_ld(&(bar)[XB_TMO])) break; if (_sp > XB_SPIN_CAP) { atomicAdd(&(bar)[XB_TMO], 1u); break; } } } } while (0)
struct XcdBarrier { unsigned* bar; unsigned x; volatile LAS unsigned* st; };
__device__ __forceinline__ XcdBarrier xcd_barrier_post(unsigned* bar, volatile LAS unsigned* st) {
    XcdBarrier b; b.bar = bar; b.x = xb_xcc_id(); b.st = st;
    if (threadIdx.x == 0) (void)xb_add(&bar[XB_XCNT(b.x)], 1u);
    return b;
}
__device__ __forceinline__ void xcd_barrier_complete(unsigned* bar, unsigned x, unsigned& nloc, unsigned& nx) {
    const unsigned G = gridDim.x * gridDim.y * gridDim.z;
    unsigned sum, cnt, mine, sp = 0u;
    for (;;) {
        sum = 0u; cnt = 0u; mine = 0u;
#pragma unroll
        for (unsigned j = 0; j < 16; ++j) { const unsigned c = xb_ld(&bar[XB_XCNT(j)]); sum += c; cnt += (c > 0u) ? 1u : 0u; mine = (j == x) ? c : mine; }
        if (sum == G) break;
        __builtin_amdgcn_s_sleep(1);
        if ((++sp & 255u) == 0u) { if (xb_ld(&bar[XB_TMO])) break; if (sp > XB_SPIN_CAP) { atomicAdd(&bar[XB_TMO], 1u); break; } }
    }
    nloc = mine > 0u ? mine : 1u; nx = cnt > 0u ? cnt : 1u;
}
__device__ __forceinline__ void xcd_barrier(const XcdBarrier& b) {
    asm volatile("s_waitcnt vmcnt(0)" ::: "memory");
    __syncthreads();
    if (threadIdx.x == 0) {
        unsigned* bar = b.bar;
        __builtin_amdgcn_s_waitcnt(0);
        unsigned nloc = b.st[0], nx = b.st[1];
        if (nloc == 0u) { xcd_barrier_complete(bar, b.x, nloc, nx); b.st[0] = nloc; b.st[1] = nx; }
        const unsigned old = xb_add(&bar[XB_XSUB(b.x)], 1u);
        const unsigned gen = old / nloc;
        if (old + 1u == (gen + 1u) * nloc) {
            __builtin_amdgcn_fence(__ATOMIC_RELEASE, "agent");
            asm volatile("s_waitcnt vmcnt(0)" ::: "memory");
            const unsigned og = xb_add(&bar[XB_TOP], 1u);
            const unsigned tg = og / nx;
            if (og + 1u == (tg + 1u) * nx) xb_add(&bar[XB_TOPGEN], 1u);
            else XB_SPIN(xb_ld(&bar[XB_TOPGEN]) == tg, bar);
            __builtin_amdgcn_fence(__ATOMIC_ACQUIRE, "agent");
            xb_add(&bar[XB_XGEN(b.x)], 1u);
            asm volatile("s_waitcnt vmcnt(0)" ::: "memory");
        } else {
            XB_SPIN(xb_ld(&bar[XB_XGEN(b.x)]) == gen, bar);
            __builtin_amdgcn_fence(__ATOMIC_ACQUIRE, "agent");
            asm volatile("s_waitcnt vmcnt(0)" ::: "memory");
        }
    }
    __syncthreads();
}
constexpr int CW_BAR = 4096;

struct UTab { unsigned short v[2560]; };
constexpr UTab make_utab() {
    UTab t{}; int k = 0;
    for (int c = 80; c >= 1; --c) {
        if (c % 5 == 0 && c / 5 <= 16) { const int qb = c / 5 - 1; for (int b = 0; b < 8; ++b) for (int h = 0; h < 4; ++h) t.v[k++] = (unsigned short)((1 << 12) | (b << 8) | (h << 4) | qb); }
        if (c % 2 == 0 && c / 2 <= 16) { const int qb = c / 2 - 1; for (int ty = 0; ty <= 2; ty += 2) for (int b = 0; b < 8; ++b) for (int h = 0; h < 8; ++h) t.v[k++] = (unsigned short)((ty << 12) | (b << 8) | (h << 4) | qb); }
    }
    return t;
}
__device__ const UTab g_utab = make_utab();
constexpr int N_ATT_UNITS = 2560;

struct Args { const float* in[11]; float* out; unsigned char* ws; int ph_lo, ph_hi, coop, pad; };
#ifndef PHM
#define PHM 127
#endif
#ifndef B1M
#define B1M 31
#endif
constexpr int NPHASES = 13;

__device__ __forceinline__ int src_in(int n) {
    const int t = n >> 8, j = n & 255;
    if (t < 6) return n;
    if (t < 8) return 1544 + (n - 1536);
    if (t == 8) return 2056 + j;
    if (t == 9) return j < 128 ? 2312 + j : (j < 192 ? 2440 + (j - 128) : (j < 200 ? 1536 + (j - 192) : -1));
    if (t < 12) return 2504 + (n - 2560);
    return 3016 + (n - 3072);
}
__device__ __forceinline__ int src_uq(int n) {
    if (n < 512) return (n >> 7) * 192 + (n & 127);
    const int p = n - 512; return p < 128 ? (p >> 5) * 192 + 128 + (p & 31) : ((p - 128) >> 5) * 192 + 160 + ((p - 128) & 31);
}
__device__ __forceinline__ int src_ukv(int n) {
    return n < 512 ? (n >> 7) * 256 + (n & 127) : ((n - 512) >> 7) * 256 + 128 + ((n - 512) & 127);
}
__device__ __forceinline__ void transpose_item(const float* W, int Ksrc, int Nsrc, const float* gain, bf16_t* WT, int Kdst, int mat, LAS float* scr, int kb, int nb, int lane) {
    const int k0 = 64 * kb, n0 = 32 * nb; const int nn = n0 + (lane & 31);
    const int sc = (mat == 0) ? src_in(nn) : (mat == 1) ? src_uq(nn) : (mat == 2) ? src_ukv(nn) : nn;
#pragma unroll 8
    for (int i = 0; i < 32; ++i) { const int kk = 2 * i + (lane >> 5); const int k = k0 + kk;
        float v = 0.f; if (sc >= 0 && k < Ksrc) v = W[(size_t)k * Nsrc + sc] * gain[k];
        scr[kk * 33 + (lane & 31)] = v; }
    asm volatile("s_waitcnt lgkmcnt(0)" ::: "memory");
    const int c = lane & 7;
#pragma unroll
    for (int j = 0; j < 4; ++j) { const int n = (lane >> 3) + 8 * j; const LAS float* s = scr + (8 * c) * 33 + n;
        u32x4 o; o.x = cvt_pk_bf16(s[0 * 33], s[1 * 33]); o.y = cvt_pk_bf16(s[2 * 33], s[3 * 33]); o.z = cvt_pk_bf16(s[4 * 33], s[5 * 33]); o.w = cvt_pk_bf16(s[6 * 33], s[7 * 33]);
        *(u32x4*)(WT + (size_t)(n0 + n) * Kdst + k0 + 8 * c) = o; }
    asm volatile("s_waitcnt lgkmcnt(0)" ::: "memory");
}

__device__ __forceinline__ float log_sigmoid_f(float x) { return fminf(x, 0.f) - log1pf(expf(-fabsf(x))); }

__device__ __forceinline__ void phase_p0(const Args& args, const int layer, LAS unsigned char* lds, unsigned char* lds_raw, const int G, const int bid) {
    unsigned char* ws = args.ws; asm volatile("" : "+s"(ws));
    int tid = threadIdx.x; asm volatile("" : "+v"(tid));
    const int lane = tid & 63, wave = __builtin_amdgcn_readfirstlane(tid >> 6);
    const int gw = bid * NWAVES + wave, NGW = G * NWAVES;
    unsigned char* wl = ws + WS_W + (size_t)layer * W_LAYER;
    (void)lane; (void)gw; (void)NGW; (void)wl; (void)lds_raw;
            LAS float* scr = (LAS float*)(lds + wave * 16384);
            constexpr int I_IN = 16 * 160, I_UQ = 4 * 24, I_UKV = 4 * 32, I_OUT = 24 * 32, I_L = I_IN + I_UQ + I_UKV + I_OUT;
            for (int it = gw; it < 2 * I_L; it += NGW) {
                const int l = it / I_L; int r = it % I_L; unsigned char* w = ws + WS_W + (size_t)l * W_LAYER;
                if (r < I_IN) { transpose_item(args.in[2] + (size_t)l * DM * D_IN, DM, D_IN, args.in[1] + l * DM, (bf16_t*)(w + W_IN_OFF), DM, 0, scr, r / 160, r % 160, lane); continue; } r -= I_IN;
                if (r < I_UQ) { transpose_item(args.in[5] + (size_t)l * 256 * 768, 256, 768, args.in[4] + l * 256, (bf16_t*)(w + W_UQ_OFF), 256, 1, scr, r / 24, r % 24, lane); continue; } r -= I_UQ;
                if (r < I_UKV) { transpose_item(args.in[7] + (size_t)l * 128 * 1024, 128, 1024, args.in[6] + l * 128, (bf16_t*)(w + W_UKV_OFF), 256, 2, scr, r / 32, r % 32, lane); continue; } r -= I_UKV;
                transpose_item(args.in[9] + (size_t)l * DMIX * DM, DMIX, DM, args.in[8] + l * DMIX, (bf16_t*)(w + W_OUT_OFF), DMIX, 3, scr, r / 32, r % 32, lane);
            }
            { const float* x = args.in[0]; bf16_t* XB = (bf16_t*)(ws + WS_XB); float* RSX = (float*)(ws + WS_RSX);
              for (int m = gw; m < T; m += NGW) { const f32x4* xr = (const f32x4*)(x + (size_t)m * DM) + lane; f32x4 v[4]; float s = 0.f;
#pragma unroll
                  for (int j = 0; j < 4; ++j) { v[j] = xr[64 * j]; s += dot4(v[j]); }
                  s = wave_sum(s);
                  u32x2* o8 = (u32x2*)(XB + (size_t)m * DM) + lane;
#pragma unroll
                  for (int j = 0; j < 4; ++j) { u32x2 w; w.x = cvt_pk_bf16(v[j][0], v[j][1]); w.y = cvt_pk_bf16(v[j][2], v[j][3]); o8[64 * j] = w; }
                  if (lane == 0) RSX[m] = rsqrtf(s * (1.0f / 1024.0f) + EPS); } }
            { float* COS = (float*)(ws + WS_ROPE); float* SIN = COS + SEQ * 32;
              for (int i = bid * NTHREADS + tid; i < SEQ * 32; i += G * NTHREADS) { const int t = i >> 5, f = i & 31;
                  const float inv = powf(10000.0f, -(float)(2 * f) / 64.0f); const float ang = (float)t * inv;
                  COS[i] = (float)cos((double)ang); SIN[i] = (float)sin((double)ang); } }
}

__device__ __forceinline__ void phase_a(const Args& args, const int layer, LAS unsigned char* lds, unsigned char* lds_raw, const int G, const int bid) {
    unsigned char* ws = args.ws; asm volatile("" : "+s"(ws));
    int tid = threadIdx.x; asm volatile("" : "+v"(tid));
    const int lane = tid & 63, wave = __builtin_amdgcn_readfirstlane(tid >> 6);
    const int gw = bid * NWAVES + wave, NGW = G * NWAVES;
    unsigned char* wl = ws + WS_W + (size_t)layer * W_LAYER;
    (void)lane; (void)gw; (void)NGW; (void)wl; (void)lds_raw;
            pg8::Gemm g{(const bf16_t*)(ws + WS_XB), (const bf16_t*)(wl + W_IN_OFF), T, NIN, DM, DM}; pg8::StaticOrder S; S.init(T, NIN, G, bid);
            EpiA E{ws, (LAS float*)(lds + SIDE_OFF)};
            pg8::gemm_phase<EpiA, true>(lds, g, S, E);
}

__device__ __forceinline__ void phase_b1(const Args& args, const int layer, LAS unsigned char* lds, unsigned char* lds_raw, const int G, const int bid) {
    unsigned char* ws = args.ws; asm volatile("" : "+s"(ws));
    int tid = threadIdx.x; asm volatile("" : "+v"(tid));
    const int lane = tid & 63, wave = __builtin_amdgcn_readfirstlane(tid >> 6);
    const int gw = bid * NWAVES + wave, NGW = G * NWAVES;
    unsigned char* wl = ws + WS_W + (size_t)layer * W_LAYER;
    (void)lane; (void)gw; (void)NGW; (void)wl; (void)lds_raw;
            if (B1M & 1) { pg8::Gemm g{(const bf16_t*)(ws + WS_QG) + 512, (const bf16_t*)(wl + W_UQ_OFF), T, 768, 256, 1536}; pg8::StaticOrder S; S.init(T, 768, G, bid);
              EpiQ E{ws}; pg8::gemm_phase<EpiQ, true>(lds, g, S, E); }
            if (B1M & 2) { pg8::Gemm g{(const bf16_t*)(ws + WS_QG) + 768, (const bf16_t*)(wl + W_UKV_OFF), T, 1024, 256, 1536}; pg8::StaticOrder S; S.init(T, 1024, G, bid);
              EpiKV E{ws}; pg8::gemm_phase<EpiKV, true>(lds, g, S, E); }
            if (B1M & 4) { const float* KRF = (const float*)(ws + WS_KRF); bf16_t* KM = (bf16_t*)(ws + WS_KM); const float* COS = (const float*)(ws + WS_ROPE); const float* SIN = COS + SEQ * 32;
              for (int i = bid * NTHREADS + tid; i < T * 8; i += G * NTHREADS) { const int t = i >> 3, c4 = (i & 7) * 4; const int tp = t & (SEQ - 1);
                  const f32x4 x1 = *(const f32x4*)(KRF + (size_t)t * 64 + c4), x2 = *(const f32x4*)(KRF + (size_t)t * 64 + 32 + c4);
                  const f32x4 c = *(const f32x4*)(COS + tp * 32 + c4), s = *(const f32x4*)(SIN + tp * 32 + c4);
                  const f32x4 o1 = x1 * c - x2 * s, o2 = x2 * c + x1 * s;
                  u32x2 w1, w2; w1.x = cvt_pk_bf16(o1[0], o1[1]); w1.y = cvt_pk_bf16(o1[2], o1[3]); w2.x = cvt_pk_bf16(o2[0], o2[1]); w2.y = cvt_pk_bf16(o2[2], o2[3]);
#pragma unroll
                  for (int hh = 0; hh < 4; ++hh) { bf16_t* p = KM + (size_t)t * 768 + hh * 192 + 128 + c4; *(u32x2*)p = w1; *(u32x2*)(p + 32) = w2; } } }
            if (B1M & 8) { const float* FFL = (const float*)(ws + WS_FFL); float* BF = (float*)(ws + WS_BIASF); const float* bfp = args.in[3] + layer * 8;
              for (int sq = gw; sq < 64; sq += NGW) { const int b = sq >> 3, h = sq & 7; const float bb = bfp[h];
                  const float* src = FFL + ((size_t)b * SEQ + lane * 64) * 8 + h; float tot = 0.f;
                  for (int i = 0; i < 64; ++i) tot += log_sigmoid_f(src[(size_t)i * 8] + bb);
                  float incl = tot;
#pragma unroll
                  for (int o = 1; o < 64; o <<= 1) { const float n = __shfl_up(incl, o); if (lane >= o) incl += n; }
                  float run = incl - tot; float* dst = BF + (size_t)sq * SEQ + lane * 64;
                  for (int i = 0; i < 64; ++i) { run += log_sigmoid_f(src[(size_t)i * 8] + bb); dst[i] = -LOG2E * run; } } }
            if (B1M & 16) { const float* KP = (const float*)(ws + WS_KPART); const bf16_t* QG = (const bf16_t*)(ws + WS_QG); unsigned* SEL = (unsigned*)(ws + WS_SEL);
              LAS float* km = (LAS float*)lds;
              for (int job = bid; job < 512; job += G) { const int b = job >> 6, h = (job >> 3) & 7, tb = job & 7;
                  __syncthreads();
                  for (int i = tid; i < 1024; i += NTHREADS) { const int n = i >> 6, d = i & 63; const float* p = KP + ((size_t)((b * 16 + n) * 2)) * 512 + h * 64 + d; km[i] = (p[0] + p[512]) * (1.0f / 256.0f); }
                  __syncthreads();
                  const int t = tb * 512 + tid; const int cur = t >> 8; const size_t row = (size_t)b * SEQ + t;
                  float q[64];
                  { const bf16x8* qp = (const bf16x8*)(QG + row * 1536 + 1024 + h * 64);
#pragma unroll
                    for (int c = 0; c < 8; ++c) { const bf16x8 v = qp[c];
#pragma unroll
                        for (int e = 0; e < 8; ++e) q[c * 8 + e] = bf2f((unsigned short)v[e]); } }
                  float g1 = -INFINITY, g2 = -INFINITY, g3 = -INFINITY; int i1 = -1, i2 = -1, i3 = -1;
                  for (int n = 0; n < cur; ++n) { float gsum = 0.f;
#pragma unroll
                      for (int d = 0; d < 64; ++d) gsum = __builtin_fmaf(q[d], km[n * 64 + d], gsum);
                      if (gsum > g1) { g3 = g2; i3 = i2; g2 = g1; i2 = i1; g1 = gsum; i1 = n; }
                      else if (gsum > g2) { g3 = g2; i3 = i2; g2 = gsum; i2 = n; }
                      else if (gsum > g3) { g3 = gsum; i3 = n; } }
                  unsigned m = 0u; if (i1 >= 0) m |= 1u << i1; if (i2 >= 0) m |= 1u << i2; if (i3 >= 0) m |= 1u << i3;
                  SEL[row * 8 + h] = m; }
              __syncthreads(); }
}

__device__ __forceinline__ void phase_b2(const Args& args, const int layer, LAS unsigned char* lds, unsigned char* lds_raw, const int G, const int bid) {
    unsigned char* ws = args.ws; asm volatile("" : "+s"(ws));
    int tid = threadIdx.x; asm volatile("" : "+v"(tid));
    const int lane = tid & 63, wave = __builtin_amdgcn_readfirstlane(tid >> 6);
    const int gw = bid * NWAVES + wave, NGW = G * NWAVES;
    unsigned char* wl = ws + WS_W + (size_t)layer * W_LAYER;
    (void)lane; (void)gw; (void)NGW; (void)wl; (void)lds_raw;
    volatile LAS unsigned* MISC = (volatile LAS unsigned*)(lds + MISC_OFF); unsigned* ctl = (unsigned*)(ws + WS_CTL);
            unsigned* qctr = ctl + CW_QCTR * (1 + layer);
            for (;;) {
                if (tid == 0) MISC[0] = __hip_atomic_fetch_add(qctr, 1u, __ATOMIC_RELAXED, __HIP_MEMORY_SCOPE_AGENT);
                __syncthreads();
                const unsigned k = MISC[0];
                __syncthreads();
                if (k >= (unsigned)N_ATT_UNITS) break;
                const unsigned e = g_utab.v[k]; const int ty = e >> 12, b = (e >> 8) & 7, h = (e >> 4) & 7, qb = e & 15;
                if (ty == 0) { const AttnP PF{(const bf16_t*)(ws + WS_QG), 1536, (const bf16_t*)(ws + WS_FK), 512, (const bf16_t*)(ws + WS_FV), 512, (bf16_t*)(ws + WS_QG), 1536,
                                   (const bf16_t*)(ws + WS_GATE), 1536, (float*)(ws + WS_SSQA), 8, (const float*)(ws + WS_BIASF), nullptr};
                    attn_unit<64, 64, 0>(PF, b, h, qb, (char*)lds_raw); }
                else if (ty == 1) { const AttnP PM{(const bf16_t*)(ws + WS_QM), 768, (const bf16_t*)(ws + WS_KM), 768, (const bf16_t*)(ws + WS_VM), 512, (bf16_t*)(ws + WS_QG) + 512, 1536,
                                   (const bf16_t*)(ws + WS_GATE) + 512, 1536, (float*)(ws + WS_SSQB), 4, nullptr, nullptr};
                    attn_unit<192, 128, 1>(PM, b, h, qb, (char*)lds_raw); }
                else { const AttnP PB{(const bf16_t*)(ws + WS_QG) + 1024, 1536, (const bf16_t*)(ws + WS_BK), 512, (const bf16_t*)(ws + WS_BV), 512, (bf16_t*)(ws + WS_QG) + 1024, 1536,
                                   (const bf16_t*)(ws + WS_GATE) + 1024, 1536, (float*)(ws + WS_SSQC), 8, nullptr, (const unsigned*)(ws + WS_SEL)};
                    attn_unit<64, 64, 2>(PB, b, h, qb, (char*)lds_raw); }
            }
}

__device__ __forceinline__ void phase_n(const Args& args, const int layer, LAS unsigned char* lds, unsigned char* lds_raw, const int G, const int bid) {
    unsigned char* ws = args.ws; asm volatile("" : "+s"(ws));
    int tid = threadIdx.x; asm volatile("" : "+v"(tid));
    const int lane = tid & 63, wave = __builtin_amdgcn_readfirstlane(tid >> 6);
    const int gw = bid * NWAVES + wave, NGW = G * NWAVES;
    unsigned char* wl = ws + WS_W + (size_t)layer * W_LAYER;
    (void)lane; (void)gw; (void)NGW; (void)wl; (void)lds_raw;
            bf16_t* Y = (bf16_t*)(ws + WS_QG); const float* SA = (const float*)(ws + WS_SSQA); const float* SB = (const float*)(ws + WS_SSQB); const float* SC = (const float*)(ws + WS_SSQC);
            for (int m = gw; m < T; m += NGW) {
                const f32x4 a0 = *(const f32x4*)(SA + (size_t)m * 8), a1 = *(const f32x4*)(SA + (size_t)m * 8 + 4), b0 = *(const f32x4*)(SB + (size_t)m * 4);
                const f32x4 c0 = *(const f32x4*)(SC + (size_t)m * 8), c1 = *(const f32x4*)(SC + (size_t)m * 8 + 4);
                const float ra = rsqrtf((sum4(a0) + sum4(a1)) * (1.0f / 512.0f) + EPS), rb = rsqrtf(sum4(b0) * (1.0f / 512.0f) + EPS), rc = rsqrtf((sum4(c0) + sum4(c1)) * (1.0f / 512.0f) + EPS);
                u32x4* yp = (u32x4*)(Y + (size_t)m * 1536);
#pragma unroll
                for (int j = 0; j < 3; ++j) { const float r = (j == 0) ? ra : (j == 1) ? rb : rc; u32x4 v = yp[64 * j + lane]; u32x4 o;
#pragma unroll
                    for (int e = 0; e < 4; ++e) { const unsigned w = v[e]; o[e] = cvt_pk_bf16(__uint_as_float(w << 16) * r, __uint_as_float(w & 0xffff0000u) * r); }
                    yp[64 * j + lane] = o; }
            }
}

__device__ __forceinline__ void phase_c(const Args& args, const int layer, LAS unsigned char* lds, unsigned char* lds_raw, const int G, const int bid) {
    unsigned char* ws = args.ws; asm volatile("" : "+s"(ws));
    int tid = threadIdx.x; asm volatile("" : "+v"(tid));
    const int lane = tid & 63, wave = __builtin_amdgcn_readfirstlane(tid >> 6);
    const int gw = bid * NWAVES + wave, NGW = G * NWAVES;
    unsigned char* wl = ws + WS_W + (size_t)layer * W_LAYER;
    (void)lane; (void)gw; (void)NGW; (void)wl; (void)lds_raw;
            pg8::Gemm g{(const bf16_t*)(ws + WS_QG), (const bf16_t*)(wl + W_OUT_OFF), T, DM, DMIX, DMIX}; pg8::StaticOrder S; S.init(T, DM, G, bid);
            EpiC E{layer == 0 ? args.in[0] : (const float*)args.out, args.out, ws, layer == DEPTH - 1 ? 1 : 0};
            pg8::gemm_phase<EpiC, true>(lds, g, S, E);
}

__device__ __forceinline__ void phase_r(const Args& args, const int layer, LAS unsigned char* lds, unsigned char* lds_raw, const int G, const int bid) {
    unsigned char* ws = args.ws; asm volatile("" : "+s"(ws));
    int tid = threadIdx.x; asm volatile("" : "+v"(tid));
    const int lane = tid & 63, wave = __builtin_amdgcn_readfirstlane(tid >> 6);
    const int gw = bid * NWAVES + wave, NGW = G * NWAVES;
    unsigned char* wl = ws + WS_W + (size_t)layer * W_LAYER;
    (void)lane; (void)gw; (void)NGW; (void)wl; (void)lds_raw;
            const float* SSX = (const float*)(ws + WS_SSX); float* RSX = (float*)(ws + WS_RSX);
            for (int m = bid * NTHREADS + tid; m < T; m += G * NTHREADS) { const f32x4* p = (const f32x4*)(SSX + (size_t)m * 16);
                const float sm = (sum4(p[0]) + sum4(p[1])) + (sum4(p[2]) + sum4(p[3])); RSX[m] = rsqrtf(sm * (1.0f / 1024.0f) + EPS); }
}

__device__ __forceinline__ void phase_f(const Args& args, const int layer, LAS unsigned char* lds, unsigned char* lds_raw, const int G, const int bid) {
    unsigned char* ws = args.ws; asm volatile("" : "+s"(ws));
    int tid = threadIdx.x; asm volatile("" : "+v"(tid));
    const int lane = tid & 63, wave = __builtin_amdgcn_readfirstlane(tid >> 6);
    const int gw = bid * NWAVES + wave, NGW = G * NWAVES;
    unsigned char* wl = ws + WS_W + (size_t)layer * W_LAYER;
    (void)lane; (void)gw; (void)NGW; (void)wl; (void)lds_raw;
            float* X = args.out; const float* gf = args.in[10];
            for (int m = gw; m < T; m += NGW) { f32x4* xr = (f32x4*)(X + (size_t)m * DM) + lane; f32x4 v[4]; float s = 0.f;
#pragma unroll
                for (int j = 0; j < 4; ++j) { v[j] = xr[64 * j]; s += dot4(v[j]); }
                const float r = rsqrtf(wave_sum(s) * (1.0f / 1024.0f) + EPS);
#pragma unroll
                for (int j = 0; j < 4; ++j) { const f32x4 gg = *((const f32x4*)gf + 64 * j + lane); xr[64 * j] = v[j] * r * gg; } }
}

__global__ void __launch_bounds__(NTHREADS, 2) fwd_kernel(Args args) {
    extern __shared__ __attribute__((aligned(16))) unsigned char lds_raw[];
    LAS unsigned char* lds = (LAS unsigned char*)lds_raw;
    const int G = gridDim.x, bid = blockIdx.x;
    const int lo = args.ph_lo, hi = args.ph_hi;
    volatile LAS unsigned* MISCW = (volatile LAS unsigned*)(lds + MISC_OFF);
    XcdBarrier xbar; xbar.bar = (unsigned*)(args.ws + WS_CTL) + CW_BAR; xbar.x = 0; xbar.st = MISCW + 8;
    if (args.coop) { if (threadIdx.x == 0) { MISCW[8] = 0u; MISCW[9] = 0u; } __syncthreads(); xbar = xcd_barrier_post((unsigned*)(args.ws + WS_CTL) + CW_BAR, MISCW + 8); }
#define IN(k) (lo <= (k) && (k) < hi)
#define SEAM(k) do { if (IN(k) && IN((k) + 1) && args.coop) { if ((k) == 0) cg::this_grid().sync(); else xcd_barrier(xbar); } } while (0)
    if (IN(0) && (PHM & 1)) phase_p0(args, 0, lds, lds_raw, G, bid);
    SEAM(0);
    if (IN(1) && (PHM & 2)) phase_a(args, 0, lds, lds_raw, G, bid);
    SEAM(1);
    if (IN(2) && (PHM & 4)) phase_b1(args, 0, lds, lds_raw, G, bid);
    SEAM(2);
    if (IN(3) && (PHM & 8)) phase_b2(args, 0, lds, lds_raw, G, bid);
    SEAM(3);
    if (IN(4) && (PHM & 16)) phase_n(args, 0, lds, lds_raw, G, bid);
    SEAM(4);
    if (IN(5) && (PHM & 32)) phase_c(args, 0, lds, lds_raw, G, bid);
    SEAM(5);
    if (IN(6)) phase_r(args, 0, lds, lds_raw, G, bid);
    SEAM(6);
    if (IN(7) && (PHM & 2)) phase_a(args, 1, lds, lds_raw, G, bid);
    SEAM(7);
    if (IN(8) && (PHM & 4)) phase_b1(args, 1, lds, lds_raw, G, bid);
    SEAM(8);
    if (IN(9) && (PHM & 8)) phase_b2(args, 1, lds, lds_raw, G, bid);
    SEAM(9);
    if (IN(10) && (PHM & 16)) phase_n(args, 1, lds, lds_raw, G, bid);
    SEAM(10);
    if (IN(11) && (PHM & 32)) phase_c(args, 1, lds, lds_raw, G, bid);
    SEAM(11);
    if (IN(12) && (PHM & 64)) phase_f(args, 0, lds, lds_raw, G, bid);
#undef IN
#undef SEAM
}

extern "C" void kernel_launch(void* const* d_in, const int* in_sizes, int n_in, void* d_out, int out_size, void* d_ws, size_t ws_size, hipStream_t stream) {
    static int grid = 0;
    if (grid == 0) {
        if (n_in != 11 || in_sizes[0] != T * DM || out_size != T * DM || ws_size < WS_END) {
            fprintf(stderr, "kernel_launch: shape mismatch (n_in %d, in0 %d, out %d, ws %zu; need ws >= %zu)\n", n_in, n_in > 0 ? in_sizes[0] : -1, out_size, ws_size, (size_t)WS_END); grid = -1; return; }
        int dev = 0, cus = 0, per_cu = 0;
        hipGetDevice(&dev); hipDeviceGetAttribute(&cus, hipDeviceAttributeMultiprocessorCount, dev);
        if (hipFuncSetAttribute((const void*)fwd_kernel, hipFuncAttributeMaxDynamicSharedMemorySize, LDS_BYTES) != hipSuccess) { fprintf(stderr, "kernel_launch: hipFuncSetAttribute failed\n"); grid = -1; return; }
        hipOccupancyMaxActiveBlocksPerMultiprocessor(&per_cu, (const void*)fwd_kernel, NTHREADS, LDS_BYTES);
        (void)hipGetLastError();
        if (per_cu < 1) { fprintf(stderr, "kernel_launch: occupancy query says %d blocks/CU\n", per_cu); per_cu = 1; }
        grid = cus * 1;
    }
    if (grid < 0) return;
    hipMemsetAsync((char*)d_ws + WS_CTL, 0, CTL_ZERO_BYTES, stream);
    Args a{};
    for (int i = 0; i < 11; ++i) a.in[i] = (const float*)d_in[i];
    a.out = (float*)d_out; a.ws = (unsigned char*)d_ws;
#ifndef ONE_LAUNCH
#define ONE_LAUNCH 1
#endif
    if (ONE_LAUNCH) {
        a.ph_lo = 0; a.ph_hi = NPHASES; a.coop = 1;
        void* kargs[] = {&a};
        hipError_t e = hipLaunchCooperativeKernel((const void*)fwd_kernel, dim3(grid), dim3(NTHREADS), kargs, LDS_BYTES, stream);
        if (e != hipSuccess) fprintf(stderr, "kernel_launch: cooperative launch failed: %s (grid %d)\n", hipGetErrorString(e), grid);
    } else {
        for (int ph = 0; ph < NPHASES; ++ph) { a.ph_lo = ph; a.ph_hi = ph + 1; a.coop = 0;
            hipLaunchKernelGGL(fwd_kernel, dim3(grid), dim3(NTHREADS), LDS_BYTES, stream, a); }
    }
}
```

```cpp
#include <hip/hip_runtime.h>
#include <hip/hip_cooperative_groups.h>
#include <cstdio>
#include <cstdint>
#include <cmath>
namespace cg = cooperative_groups;

#define LAS __attribute__((address_space(3)))
typedef unsigned short bf16_t;
typedef short bf16x8 __attribute__((ext_vector_type(8)));
typedef short s16x4 __attribute__((ext_vector_type(4)));
typedef float f32x4 __attribute__((ext_vector_type(4)));
typedef float f32x2 __attribute__((ext_vector_type(2)));
typedef float f32x16 __attribute__((ext_vector_type(16)));
typedef unsigned u32x4 __attribute__((ext_vector_type(4)));
typedef unsigned u32x2 __attribute__((ext_vector_type(2)));

constexpr int BATCH = 8, SEQ = 4096, T = BATCH * SEQ, DM = 1024, DEPTH = 2;
constexpr int D_IN = 5064, NIN = 5120, DMIX = 1536;
constexpr float EPS = 1e-6f, LOG2E = 1.4426950408889634f;
constexpr float C2_64 = 0.125f * LOG2E;
constexpr float C2_192 = 0.07216878364870323f * LOG2E;
constexpr int NWAVES = 8, NTHREADS = 512;

constexpr size_t MiB = 1u << 20;
constexpr size_t WS_CTL = 0, CTL_ZERO_BYTES = 1 * MiB;
constexpr size_t WS_SSX = 1 * MiB;
constexpr size_t WS_KRF = 3 * MiB;
constexpr size_t WS_FFL = 11 * MiB;
constexpr size_t WS_RSCQ = 12 * MiB;
constexpr size_t WS_RSCKV = 12 * MiB + 256 * 1024;
constexpr size_t WS_RSX = 12 * MiB + 512 * 1024;
constexpr size_t WS_KPART = 13 * MiB;
constexpr size_t WS_BIASF = 14 * MiB;
constexpr size_t WS_SEL = 15 * MiB;
constexpr size_t WS_SSQA = 16 * MiB;
constexpr size_t WS_SSQB = 17 * MiB;
constexpr size_t WS_SSQC = 18 * MiB;
constexpr size_t WS_ROPE = 19 * MiB;
constexpr size_t WS_W = 24 * MiB, W_LAYER = 14 * MiB;
constexpr size_t W_IN_OFF = 0, W_UQ_OFF = 10 * MiB, W_UKV_OFF = 10 * MiB + 512 * 1024, W_OUT_OFF = 11 * MiB;
constexpr size_t WS_QG = 56 * MiB;
constexpr size_t WS_GATE = 152 * MiB;
constexpr size_t WS_FK = 248 * MiB, WS_FV = 280 * MiB, WS_BK = 312 * MiB, WS_BV = 344 * MiB;
constexpr size_t WS_R2 = 376 * MiB;
constexpr size_t WS_XB = WS_R2, WS_QM = WS_R2, WS_KM = WS_R2 + 48 * MiB, WS_VM = WS_R2 + 96 * MiB;
constexpr size_t WS_END = 504 * MiB;
constexpr int CW_QCTR = 64;

constexpr int RING_BYTES = 131072, MISC_OFF = RING_BYTES + 256, SIDE_OFF = RING_BYTES + 1024  , LDS_BYTES = 147456;

__device__ __forceinline__ unsigned cvt_pk_bf16(float lo, float hi) { unsigned r; asm volatile("v_cvt_pk_bf16_f32 %0, %1, %2" : "=v"(r) : "v"(lo), "v"(hi)); return r; }
__device__ __forceinline__ float bf2f(unsigned short b) { return __uint_as_float(((unsigned)b) << 16); }
__device__ __forceinline__ void store8_bf16(bf16_t* p, f32x4 a, f32x4 b) {
    u32x4 w; w.x = cvt_pk_bf16(a[0], a[1]); w.y = cvt_pk_bf16(a[2], a[3]); w.z = cvt_pk_bf16(b[0], b[1]); w.w = cvt_pk_bf16(b[2], b[3]); *(u32x4*)p = w; }
__device__ __forceinline__ float silu_f(float v) { return v * __builtin_amdgcn_rcpf(1.0f + __builtin_amdgcn_exp2f(-v * LOG2E)); }
__device__ __forceinline__ f32x4 silu4(f32x4 v) { f32x4 o; o[0] = silu_f(v[0]); o[1] = silu_f(v[1]); o[2] = silu_f(v[2]); o[3] = silu_f(v[3]); return o; }
__device__ __forceinline__ float wave_sum(float v) {
#pragma unroll
    for (int o = 1; o < 64; o <<= 1) v += __shfl_xor(v, o);
    return v;
}
__device__ __forceinline__ float log_sigmoid_fast(float x) { return -0.6931471805599453f * __builtin_amdgcn_logf(1.0f + __builtin_amdgcn_exp2f(-x * LOG2E)); }
__device__ __forceinline__ float sum4(f32x4 a) { return (a[0] + a[1]) + (a[2] + a[3]); }
__device__ __forceinline__ float dot4(f32x4 a) { return (a[0] * a[0] + a[1] * a[1]) + (a[2] * a[2] + a[3] * a[3]); }

namespace pg8 {
constexpr int BM = 256, BK = 64, HALF = 128, HTB = HALF * BK * 2, STAGE_BYTES = 8 * HTB, NXCD = 8, WGM = 8;
__host__ __device__ __forceinline__ int lds_byte(int r, int c) { const int st = (r >> 4) * 2 + (c >> 5), rr = r & 15, cc = c & 31, ob = rr * 64 + cc * 2; return st * 1024 + (ob ^ (((ob >> 9) & 1) << 5)); }
__host__ __device__ __forceinline__ void stage_rc(int b, int& R, int& C) { const int st = b / 1024, sb = b % 1024, swz = sb ^ (((sb >> 9) & 1) << 5); R = (st >> 1) * 16 + swz / 64; C = (st & 1) * 32 + (swz % 64) / 2; }
__host__ __device__ __forceinline__ int perm32(int rho) { const int n = rho >> 4, i = rho & 15; return 8 * (i >> 2) + 4 * n + (i & 3); }

struct Unit { int pm, pn; };
struct Gemm { const bf16_t* A; const bf16_t* Bt; int M, N, K, lda; };

struct StaticOrder {
    int nM, nN, nwg, G, c;
    __host__ __device__ void init(int M, int N, int G_, int c_) { nM = M / BM; nN = N / BM; nwg = nM * nN; G = G_; c = c_; }
    __host__ __device__ bool next(int i, Unit& u) const {
        const long L = (long)i * G + c; if (L >= nwg) return false;
        int wgid = (int)L; { const int q = nwg / NXCD, r = nwg % NXCD, xcd = wgid % NXCD, off = wgid / NXCD; wgid = (xcd < r ? xcd * (q + 1) : r * (q + 1) + (xcd - r) * q) + off; }
        const int nig = WGM * nN, gid = wgid / nig, fm = gid * WGM, gsz = (nM - fm) < WGM ? (nM - fm) : WGM;
        u.pm = fm + ((wgid % nig) % gsz); u.pn = (wgid % nig) / gsz; return true;
    }
};

template <class Epi, bool ALIGN_EPI>
__device__ __forceinline__ void gemm_phase(LAS unsigned char* lds, const Gemm g, const StaticOrder& S, const Epi& E) {
    int tid_ = threadIdx.x; asm volatile("" : "+v"(tid_));
    const int tid = tid_, wid = __builtin_amdgcn_readfirstlane(tid >> 6), lane = tid & 63, wr = wid >> 2, wc = wid & 3, fr = lane & 15, fq = lane >> 4;
    const int K = g.K, nt = K / BK, lda = g.lda;
    unsigned voffA[2], voffB[2];
#pragma unroll
    for (int i = 0; i < 2; ++i) { int R, C; stage_rc(tid * 16 + i * 8192, R, C); const int Rb = Epi::PERM ? ((R & ~31) + perm32(R & 31)) : R;
        voffA[i] = (unsigned)(R * lda + C) * 2u; voffB[i] = (unsigned)(Rb * K + C) * 2u; }
    const size_t kstep = (size_t)(BK * 2);
    const size_t hstepA = (size_t)HALF * lda * 2, hstepB = (size_t)HALF * K * 2;
    const size_t tstepA = 2 * hstepA, tstepB = 2 * hstepB;
    const unsigned ldsw = (unsigned)wid * 1024u;
    const int aoff = lds_byte(wr * 64 + fr, fq * 8), boff = lds_byte(wc * 32 + fr, fq * 8);
#define PG8_SA(b, h) (((b) * 2 + (h)) * HTB)
#define PG8_SB(b, h) ((4 + (b) * 2 + (h)) * HTB)
#define PG8_STAGE(bufoff, gbase, voff) do { _Pragma("unroll") for (int _i = 0; _i < 2; ++_i) \
        __builtin_amdgcn_global_load_lds((const unsigned*)((const char*)(gbase) + (voff)[_i]), (LAS unsigned*)(lds + (bufoff) + ldsw + _i * 8192), 16, 0, 0); } while (0)
#define PG8_LDA(dst, b, h) do { _Pragma("unroll") for (int m = 0; m < 4; ++m) _Pragma("unroll") for (int k = 0; k < 2; ++k) dst[m][k] = *(const LAS bf16x8*)(lds + PG8_SA(b, h) + aoff + m * 2048 + k * 1024); } while (0)
#define PG8_LDB(dst, b, h) do { _Pragma("unroll") for (int n = 0; n < 2; ++n) _Pragma("unroll") for (int k = 0; k < 2; ++k) dst[n][k] = *(const LAS bf16x8*)(lds + PG8_SB(b, h) + boff + n * 2048 + k * 1024); } while (0)
#define PG8_MMA(ai, bj, At, Bt) do { __builtin_amdgcn_s_setprio(1); _Pragma("unroll") for (int m = 0; m < 4; ++m) _Pragma("unroll") for (int n = 0; n < 2; ++n) _Pragma("unroll") for (int k = 0; k < 2; ++k) \
        acc[ai][bj][m][n] = __builtin_amdgcn_mfma_f32_16x16x32_bf16(Bt[n][k], At[m][k], acc[ai][bj][m][n], 0, 0, 0); __builtin_amdgcn_s_setprio(0); } while (0)
#define PG8_WAIT_V(n) asm volatile("s_waitcnt vmcnt(" #n ")" ::: "memory")
#define PG8_WAIT_L(n) asm volatile("s_waitcnt lgkmcnt(" #n ")" ::: "memory")
#define PG8_BAR __builtin_amdgcn_s_barrier()
#define PG8_SCHED __builtin_amdgcn_sched_barrier(0)
    Unit cur, nxt; int ui = 0;
    if (!S.next(0, cur)) return;
    f32x4 acc[2][2][4][2];
#pragma unroll
    for (int a = 0; a < 2; ++a)
#pragma unroll
        for (int b = 0; b < 2; ++b)
#pragma unroll
            for (int m = 0; m < 4; ++m)
#pragma unroll
                for (int n = 0; n < 2; ++n) acc[a][b][m][n] = (f32x4){0.f, 0.f, 0.f, 0.f};
    bf16x8 At[4][2], B0[2][2], B1[2][2];
    const char* cA = (const char*)g.A + (size_t)cur.pm * tstepA; const char* cB = (const char*)g.Bt + (size_t)cur.pn * tstepB;
    PG8_STAGE(PG8_SB(0, 0), cB, voffB); PG8_STAGE(PG8_SB(0, 1), cB + hstepB, voffB); PG8_STAGE(PG8_SA(0, 0), cA, voffA); PG8_STAGE(PG8_SA(0, 1), cA + hstepA, voffA);
    if (wr == 1) PG8_BAR;
    PG8_WAIT_V(2); PG8_BAR;
    PG8_STAGE(PG8_SB(1, 0), cB + kstep, voffB); PG8_STAGE(PG8_SA(1, 0), cA + kstep, voffA); PG8_STAGE(PG8_SB(1, 1), cB + hstepB + kstep, voffB);
    PG8_WAIT_V(6); PG8_BAR;
    for (;;) {
        const bool has_next = S.next(ui + 1, nxt);
        const char* nA = has_next ? (const char*)g.A + (size_t)nxt.pm * tstepA : cA; const char* nB = has_next ? (const char*)g.Bt + (size_t)nxt.pn * tstepB : cB;
#pragma unroll 1
        for (int t = 0; t < nt; t += 2) {
            const bool last = (t == nt - 2);
            const char* a1 = cA + (size_t)(t + 1) * kstep;
            const char* a2 = last ? nA : cA + (size_t)(t + 2) * kstep; const char* b2 = last ? nB : cB + (size_t)(t + 2) * kstep;
            const char* a3 = a2 + kstep; const char* b3 = b2 + kstep;
            PG8_LDB(B0, 0, 0); PG8_LDB(B1, 0, 1); PG8_SCHED; PG8_LDA(At, 0, 0); PG8_STAGE(PG8_SA(1, 1), a1 + hstepA, voffA);
            PG8_WAIT_V(8); PG8_WAIT_L(0); PG8_BAR; PG8_MMA(0, 0, At, B0); PG8_MMA(0, 1, At, B1); PG8_BAR; PG8_SCHED;
            PG8_LDA(At, 0, 1); PG8_STAGE(PG8_SB(0, 0), b2, voffB); PG8_STAGE(PG8_SB(0, 1), b2 + hstepB, voffB); PG8_STAGE(PG8_SA(0, 0), a2, voffA);
            PG8_WAIT_V(8); PG8_WAIT_L(0); PG8_BAR; PG8_MMA(1, 0, At, B0); PG8_MMA(1, 1, At, B1); PG8_BAR; PG8_SCHED;
            PG8_LDB(B0, 1, 0); PG8_LDB(B1, 1, 1); PG8_SCHED; PG8_LDA(At, 1, 0); PG8_STAGE(PG8_SA(0, 1), a2 + hstepA, voffA);
            PG8_WAIT_V(8); PG8_WAIT_L(0); PG8_BAR; PG8_MMA(0, 0, At, B0); PG8_MMA(0, 1, At, B1); PG8_BAR; PG8_SCHED;
            PG8_LDA(At, 1, 1); PG8_STAGE(PG8_SB(1, 0), b3, voffB); PG8_STAGE(PG8_SB(1, 1), b3 + hstepB, voffB); PG8_STAGE(PG8_SA(1, 0), a3, voffA);
            PG8_WAIT_V(8); PG8_WAIT_L(0); PG8_BAR; PG8_MMA(1, 0, At, B0); PG8_MMA(1, 1, At, B1); PG8_BAR; PG8_SCHED;
        }
        if constexpr (ALIGN_EPI) { if (wr == 0) PG8_BAR; }
        E(acc, cur, wr, wc, fr, fq);
        if (!has_next) break;
#pragma unroll
        for (int a = 0; a < 2; ++a)
#pragma unroll
            for (int b = 0; b < 2; ++b)
#pragma unroll
                for (int m = 0; m < 4; ++m)
#pragma unroll
                    for (int n = 0; n < 2; ++n) acc[a][b][m][n] = (f32x4){0.f, 0.f, 0.f, 0.f};
        cur = nxt; cA = nA; cB = nB; ++ui;
        if constexpr (ALIGN_EPI) { if (wr == 1) PG8_BAR; }
    }
    PG8_WAIT_V(0);
    if constexpr (!ALIGN_EPI) { if (wr == 0) PG8_BAR; }
    PG8_BAR;
#undef PG8_SA
#undef PG8_SB
#undef PG8_STAGE
#undef PG8_LDA
#undef PG8_LDB
#undef PG8_MMA
#undef PG8_WAIT_V
#undef PG8_WAIT_L
#undef PG8_BAR
#undef PG8_SCHED
}
}

struct EpiA {
    static constexpr bool PERM = true;
    unsigned char* ws; LAS float* side; const float* bfp;
    __device__ __forceinline__ void operator()(const f32x4 (&acc)[2][2][4][2], const pg8::Unit& u, int wr, int wc, int fr, int fq) const {
        const float* RSX = (const float*)(ws + WS_RSX);
        float rs[2][4];
#pragma unroll
        for (int ai = 0; ai < 2; ++ai)
#pragma unroll
            for (int m = 0; m < 4; ++m) rs[ai][m] = RSX[u.pm * 256 + ai * 128 + wr * 64 + m * 16 + fr];
        const int pn = u.pn, cw = wc * 32 + 8 * fq;
        bf16_t* dst; int pitch, coff, mode;
        if (pn < 2)       { dst = (bf16_t*)(ws + WS_QG);   pitch = 1536; coff = pn * 256;               mode = 1; }
        else if (pn < 4)  { dst = (bf16_t*)(ws + WS_FK);   pitch = 512;  coff = (pn - 2) * 256;         mode = 0; }
        else if (pn < 6)  { dst = (bf16_t*)(ws + WS_FV);   pitch = 512;  coff = (pn - 4) * 256;         mode = 0; }
        else if (pn < 8)  { dst = (bf16_t*)(ws + WS_GATE); pitch = 1536; coff = (pn - 6) * 256;         mode = 2; }
        else if (pn == 8) { dst = (bf16_t*)(ws + WS_QG);   pitch = 1536; coff = 512;                    mode = 0; }
        else if (pn == 9) { dst = (bf16_t*)(ws + WS_QG);   pitch = 1536; coff = 768;                    mode = 0; }
        else if (pn < 12) { dst = (bf16_t*)(ws + WS_GATE); pitch = 1536; coff = 512 + (pn - 10) * 256;  mode = 2; }
        else if (pn < 14) { dst = (bf16_t*)(ws + WS_QG);   pitch = 1536; coff = 1024 + (pn - 12) * 256; mode = 1; }
        else if (pn < 16) { dst = (bf16_t*)(ws + WS_BK);   pitch = 512;  coff = (pn - 14) * 256;        mode = 0; }
        else if (pn < 18) { dst = (bf16_t*)(ws + WS_BV);   pitch = 512;  coff = (pn - 16) * 256;        mode = 0; }
        else              { dst = (bf16_t*)(ws + WS_GATE); pitch = 1536; coff = 1024 + (pn - 18) * 256; mode = 2; }
        const float msc = (mode == 1) ? C2_64 : 1.0f;
#pragma unroll
        for (int ai = 0; ai < 2; ++ai)
#pragma unroll
            for (int m = 0; m < 4; ++m) { const int row = u.pm * 256 + ai * 128 + wr * 64 + m * 16 + fr; bf16_t* rowp = dst + (size_t)row * pitch + coff + cw; const float sc = rs[ai][m] * msc;
#pragma unroll
                for (int bj = 0; bj < 2; ++bj) { f32x4 v0 = acc[ai][bj][m][0] * sc, v1 = acc[ai][bj][m][1] * sc;
                    if (mode == 2) { v0 = silu4(v0); v1 = silu4(v1); }
                    store8_bf16(rowp + bj * 128, v0, v1); } }
        if (pn == 8 || pn == 9) {
#pragma unroll
            for (int ai = 0; ai < 2; ++ai)
#pragma unroll
                for (int m = 0; m < 4; ++m) { const int rl = ai * 128 + wr * 64 + m * 16 + fr; const float sc = rs[ai][m];
                    float s = dot4(acc[ai][0][m][0] * sc) + dot4(acc[ai][0][m][1] * sc);
                    if (pn == 8) s += dot4(acc[ai][1][m][0] * sc) + dot4(acc[ai][1][m][1] * sc);
                    s += __shfl_xor(s, 16); s += __shfl_xor(s, 32);
                    if (fq == 0) side[rl * 4 + wc] = s; }
            asm volatile("s_waitcnt lgkmcnt(0)" ::: "memory"); __builtin_amdgcn_s_barrier(); asm volatile("" ::: "memory");
            if (threadIdx.x < 256) { const int rl = threadIdx.x; const f32x4 v = *(const LAS f32x4*)(side + rl * 4);
                float* RS = (float*)(ws + (pn == 8 ? WS_RSCQ : WS_RSCKV)); RS[u.pm * 256 + rl] = rsqrtf(sum4(v) * (pn == 8 ? 1.0f / 256.0f : 1.0f / 128.0f) + EPS); }
        }
        if (pn == 9) {
            float* KRF = (float*)(ws + WS_KRF); float* FFL = (float*)(ws + WS_FFL);
#pragma unroll
            for (int ai = 0; ai < 2; ++ai)
#pragma unroll
                for (int m = 0; m < 4; ++m) { const int row = u.pm * 256 + ai * 128 + wr * 64 + m * 16 + fr; const float sc = rs[ai][m];
                    const f32x4 v0 = acc[ai][1][m][0] * sc, v1 = acc[ai][1][m][1] * sc;
                    if (wc < 2) { float* p = KRF + (size_t)row * 64 + cw; *(f32x4*)p = v0; *(f32x4*)(p + 4) = v1; }
                    else if (wc == 2 && fq == 0) { float* p = FFL + (size_t)row * 8; const f32x4 b0 = *(const f32x4*)bfp, b1 = *(const f32x4*)(bfp + 4); f32x4 l0, l1;
#pragma unroll
                        for (int e = 0; e < 4; ++e) { l0[e] = log_sigmoid_fast(v0[e] + b0[e]); l1[e] = log_sigmoid_fast(v1[e] + b1[e]); }
                        *(f32x4*)p = l0; *(f32x4*)(p + 4) = l1; } }
        }
        if (pn == 14 || pn == 15) {
            float* KP = (float*)(ws + WS_KPART) + ((size_t)(u.pm * 2 + wr)) * 512 + (pn - 14) * 256;
#pragma unroll
            for (int bj = 0; bj < 2; ++bj)
#pragma unroll
                for (int n = 0; n < 2; ++n) { f32x4 s = (f32x4){0.f, 0.f, 0.f, 0.f};
#pragma unroll
                    for (int ai = 0; ai < 2; ++ai)
#pragma unroll
                        for (int m = 0; m < 4; ++m) s += acc[ai][bj][m][n] * rs[ai][m];
#pragma unroll
                    for (int o = 1; o < 16; o <<= 1) { s[0] += __shfl_xor(s[0], o); s[1] += __shfl_xor(s[1], o); s[2] += __shfl_xor(s[2], o); s[3] += __shfl_xor(s[3], o); }
                    if (fr == 0) *(f32x4*)(KP + bj * 128 + cw + 4 * n) = s; }
        }
    }
};

struct EpiQ {
    static constexpr bool PERM = true;
    unsigned char* ws;
    __device__ __forceinline__ void operator()(const f32x4 (&acc)[2][2][4][2], const pg8::Unit& u, int wr, int wc, int fr, int fq) const {
        const float* RS = (const float*)(ws + WS_RSCQ); bf16_t* QM = (bf16_t*)(ws + WS_QM);
        const float* COS = (const float*)(ws + WS_ROPE); const float* SIN = COS + SEQ * 32;
        const int pn = u.pn, cw = wc * 32 + 8 * fq;
#pragma unroll
        for (int ai = 0; ai < 2; ++ai)
#pragma unroll
            for (int m = 0; m < 4; ++m) { const int row = u.pm * 256 + ai * 128 + wr * 64 + m * 16 + fr;
                const float sc = RS[row] * C2_192;
                if (pn < 2) {
#pragma unroll
                    for (int bj = 0; bj < 2; ++bj) { const int head = pn * 2 + bj; store8_bf16(QM + (size_t)row * 768 + head * 192 + cw, acc[ai][bj][m][0] * sc, acc[ai][bj][m][1] * sc); }
                } else {
                    const int tpos = row & (SEQ - 1); const float* cp = COS + (size_t)tpos * 32 + 8 * fq; const float* sp = SIN + (size_t)tpos * 32 + 8 * fq;
                    const f32x4 c0 = *(const f32x4*)cp, c1 = *(const f32x4*)(cp + 4), s0 = *(const f32x4*)sp, s1 = *(const f32x4*)(sp + 4);
                    const f32x4 x10 = acc[ai][0][m][0] * sc, x11 = acc[ai][0][m][1] * sc, x20 = acc[ai][1][m][0] * sc, x21 = acc[ai][1][m][1] * sc;
                    bf16_t* p = QM + (size_t)row * 768 + wc * 192 + 128 + 8 * fq;
                    store8_bf16(p, x10 * c0 - x20 * s0, x11 * c1 - x21 * s1);
                    store8_bf16(p + 32, x20 * c0 + x10 * s0, x21 * c1 + x11 * s1);
                    if (m & 1) asm volatile("" ::: "memory");
                } }
    }
};
struct EpiKV {
    static constexpr bool PERM = true;
    unsigned char* ws;
    __device__ __forceinline__ void operator()(const f32x4 (&acc)[2][2][4][2], const pg8::Unit& u, int wr, int wc, int fr, int fq) const {
        const float* RS = (const float*)(ws + WS_RSCKV);
        const int pn = u.pn, cw = wc * 32 + 8 * fq;
        bf16_t* base = (pn < 2) ? (bf16_t*)(ws + WS_KM) + (pn * 2) * 192 + cw : (bf16_t*)(ws + WS_VM) + (pn - 2) * 256 + cw;
        const int pitch = (pn < 2) ? 768 : 512, bjs = (pn < 2) ? 192 : 128;
#pragma unroll
        for (int ai = 0; ai < 2; ++ai)
#pragma unroll
            for (int m = 0; m < 4; ++m) { const int row = u.pm * 256 + ai * 128 + wr * 64 + m * 16 + fr; const float sc = RS[row]; bf16_t* rowp = base + (size_t)row * pitch;
#pragma unroll
                for (int bj = 0; bj < 2; ++bj) store8_bf16(rowp + bj * bjs, acc[ai][bj][m][0] * sc, acc[ai][bj][m][1] * sc); }
    }
};
struct EpiC {
    static constexpr bool PERM = false;
    const float* xin; float* xout; unsigned char* ws; int last;
    __device__ __forceinline__ void operator()(const f32x4 (&acc)[2][2][4][2], const pg8::Unit& u, int wr, int wc, int fr, int fq) const {
        bf16_t* XB = (bf16_t*)(ws + WS_XB); float* SSX = (float*)(ws + WS_SSX);
#pragma unroll
        for (int ai = 0; ai < 2; ++ai)
#pragma unroll
            for (int m = 0; m < 4; ++m) { const int row = u.pm * 256 + ai * 128 + wr * 64 + m * 16 + fr; const size_t off = (size_t)row * DM + u.pn * 256 + wc * 32 + 4 * fq; float ss = 0.f;
#pragma unroll
                for (int bj = 0; bj < 2; ++bj)
#pragma unroll
                    for (int n = 0; n < 2; ++n) { const size_t o = off + bj * 128 + n * 16; const f32x4 v = acc[ai][bj][m][n] + *(const f32x4*)(xin + o); *(f32x4*)(xout + o) = v; ss += dot4(v);
                        if (!last) { u32x2 w; w.x = cvt_pk_bf16(v[0], v[1]); w.y = cvt_pk_bf16(v[2], v[3]); *(u32x2*)(XB + o) = w; } }
                if (!last) { ss += __shfl_xor(ss, 16); ss += __shfl_xor(ss, 32); if (fq == 0) SSX[(size_t)row * 16 + u.pn * 4 + wc] = ss; } }
    }
};

#define SBAR() __builtin_amdgcn_sched_barrier(0)
__device__ __forceinline__ int crow(int r, int hi) { return (r & 3) + 8 * (r >> 2) + 4 * hi; }
template <int OFF> __device__ __forceinline__ s16x4 tr_read(int vb) { s16x4 r; asm volatile("ds_read_b64_tr_b16 %0, %1 offset:%2" : "=&v"(r) : "v"(vb), "i"(OFF) : "memory"); return r; }
__device__ __forceinline__ int v_rd_base(int lane) { return ((lane & 3) << 3) | (((lane >> 2) & 3) << 6) | (((lane >> 4) & 1) << 5) | (((lane >> 5) & 1) << 8); }
template <int NCB> __device__ __forceinline__ int v_st(int k, int c) { const int kk = (k & ~0xC) | ((k & 4) << 1) | ((k & 8) >> 1); return ((kk >> 3) * NCB + (c >> 5)) * 512 + ((kk & 7) * 32 + (c & 31)) * 2; }
template <int NCB, int D0> __device__ __forceinline__ void pv_one(f32x16& od, int vb, bf16x8 pa0, bf16x8 pa1, bf16x8 pa2, bf16x8 pa3) {
#define VOFF(ks, half) (((2 * (ks) + (half)) * NCB + D0) * 512)
    const s16x4 l0 = tr_read<VOFF(0, 0)>(vb), h0 = tr_read<VOFF(0, 1)>(vb), l1 = tr_read<VOFF(1, 0)>(vb), h1 = tr_read<VOFF(1, 1)>(vb);
    const s16x4 l2 = tr_read<VOFF(2, 0)>(vb), h2 = tr_read<VOFF(2, 1)>(vb), l3 = tr_read<VOFF(3, 0)>(vb), h3 = tr_read<VOFF(3, 1)>(vb);
#undef VOFF
    asm volatile("s_waitcnt lgkmcnt(0)" ::: "memory"); SBAR();
#define PK(L, H) (bf16x8){L[0], L[1], L[2], L[3], H[0], H[1], H[2], H[3]}
    od = __builtin_amdgcn_mfma_f32_32x32x16_bf16(pa0, PK(l0, h0), od, 0, 0, 0);
    od = __builtin_amdgcn_mfma_f32_32x32x16_bf16(pa1, PK(l1, h1), od, 0, 0, 0);
    od = __builtin_amdgcn_mfma_f32_32x32x16_bf16(pa2, PK(l2, h2), od, 0, 0, 0);
    od = __builtin_amdgcn_mfma_f32_32x32x16_bf16(pa3, PK(l3, h3), od, 0, 0, 0);
#undef PK
}
struct AttnP {
    const bf16_t* Q; int ldq;
    const bf16_t* K; int ldk;
    const bf16_t* V; int ldv;
    bf16_t* O; int ldo;
    const bf16_t* G; int ldg;
    float* SSQ; int nh;
    const float* bias;
    const unsigned* sel;
};
template <int DK, int DV, int MODE>
__device__ __forceinline__ void attn_unit(const AttnP& P, int b, int h, int qb, char* lds) {
    constexpr int NKL = DK / 64, NVL = DV / 64, NCB = DV / 32, ND0 = DK / 16, KB = 64 * DK * 2, VB = 64 * DV * 2;
    constexpr float THR = 8.0f;
    int tid_ = threadIdx.x; asm volatile("" : "+v"(tid_));
    const int tid = tid_, lane = tid & 63, r32 = lane & 31, hi = lane >> 5; const int wid = __builtin_amdgcn_readfirstlane(tid >> 6);
    char* Kl = lds; char* Vl = lds + 2 * KB; float* wsf = (float*)(lds + 2 * KB + 2 * VB) + wid * 64;
    const int q0 = qb * 256; const size_t row0 = (size_t)b * SEQ;
    const int qrow = q0 + wid * 32 + r32;
    const int qlast = q0 + wid * 32 + 31;
    bf16x8 qr[ND0];
    { const bf16_t* Qw = P.Q + (row0 + qrow) * P.ldq + h * DK + hi * 8;
#pragma unroll
      for (int d0 = 0; d0 < ND0; ++d0) qr[d0] = *(const bf16x8*)(Qw + d0 * 16); }
    const int sr = tid >> 3, sc = (tid & 7) * 8;
    const bf16_t* Kg = P.K + (row0 + sr) * P.ldk + h * DK + sc;
    const bf16_t* Vg = P.V + (row0 + sr) * P.ldv + h * DV + sc;
    const int vb0 = (int)(uintptr_t)Vl + v_rd_base(lane);
    const int NT = 4 * (qb + 1);
    unsigned selw = 0u; float alpha_b = 0.f;
    if (MODE == 2) { selw = P.sel[(row0 + qrow) * 8 + h]; alpha_b = LOG2E * __builtin_amdgcn_exp2f(-(float)(h + 1)); }
    const float* biasp = (MODE == 0) ? P.bias + (size_t)(b * 8 + h) * SEQ + 4 * hi : nullptr;
#define KEY0(j) ((MODE == 2) ? (((j) < 4) ? q0 + 64 * (j) : 64 * ((j) - 4)) : 64 * (j))
    bf16x8 ks[NKL], vs[NVL];
#define SLOAD(k0) do { _Pragma("unroll") for (int i_ = 0; i_ < NKL; ++i_) ks[i_] = *(const bf16x8*)(Kg + (size_t)(k0) * P.ldk + 64 * i_); \
                       _Pragma("unroll") for (int i_ = 0; i_ < NVL; ++i_) vs[i_] = *(const bf16x8*)(Vg + (size_t)(k0) * P.ldv + 64 * i_); } while (0)
#define SWRITE(bsel) do { _Pragma("unroll") for (int i_ = 0; i_ < NKL; ++i_) *(bf16x8*)(Kl + (bsel) * KB + sr * (DK * 2) + ((((sc + 64 * i_) * 2)) ^ ((sr & 7) << 4))) = ks[i_]; \
                          _Pragma("unroll") for (int i_ = 0; i_ < NVL; ++i_) *(bf16x8*)(Vl + (bsel) * VB + v_st<NCB>(sr, sc + 64 * i_)) = vs[i_]; } while (0)
    float m_reg = -1e30f, l_reg = 0.f; f32x16 o[NCB];
#pragma unroll
    for (int d = 0; d < NCB; ++d) o[d] = f32x16{};
    SLOAD(KEY0(0)); SWRITE(0);
    for (int j = 0; j < NT; ++j) {
        __syncthreads();
        const int key0 = KEY0(j); const int bsel = j & 1;
        if (j + 1 < NT) SLOAD(KEY0(j + 1));
        bool active = true;
        if (MODE == 2 && j >= 4) { active = __any((int)((selw >> ((j - 4) >> 2)) & 1u)); }
        else { active = key0 <= qlast; }
        if (active) {
            f32x16 p0 = f32x16{}, p1 = f32x16{};
            const char* Kb = Kl + bsel * KB;
#pragma unroll
            for (int d0 = 0; d0 < ND0; ++d0) { const int cb = (d0 * 16 + hi * 8) * 2;
                const bf16x8 b0 = *(const bf16x8*)(Kb + r32 * (DK * 2) + (cb ^ ((r32 & 7) << 4)));
                const bf16x8 b1 = *(const bf16x8*)(Kb + (32 + r32) * (DK * 2) + (cb ^ ((r32 & 7) << 4)));
                p0 = __builtin_amdgcn_mfma_f32_32x32x16_bf16(b0, qr[d0], p0, 0, 0, 0);
                p1 = __builtin_amdgcn_mfma_f32_32x32x16_bf16(b1, qr[d0], p1, 0, 0, 0); }
            if (MODE == 0) {
#pragma unroll
                for (int g = 0; g < 4; ++g) { const f32x4 b0 = *(const f32x4*)(biasp + key0 + 8 * g), b1 = *(const f32x4*)(biasp + key0 + 32 + 8 * g);
#pragma unroll
                    for (int i = 0; i < 4; ++i) { p0[4 * g + i] += b0[i]; p1[4 * g + i] += b1[i]; } }
            }
            if (MODE == 2) { const float kb = (float)(key0 - q0 + 4 * hi);
#pragma unroll
                for (int r = 0; r < 16; ++r) { const float kk = kb + (float)((r & 3) + 8 * (r >> 2)); p0[r] = __builtin_fmaf(alpha_b, kk, p0[r]); p1[r] = __builtin_fmaf(alpha_b, kk + 32.0f, p1[r]); } }
            if (MODE == 2 && j >= 4) { if (!((selw >> ((j - 4) >> 2)) & 1u)) {
#pragma unroll
                for (int r = 0; r < 16; ++r) { p0[r] = -INFINITY; p1[r] = -INFINITY; } } }
            else if (key0 + 63 > q0 + wid * 32) { const int kb = key0 + 4 * hi;
#pragma unroll
                for (int r = 0; r < 16; ++r) { const int kv = kb + (r & 3) + 8 * (r >> 2); if (kv > qrow) p0[r] = -INFINITY; if (kv + 32 > qrow) p1[r] = -INFINITY; } }
            float pmax = p0[0];
#pragma unroll
            for (int r = 1; r < 16; ++r) pmax = fmaxf(pmax, p0[r]);
#pragma unroll
            for (int r = 0; r < 16; ++r) pmax = fmaxf(pmax, p1[r]);
            { auto rr = __builtin_amdgcn_permlane32_swap(__float_as_uint(pmax), __float_as_uint(pmax), false, false); pmax = fmaxf(__uint_as_float(rr[0]), __uint_as_float(rr[1])); }
            if (!__all(pmax - m_reg <= THR)) {
                const float mn = fmaxf(m_reg, pmax); const float al = __builtin_amdgcn_exp2f(m_reg - mn); m_reg = mn; l_reg *= al;
                if (hi == 0) wsf[r32] = al; asm volatile("s_waitcnt lgkmcnt(0)" ::: "memory");
#pragma unroll
                for (int r = 0; r < 16; ++r) { const float a = wsf[crow(r, hi)];
#pragma unroll
                    for (int d = 0; d < NCB; ++d) o[d][r] *= a; }
            }
            float ps = 0.f;
#pragma unroll
            for (int r = 0; r < 16; ++r) { p0[r] = __builtin_amdgcn_exp2f(p0[r] - m_reg); p1[r] = __builtin_amdgcn_exp2f(p1[r] - m_reg); ps += p0[r] + p1[r]; }
            { auto rr = __builtin_amdgcn_permlane32_swap(__float_as_uint(ps), __float_as_uint(ps), false, false); ps = __uint_as_float(rr[0]) + __uint_as_float(rr[1]); }
            l_reg += ps;
            bf16x8 pa0, pa1, pa2, pa3;
#define PK4(Pv, BASE, OUT) do { unsigned a0 = cvt_pk_bf16(Pv[BASE + 0], Pv[BASE + 1]), a1 = cvt_pk_bf16(Pv[BASE + 2], Pv[BASE + 3]); \
    unsigned b0_ = cvt_pk_bf16(Pv[BASE + 4], Pv[BASE + 5]), b1_ = cvt_pk_bf16(Pv[BASE + 6], Pv[BASE + 7]); \
    auto r0 = __builtin_amdgcn_permlane32_swap(a0, b0_, false, false); auto r1 = __builtin_amdgcn_permlane32_swap(a1, b1_, false, false); \
    u32x4 w = {r0[0], r1[0], r0[1], r1[1]}; OUT = *reinterpret_cast<bf16x8*>(&w); } while (0)
            PK4(p0, 0, pa0); PK4(p0, 8, pa1); PK4(p1, 0, pa2); PK4(p1, 8, pa3);
#undef PK4
            const int vb = vb0 + bsel * VB;
            pv_one<NCB, 0>(o[0], vb, pa0, pa1, pa2, pa3); pv_one<NCB, 1>(o[1], vb, pa0, pa1, pa2, pa3);
            if constexpr (NCB == 4) { pv_one<NCB, 2>(o[2], vb, pa0, pa1, pa2, pa3); pv_one<NCB, 3>(o[3], vb, pa0, pa1, pa2, pa3); }
        }
        if (j + 1 < NT) SWRITE((j + 1) & 1);
    }
    if (hi == 0) wsf[32 + r32] = l_reg; asm volatile("s_waitcnt lgkmcnt(0)" ::: "memory");
    const size_t orow0 = row0 + q0 + wid * 32;
#pragma unroll
    for (int r = 0; r < 16; ++r) { const int orow = crow(r, hi); const float rl = __builtin_amdgcn_rcpf(wsf[32 + orow]); float ss = 0.f;
        float y[NCB];
#pragma unroll
        for (int d = 0; d < NCB; ++d) { y[d] = o[d][r] * rl; ss += y[d] * y[d]; }
#pragma unroll
        for (int sh = 1; sh < 32; sh <<= 1) ss += __shfl_xor(ss, sh);
        if (r32 == 0) P.SSQ[(orow0 + orow) * P.nh + h] = ss;
#pragma unroll
        for (int d = 0; d < NCB; ++d) { const size_t gi = (orow0 + orow) * P.ldg + h * DV + d * 32 + r32; const float gt = bf2f(P.G[gi]);
            const size_t oi = (orow0 + orow) * P.ldo + h * DV + d * 32 + r32; P.O[oi] = (bf16_t)(cvt_pk_bf16(y[d] * gt, 0.f) & 0xffffu); } }
    __syncthreads();
#undef KEY0
#undef SLOAD
#undef SWRITE
}


#define XB_TMO      128
#define XB_XCNT(j)  (256  + 64 * (j))
#define XB_XSUB(j)  (1280 + 64 * (j))
#define XB_XGEN(j)  (2304 + 64 * (j))
#define XB_TOP      3328
#define XB_TOPGEN   3392
#define XCD_BAR_WORDS 3456
#define XB_SPIN_CAP (1u << 18)
__device__ __forceinline__ unsigned xb_ld(unsigned* p)              { return __hip_atomic_load(p, __ATOMIC_RELAXED, __HIP_MEMORY_SCOPE_AGENT); }
__device__ __forceinline__ unsigned xb_add(unsigned* p, unsigned v) { return __hip_atomic_fetch_add(p, v, __ATOMIC_RELAXED, __HIP_MEMORY_SCOPE_AGENT); }
__device__ __forceinline__ unsigned xb_xcc_id() { return (unsigned)__builtin_amdgcn_s_getreg((3 << 11) | 20) & 0xFu; }
#define XB_SPIN(cond, bar) do { unsigned _sp = 0; while (cond) { __builtin_amdgcn_s_sleep(1); \
    if ((++_sp & 255u) == 0u) { if (xb_ld(&(bar)[XB_TMO])) break; if (_sp > XB_SPIN_CAP) { atomicAdd(&(bar)[XB_TMO], 1u); break; } } } } while (0)
struct XcdBarrier { unsigned* bar; unsigned x; volatile LAS unsigned* st; };
__device__ __forceinline__ XcdBarrier xcd_barrier_post(unsigned* bar, volatile LAS unsigned* st) {
    XcdBarrier b; b.bar = bar; b.x = xb_xcc_id(); b.st = st;
    if (threadIdx.x == 0) (void)xb_add(&bar[XB_XCNT(b.x)], 1u);
    return b;
}
__device__ __forceinline__ void xcd_barrier_complete(unsigned* bar, unsigned x, unsigned& nloc, unsigned& nx) {
    const unsigned G = gridDim.x * gridDim.y * gridDim.z;
    unsigned sum, cnt, mine, sp = 0u;
    for (;;) {
        sum = 0u; cnt = 0u; mine = 0u;
#pragma unroll
        for (unsigned j = 0; j < 16; ++j) { const unsigned c = xb_ld(&bar[XB_XCNT(j)]); sum += c; cnt += (c > 0u) ? 1u : 0u; mine = (j == x) ? c : mine; }
        if (sum == G) break;
        __builtin_amdgcn_s_sleep(1);
        if ((++sp & 255u) == 0u) { if (xb_ld(&bar[XB_TMO])) break; if (sp > XB_SPIN_CAP) { atomicAdd(&bar[XB_TMO], 1u); break; } }
    }
    nloc = mine > 0u ? mine : 1u; nx = cnt > 0u ? cnt : 1u;
}
__device__ __forceinline__ void xcd_barrier(const XcdBarrier& b) {
    asm volatile("s_waitcnt vmcnt(0)" ::: "memory");
    __syncthreads();
    if (threadIdx.x == 0) {
        unsigned* bar = b.bar;
        __builtin_amdgcn_s_waitcnt(0);
        unsigned nloc = b.st[0], nx = b.st[1];
        if (nloc == 0u) { xcd_barrier_complete(bar, b.x, nloc, nx); b.st[0] = nloc; b.st[1] = nx; }
        const unsigned old = xb_add(&bar[XB_XSUB(b.x)], 1u);
        const unsigned gen = old / nloc;
        if (old + 1u == (gen + 1u) * nloc) {
            __builtin_amdgcn_fence(__ATOMIC_RELEASE, "agent");
            asm volatile("s_waitcnt vmcnt(0)" ::: "memory");
            const unsigned og = xb_add(&bar[XB_TOP], 1u);
            const unsigned tg = og / nx;
            if (og + 1u == (tg + 1u) * nx) xb_add(&bar[XB_TOPGEN], 1u);
            else XB_SPIN(xb_ld(&bar[XB_TOPGEN]) == tg, bar);
            __builtin_amdgcn_fence(__ATOMIC_ACQUIRE, "agent");
            xb_add(&bar[XB_XGEN(b.x)], 1u);
            asm volatile("s_waitcnt vmcnt(0)" ::: "memory");
        } else {
            XB_SPIN(xb_ld(&bar[XB_XGEN(b.x)]) == gen, bar);
            __builtin_amdgcn_fence(__ATOMIC_ACQUIRE, "agent");
            asm volatile("s_waitcnt vmcnt(0)" ::: "memory");
        }
    }
    __syncthreads();
}
constexpr int CW_BAR = 4096;

struct UTab { unsigned short v[2560]; };
constexpr UTab make_utab() {
    UTab t{}; int k = 0;
    for (int c = 80; c >= 1; --c) {
        if (c % 5 == 0 && c / 5 <= 16) { const int qb = c / 5 - 1; for (int b = 0; b < 8; ++b) for (int h = 0; h < 4; ++h) t.v[k++] = (unsigned short)((1 << 12) | (b << 8) | (h << 4) | qb); }
        if (c % 2 == 0 && c / 2 <= 16) { const int qb = c / 2 - 1; for (int ty = 0; ty <= 2; ty += 2) for (int b = 0; b < 8; ++b) for (int h = 0; h < 8; ++h) t.v[k++] = (unsigned short)((ty << 12) | (b << 8) | (h << 4) | qb); }
    }
    return t;
}
__device__ const UTab g_utab = make_utab();
constexpr int N_ATT_UNITS = 2560;

struct Args { const float* in[11]; float* out; unsigned char* ws; int ph_lo, ph_hi, coop, pad; };
#ifndef PHM
#define PHM 127
#endif
#ifndef B1M
#define B1M 31
#endif
#ifndef DBL
#define DBL 0
#endif
constexpr int NPHASES = 13;

__device__ __forceinline__ int src_in(int n) {
    const int t = n >> 8, j = n & 255;
    if (t < 6) return n;
    if (t < 8) return 1544 + (n - 1536);
    if (t == 8) return 2056 + j;
    if (t == 9) return j < 128 ? 2312 + j : (j < 192 ? 2440 + (j - 128) : (j < 200 ? 1536 + (j - 192) : -1));
    if (t < 12) return 2504 + (n - 2560);
    return 3016 + (n - 3072);
}
__device__ __forceinline__ int src_uq(int n) {
    if (n < 512) return (n >> 7) * 192 + (n & 127);
    const int p = n - 512; return p < 128 ? (p >> 5) * 192 + 128 + (p & 31) : ((p - 128) >> 5) * 192 + 160 + ((p - 128) & 31);
}
__device__ __forceinline__ int src_ukv(int n) {
    return n < 512 ? (n >> 7) * 256 + (n & 127) : ((n - 512) >> 7) * 256 + 128 + ((n - 512) & 127);
}
__device__ __forceinline__ void transpose_item(const float* W, int Ksrc, int Nsrc, const float* gain, bf16_t* WT, int Kdst, int mat, LAS float* scr, int kb, int nb, int lane) {
    const int k0 = 64 * kb, n0 = 32 * nb; const int nn = n0 + (lane & 31);
    const int sc = (mat == 0) ? src_in(nn) : (mat == 1) ? src_uq(nn) : (mat == 2) ? src_ukv(nn) : nn;
#pragma unroll 8
    for (int i = 0; i < 32; ++i) { const int kk = 2 * i + (lane >> 5); const int k = k0 + kk;
        float v = 0.f; if (sc >= 0 && k < Ksrc) v = W[(size_t)k * Nsrc + sc] * gain[k];
        scr[kk * 33 + (lane & 31)] = v; }
    asm volatile("s_waitcnt lgkmcnt(0)" ::: "memory");
    const int c = lane & 7;
#pragma unroll
    for (int j = 0; j < 4; ++j) { const int n = (lane >> 3) + 8 * j; const LAS float* s = scr + (8 * c) * 33 + n;
        u32x4 o; o.x = cvt_pk_bf16(s[0 * 33], s[1 * 33]); o.y = cvt_pk_bf16(s[2 * 33], s[3 * 33]); o.z = cvt_pk_bf16(s[4 * 33], s[5 * 33]); o.w = cvt_pk_bf16(s[6 * 33], s[7 * 33]);
        *(u32x4*)(WT + (size_t)(n0 + n) * Kdst + k0 + 8 * c) = o; }
    asm volatile("s_waitcnt lgkmcnt(0)" ::: "memory");
}

__device__ __forceinline__ float log_sigmoid_f(float x) { return fminf(x, 0.f) - log1pf(expf(-fabsf(x))); }

__device__ __forceinline__ void phase_p0(const Args& args, const int layer, LAS unsigned char* lds, unsigned char* lds_raw, const int G, const int bid) {
    unsigned char* ws = args.ws; asm volatile("" : "+s"(ws));
    int tid = threadIdx.x; asm volatile("" : "+v"(tid));
    const int lane = tid & 63, wave = __builtin_amdgcn_readfirstlane(tid >> 6);
    const int gw = bid * NWAVES + wave, NGW = G * NWAVES;
    unsigned char* wl = ws + WS_W + (size_t)layer * W_LAYER;
    (void)lane; (void)gw; (void)NGW; (void)wl; (void)lds_raw;
            LAS float* scr = (LAS float*)(lds + wave * 16384);
            constexpr int I_IN = 16 * 160, I_UQ = 4 * 24, I_UKV = 4 * 32, I_OUT = 24 * 32, I_L = I_IN + I_UQ + I_UKV + I_OUT;
            for (int it = gw; it < 2 * I_L; it += NGW) {
                const int l = it / I_L; int r = it % I_L; unsigned char* w = ws + WS_W + (size_t)l * W_LAYER;
                if (r < I_IN) { transpose_item(args.in[2] + (size_t)l * DM * D_IN, DM, D_IN, args.in[1] + l * DM, (bf16_t*)(w + W_IN_OFF), DM, 0, scr, r / 160, r % 160, lane); continue; } r -= I_IN;
                if (r < I_UQ) { transpose_item(args.in[5] + (size_t)l * 256 * 768, 256, 768, args.in[4] + l * 256, (bf16_t*)(w + W_UQ_OFF), 256, 1, scr, r / 24, r % 24, lane); continue; } r -= I_UQ;
                if (r < I_UKV) { transpose_item(args.in[7] + (size_t)l * 128 * 1024, 128, 1024, args.in[6] + l * 128, (bf16_t*)(w + W_UKV_OFF), 256, 2, scr, r / 32, r % 32, lane); continue; } r -= I_UKV;
                transpose_item(args.in[9] + (size_t)l * DMIX * DM, DMIX, DM, args.in[8] + l * DMIX, (bf16_t*)(w + W_OUT_OFF), DMIX, 3, scr, r / 32, r % 32, lane);
            }
            { const float* x = args.in[0]; bf16_t* XB = (bf16_t*)(ws + WS_XB); float* RSX = (float*)(ws + WS_RSX);
              for (int m = gw; m < T; m += NGW) { const f32x4* xr = (const f32x4*)(x + (size_t)m * DM) + lane; f32x4 v[4]; float s = 0.f;
#pragma unroll
                  for (int j = 0; j < 4; ++j) { v[j] = xr[64 * j]; s += dot4(v[j]); }
                  s = wave_sum(s);
                  u32x2* o8 = (u32x2*)(XB + (size_t)m * DM) + lane;
#pragma unroll
                  for (int j = 0; j < 4; ++j) { u32x2 w; w.x = cvt_pk_bf16(v[j][0], v[j][1]); w.y = cvt_pk_bf16(v[j][2], v[j][3]); o8[64 * j] = w; }
                  if (lane == 0) RSX[m] = rsqrtf(s * (1.0f / 1024.0f) + EPS); } }
            { float* COS = (float*)(ws + WS_ROPE); float* SIN = COS + SEQ * 32;
              for (int i = bid * NTHREADS + tid; i < SEQ * 32; i += G * NTHREADS) { const int t = i >> 5, f = i & 31;
                  const float inv = powf(10000.0f, -(float)(2 * f) / 64.0f); const float ang = (float)t * inv;
                  COS[i] = (float)cos((double)ang); SIN[i] = (float)sin((double)ang); } }
}

__device__ __forceinline__ void phase_a(const Args& args, const int layer, LAS unsigned char* lds, unsigned char* lds_raw, const int G, const int bid) {
    unsigned char* ws = args.ws; asm volatile("" : "+s"(ws));
    int tid = threadIdx.x; asm volatile("" : "+v"(tid));
    const int lane = tid & 63, wave = __builtin_amdgcn_readfirstlane(tid >> 6);
    const int gw = bid * NWAVES + wave, NGW = G * NWAVES;
    unsigned char* wl = ws + WS_W + (size_t)layer * W_LAYER;
    (void)lane; (void)gw; (void)NGW; (void)wl; (void)lds_raw;
            pg8::Gemm g{(const bf16_t*)(ws + WS_XB), (const bf16_t*)(wl + W_IN_OFF), T, NIN, DM, DM}; pg8::StaticOrder S; S.init(T, NIN, G, bid);
            EpiA E{ws, (LAS float*)(lds + SIDE_OFF), args.in[3] + layer * 8};
            pg8::gemm_phase<EpiA, true>(lds, g, S, E);
}

__device__ __forceinline__ void phase_b1(const Args& args, const int layer, LAS unsigned char* lds, unsigned char* lds_raw, const int G, const int bid) {
    unsigned char* ws = args.ws; asm volatile("" : "+s"(ws));
    int tid = threadIdx.x; asm volatile("" : "+v"(tid));
    const int lane = tid & 63, wave = __builtin_amdgcn_readfirstlane(tid >> 6);
    const int gw = bid * NWAVES + wave, NGW = G * NWAVES;
    unsigned char* wl = ws + WS_W + (size_t)layer * W_LAYER;
    (void)lane; (void)gw; (void)NGW; (void)wl; (void)lds_raw;
            if (B1M & 1) { pg8::Gemm g{(const bf16_t*)(ws + WS_QG) + 512, (const bf16_t*)(wl + W_UQ_OFF), T, 768, 256, 1536}; pg8::StaticOrder S; S.init(T, 768, G, bid);
              EpiQ E{ws}; pg8::gemm_phase<EpiQ, true>(lds, g, S, E); }
            if (B1M & 2) { pg8::Gemm g{(const bf16_t*)(ws + WS_QG) + 768, (const bf16_t*)(wl + W_UKV_OFF), T, 1024, 256, 1536}; pg8::StaticOrder S; S.init(T, 1024, G, bid);
              EpiKV E{ws}; pg8::gemm_phase<EpiKV, true>(lds, g, S, E); }
            if (B1M & 4) { const float* KRF = (const float*)(ws + WS_KRF); bf16_t* KM = (bf16_t*)(ws + WS_KM); const float* COS = (const float*)(ws + WS_ROPE); const float* SIN = COS + SEQ * 32;
              for (int i = bid * NTHREADS + tid; i < T * 8; i += G * NTHREADS) { const int t = i >> 3, c4 = (i & 7) * 4; const int tp = t & (SEQ - 1);
                  const f32x4 x1 = *(const f32x4*)(KRF + (size_t)t * 64 + c4), x2 = *(const f32x4*)(KRF + (size_t)t * 64 + 32 + c4);
                  const f32x4 c = *(const f32x4*)(COS + tp * 32 + c4), s = *(const f32x4*)(SIN + tp * 32 + c4);
                  const f32x4 o1 = x1 * c - x2 * s, o2 = x2 * c + x1 * s;
                  u32x2 w1, w2; w1.x = cvt_pk_bf16(o1[0], o1[1]); w1.y = cvt_pk_bf16(o1[2], o1[3]); w2.x = cvt_pk_bf16(o2[0], o2[1]); w2.y = cvt_pk_bf16(o2[2], o2[3]);
#pragma unroll
                  for (int hh = 0; hh < 4; ++hh) { bf16_t* p = KM + (size_t)t * 768 + hh * 192 + 128 + c4; *(u32x2*)p = w1; *(u32x2*)(p + 32) = w2; } } }
            if (B1M & 8) { const float* FFL = (const float*)(ws + WS_FFL); float* BF = (float*)(ws + WS_BIASF); LAS float* xs = (LAS float*)lds;
              for (int b = bid; b < BATCH; b += G) {
                  const float* src = FFL + ((size_t)b * SEQ + tid * 8) * 8; float v[8][8];
#pragma unroll
                  for (int i = 0; i < 8; ++i) { const f32x4 a = *(const f32x4*)(src + i * 8), c = *(const f32x4*)(src + i * 8 + 4);
#pragma unroll
                      for (int e = 0; e < 4; ++e) { v[i][e] = a[e]; v[i][4 + e] = c[e]; } }
#pragma unroll
                  for (int i = 1; i < 8; ++i)
#pragma unroll
                      for (int h = 0; h < 8; ++h) v[i][h] += v[i - 1][h];
                  float off[8];
#pragma unroll
                  for (int h = 0; h < 8; ++h) { const float tot = v[7][h]; float incl = tot;
#pragma unroll
                      for (int o = 1; o < 64; o <<= 1) { const float n = __shfl_up(incl, o); if (lane >= o) incl += n; }
                      off[h] = incl - tot; if (lane == 63) xs[wave * 8 + h] = incl; }
                  __syncthreads();
#pragma unroll
                  for (int h = 0; h < 8; ++h) { float wo = 0.f; for (int w = 0; w < wave; ++w) wo += xs[w * 8 + h]; off[h] += wo; }
#pragma unroll
                  for (int h = 0; h < 8; ++h) { float* dst = BF + (size_t)(b * 8 + h) * SEQ + tid * 8; f32x4 o0, o1;
#pragma unroll
                      for (int e = 0; e < 4; ++e) { o0[e] = -LOG2E * (v[e][h] + off[h]); o1[e] = -LOG2E * (v[4 + e][h] + off[h]); }
                      *(f32x4*)dst = o0; *(f32x4*)(dst + 4) = o1; }
                  __syncthreads(); } }
            if (B1M & 16) { const float* KP = (const float*)(ws + WS_KPART); const bf16_t* QG = (const bf16_t*)(ws + WS_QG); unsigned* SEL = (unsigned*)(ws + WS_SEL);
              LAS float* km = (LAS float*)lds;
              for (int job = bid; job < 512; job += G) { const int b = job >> 6, h = (job >> 3) & 7, tb = job & 7;
                  __syncthreads();
                  for (int i = tid; i < 1024; i += NTHREADS) { const int n = i >> 6, d = i & 63; const float* p = KP + ((size_t)((b * 16 + n) * 2)) * 512 + h * 64 + d; km[i] = (p[0] + p[512]) * (1.0f / 256.0f); }
                  __syncthreads();
                  const int t = tb * 512 + tid; const int cur = t >> 8; const size_t row = (size_t)b * SEQ + t;
                  float q[64];
                  { const bf16x8* qp = (const bf16x8*)(QG + row * 1536 + 1024 + h * 64);
#pragma unroll
                    for (int c = 0; c < 8; ++c) { const bf16x8 v = qp[c];
#pragma unroll
                        for (int e = 0; e < 8; ++e) q[c * 8 + e] = bf2f((unsigned short)v[e]); } }
                  float g1 = -INFINITY, g2 = -INFINITY, g3 = -INFINITY; int i1 = -1, i2 = -1, i3 = -1;
                  for (int n = 0; n < cur; ++n) { float gsum = 0.f;
#pragma unroll
                      for (int d = 0; d < 64; ++d) gsum = __builtin_fmaf(q[d], km[n * 64 + d], gsum);
                      if (gsum > g1) { g3 = g2; i3 = i2; g2 = g1; i2 = i1; g1 = gsum; i1 = n; }
                      else if (gsum > g2) { g3 = g2; i3 = i2; g2 = gsum; i2 = n; }
                      else if (gsum > g3) { g3 = gsum; i3 = n; } }
                  unsigned m = 0u; if (i1 >= 0) m |= 1u << i1; if (i2 >= 0) m |= 1u << i2; if (i3 >= 0) m |= 1u << i3;
                  SEL[row * 8 + h] = m; }
              __syncthreads(); }
}

__device__ __forceinline__ void phase_b2(const Args& args, const int layer, LAS unsigned char* lds, unsigned char* lds_raw, const int G, const int bid) {
    unsigned char* ws = args.ws; asm volatile("" : "+s"(ws));
    int tid = threadIdx.x; asm volatile("" : "+v"(tid));
    const int lane = tid & 63, wave = __builtin_amdgcn_readfirstlane(tid >> 6);
    const int gw = bid * NWAVES + wave, NGW = G * NWAVES;
    unsigned char* wl = ws + WS_W + (size_t)layer * W_LAYER;
    (void)lane; (void)gw; (void)NGW; (void)wl; (void)lds_raw;
    volatile LAS unsigned* MISC = (volatile LAS unsigned*)(lds + MISC_OFF); unsigned* ctl = (unsigned*)(ws + WS_CTL);
            unsigned* qctr = ctl + CW_QCTR * (1 + layer);
            for (;;) {
                if (tid == 0) MISC[0] = __hip_atomic_fetch_add(qctr, 1u, __ATOMIC_RELAXED, __HIP_MEMORY_SCOPE_AGENT);
                __syncthreads();
                const unsigned k = MISC[0];
                __syncthreads();
                if (k >= (unsigned)N_ATT_UNITS) break;
                const unsigned e = g_utab.v[k]; const int ty = e >> 12, b = (e >> 8) & 7, h = (e >> 4) & 7, qb = e & 15;
                if (ty == 0) { const AttnP PF{(const bf16_t*)(ws + WS_QG), 1536, (const bf16_t*)(ws + WS_FK), 512, (const bf16_t*)(ws + WS_FV), 512, (bf16_t*)(ws + WS_QG), 1536,
                                   (const bf16_t*)(ws + WS_GATE), 1536, (float*)(ws + WS_SSQA), 8, (const float*)(ws + WS_BIASF), nullptr};
                    attn_unit<64, 64, 0>(PF, b, h, qb, (char*)lds_raw); }
                else if (ty == 1) { const AttnP PM{(const bf16_t*)(ws + WS_QM), 768, (const bf16_t*)(ws + WS_KM), 768, (const bf16_t*)(ws + WS_VM), 512, (bf16_t*)(ws + WS_QG) + 512, 1536,
                                   (const bf16_t*)(ws + WS_GATE) + 512, 1536, (float*)(ws + WS_SSQB), 4, nullptr, nullptr};
                    attn_unit<192, 128, 1>(PM, b, h, qb, (char*)lds_raw); }
                else { const AttnP PB{(const bf16_t*)(ws + WS_QG) + 1024, 1536, (const bf16_t*)(ws + WS_BK), 512, (const bf16_t*)(ws + WS_BV), 512, (bf16_t*)(ws + WS_QG) + 1024, 1536,
                                   (const bf16_t*)(ws + WS_GATE) + 1024, 1536, (float*)(ws + WS_SSQC), 8, nullptr, (const unsigned*)(ws + WS_SEL)};
                    attn_unit<64, 64, 2>(PB, b, h, qb, (char*)lds_raw); }
            }
}

__device__ __forceinline__ void phase_n(const Args& args, const int layer, LAS unsigned char* lds, unsigned char* lds_raw, const int G, const int bid) {
    unsigned char* ws = args.ws; asm volatile("" : "+s"(ws));
    int tid = threadIdx.x; asm volatile("" : "+v"(tid));
    const int lane = tid & 63, wave = __builtin_amdgcn_readfirstlane(tid >> 6);
    const int gw = bid * NWAVES + wave, NGW = G * NWAVES;
    unsigned char* wl = ws + WS_W + (size_t)layer * W_LAYER;
    (void)lane; (void)gw; (void)NGW; (void)wl; (void)lds_raw;
            bf16_t* Y = (bf16_t*)(ws + WS_QG); const float* SA = (const float*)(ws + WS_SSQA); const float* SB = (const float*)(ws + WS_SSQB); const float* SC = (const float*)(ws + WS_SSQC);
            for (int m = gw; m < T; m += NGW) {
                const f32x4 a0 = *(const f32x4*)(SA + (size_t)m * 8), a1 = *(const f32x4*)(SA + (size_t)m * 8 + 4), b0 = *(const f32x4*)(SB + (size_t)m * 4);
                const f32x4 c0 = *(const f32x4*)(SC + (size_t)m * 8), c1 = *(const f32x4*)(SC + (size_t)m * 8 + 4);
                const float ra = rsqrtf((sum4(a0) + sum4(a1)) * (1.0f / 512.0f) + EPS), rb = rsqrtf(sum4(b0) * (1.0f / 512.0f) + EPS), rc = rsqrtf((sum4(c0) + sum4(c1)) * (1.0f / 512.0f) + EPS);
                u32x4* yp = (u32x4*)(Y + (size_t)m * 1536);
#pragma unroll
                for (int j = 0; j < 3; ++j) { const float r = (j == 0) ? ra : (j == 1) ? rb : rc; u32x4 v = yp[64 * j + lane]; u32x4 o;
#pragma unroll
                    for (int e = 0; e < 4; ++e) { const unsigned w = v[e]; o[e] = cvt_pk_bf16(__uint_as_float(w << 16) * r, __uint_as_float(w & 0xffff0000u) * r); }
                    yp[64 * j + lane] = o; }
            }
}

__device__ __forceinline__ void phase_c(const Args& args, const int layer, LAS unsigned char* lds, unsigned char* lds_raw, const int G, const int bid) {
    unsigned char* ws = args.ws; asm volatile("" : "+s"(ws));
    int tid = threadIdx.x; asm volatile("" : "+v"(tid));
    const int lane = tid & 63, wave = __builtin_amdgcn_readfirstlane(tid >> 6);
    const int gw = bid * NWAVES + wave, NGW = G * NWAVES;
    unsigned char* wl = ws + WS_W + (size_t)layer * W_LAYER;
    (void)lane; (void)gw; (void)NGW; (void)wl; (void)lds_raw;
            pg8::Gemm g{(const bf16_t*)(ws + WS_QG), (const bf16_t*)(wl + W_OUT_OFF), T, DM, DMIX, DMIX}; pg8::StaticOrder S; S.init(T, DM, G, bid);
            EpiC E{layer == 0 ? args.in[0] : (const float*)args.out, args.out, ws, layer == DEPTH - 1 ? 1 : 0};
            pg8::gemm_phase<EpiC, true>(lds, g, S, E);
}

__device__ __forceinline__ void phase_r(const Args& args, const int layer, LAS unsigned char* lds, unsigned char* lds_raw, const int G, const int bid) {
    unsigned char* ws = args.ws; asm volatile("" : "+s"(ws));
    int tid = threadIdx.x; asm volatile("" : "+v"(tid));
    const int lane = tid & 63, wave = __builtin_amdgcn_readfirstlane(tid >> 6);
    const int gw = bid * NWAVES + wave, NGW = G * NWAVES;
    unsigned char* wl = ws + WS_W + (size_t)layer * W_LAYER;
    (void)lane; (void)gw; (void)NGW; (void)wl; (void)lds_raw;
            const float* SSX = (const float*)(ws + WS_SSX); float* RSX = (float*)(ws + WS_RSX);
            for (int m = bid * NTHREADS + tid; m < T; m += G * NTHREADS) { const f32x4* p = (const f32x4*)(SSX + (size_t)m * 16);
                const float sm = (sum4(p[0]) + sum4(p[1])) + (sum4(p[2]) + sum4(p[3])); RSX[m] = rsqrtf(sm * (1.0f / 1024.0f) + EPS); }
}

__device__ __forceinline__ void phase_f(const Args& args, const int layer, LAS unsigned char* lds, unsigned char* lds_raw, const int G, const int bid) {
    unsigned char* ws = args.ws; asm volatile("" : "+s"(ws));
    int tid = threadIdx.x; asm volatile("" : "+v"(tid));
    const int lane = tid & 63, wave = __builtin_amdgcn_readfirstlane(tid >> 6);
    const int gw = bid * NWAVES + wave, NGW = G * NWAVES;
    unsigned char* wl = ws + WS_W + (size_t)layer * W_LAYER;
    (void)lane; (void)gw; (void)NGW; (void)wl; (void)lds_raw;
            float* X = args.out; const float* gf = args.in[10];
            for (int m = gw; m < T; m += NGW) { f32x4* xr = (f32x4*)(X + (size_t)m * DM) + lane; f32x4 v[4]; float s = 0.f;
#pragma unroll
                for (int j = 0; j < 4; ++j) { v[j] = xr[64 * j]; s += dot4(v[j]); }
                const float r = rsqrtf(wave_sum(s) * (1.0f / 1024.0f) + EPS);
#pragma unroll
                for (int j = 0; j < 4; ++j) { const f32x4 gg = *((const f32x4*)gf + 64 * j + lane); xr[64 * j] = v[j] * r * gg; } }
}

__global__ void __launch_bounds__(NTHREADS, 2) fwd_kernel(Args args) {
    extern __shared__ __attribute__((aligned(16))) unsigned char lds_raw[];
    LAS unsigned char* lds = (LAS unsigned char*)lds_raw;
    const int G = gridDim.x, bid = blockIdx.x;
    const int lo = args.ph_lo, hi = args.ph_hi;
    volatile LAS unsigned* MISCW = (volatile LAS unsigned*)(lds + MISC_OFF);
    XcdBarrier xbar; xbar.bar = (unsigned*)(args.ws + WS_CTL) + CW_BAR; xbar.x = 0; xbar.st = MISCW + 8;
    if (args.coop) { if (threadIdx.x == 0) { MISCW[8] = 0u; MISCW[9] = 0u; } __syncthreads(); xbar = xcd_barrier_post((unsigned*)(args.ws + WS_CTL) + CW_BAR, MISCW + 8); }
#define IN(k) (lo <= (k) && (k) < hi)
#define SEAM(k) do { if (IN(k) && IN((k) + 1) && args.coop) { if ((k) == 0) cg::this_grid().sync(); else xcd_barrier(xbar); } } while (0)
    if (IN(0) && (PHM & 1)) phase_p0(args, 0, lds, lds_raw, G, bid);
    if (DBL & 1) { __syncthreads(); phase_p0(args, 0, lds, lds_raw, G, bid); }
    SEAM(0);
    if (IN(1) && (PHM & 2)) phase_a(args, 0, lds, lds_raw, G, bid);
    if (DBL & 2) { __syncthreads(); phase_a(args, 0, lds, lds_raw, G, bid); }
    SEAM(1);
    if (IN(2) && (PHM & 4)) phase_b1(args, 0, lds, lds_raw, G, bid);
    if (DBL & 4) { __syncthreads(); phase_b1(args, 0, lds, lds_raw, G, bid); }
    SEAM(2);
    if (IN(3) && (PHM & 8)) phase_b2(args, 0, lds, lds_raw, G, bid);
    SEAM(3);
    if (IN(4) && (PHM & 16)) phase_n(args, 0, lds, lds_raw, G, bid);
    SEAM(4);
    if (IN(5) && (PHM & 32)) phase_c(args, 0, lds, lds_raw, G, bid);
    if (DBL & 32) { __syncthreads(); phase_c(args, 0, lds, lds_raw, G, bid); }
    SEAM(5);
    if (IN(6)) phase_r(args, 0, lds, lds_raw, G, bid);
    SEAM(6);
    if (IN(7) && (PHM & 2)) phase_a(args, 1, lds, lds_raw, G, bid);
    SEAM(7);
    if (IN(8) && (PHM & 4)) phase_b1(args, 1, lds, lds_raw, G, bid);
    SEAM(8);
    if (IN(9) && (PHM & 8)) phase_b2(args, 1, lds, lds_raw, G, bid);
    SEAM(9);
    if (IN(10) && (PHM & 16)) phase_n(args, 1, lds, lds_raw, G, bid);
    SEAM(10);
    if (IN(11) && (PHM & 32)) phase_c(args, 1, lds, lds_raw, G, bid);
    SEAM(11);
    if (IN(12) && (PHM & 64)) phase_f(args, 0, lds, lds_raw, G, bid);
#undef IN
#undef SEAM
}

extern "C" void kernel_launch(void* const* d_in, const int* in_sizes, int n_in, void* d_out, int out_size, void* d_ws, size_t ws_size, hipStream_t stream) {
    static int grid = 0;
    if (grid == 0) {
        if (n_in != 11 || in_sizes[0] != T * DM || out_size != T * DM || ws_size < WS_END) {
            fprintf(stderr, "kernel_launch: shape mismatch (n_in %d, in0 %d, out %d, ws %zu; need ws >= %zu)\n", n_in, n_in > 0 ? in_sizes[0] : -1, out_size, ws_size, (size_t)WS_END); grid = -1; return; }
        int dev = 0, cus = 0, per_cu = 0;
        hipGetDevice(&dev); hipDeviceGetAttribute(&cus, hipDeviceAttributeMultiprocessorCount, dev);
        if (hipFuncSetAttribute((const void*)fwd_kernel, hipFuncAttributeMaxDynamicSharedMemorySize, LDS_BYTES) != hipSuccess) { fprintf(stderr, "kernel_launch: hipFuncSetAttribute failed\n"); grid = -1; return; }
        hipOccupancyMaxActiveBlocksPerMultiprocessor(&per_cu, (const void*)fwd_kernel, NTHREADS, LDS_BYTES);
        (void)hipGetLastError();
        if (per_cu < 1) { fprintf(stderr, "kernel_launch: occupancy query says %d blocks/CU\n", per_cu); per_cu = 1; }
        grid = cus * 1;
    }
    if (grid < 0) return;
    hipMemsetAsync((char*)d_ws + WS_CTL, 0, CTL_ZERO_BYTES, stream);
    Args a{};
    for (int i = 0; i < 11; ++i) a.in[i] = (const float*)d_in[i];
    a.out = (float*)d_out; a.ws = (unsigned char*)d_ws;
#ifndef ONE_LAUNCH
#define ONE_LAUNCH 1
#endif
    if (ONE_LAUNCH) {
        a.ph_lo = 0; a.ph_hi = NPHASES; a.coop = 1;
        void* kargs[] = {&a};
        hipError_t e = hipLaunchCooperativeKernel((const void*)fwd_kernel, dim3(grid), dim3(NTHREADS), kargs, LDS_BYTES, stream);
        if (e != hipSuccess) fprintf(stderr, "kernel_launch: cooperative launch failed: %s (grid %d)\n", hipGetErrorString(e), grid);
    } else {
        for (int ph = 0; ph < NPHASES; ++ph) { a.ph_lo = ph; a.ph_hi = ph + 1; a.coop = 0;
            hipLaunchKernelGGL(fwd_kernel, dim3(grid), dim3(NTHREADS), LDS_BYTES, stream, a); }
    }
}
```

```cpp
#include <hip/hip_runtime.h>
#include <hip/hip_cooperative_groups.h>
#include <cstdio>
#include <cstdint>
#include <cmath>
namespace cg = cooperative_groups;

#define LAS __attribute__((address_space(3)))
typedef unsigned short bf16_t;
typedef short bf16x8 __attribute__((ext_vector_type(8)));
typedef short s16x4 __attribute__((ext_vector_type(4)));
typedef float f32x4 __attribute__((ext_vector_type(4)));
typedef float f32x2 __attribute__((ext_vector_type(2)));
typedef float f32x16 __attribute__((ext_vector_type(16)));
typedef unsigned u32x4 __attribute__((ext_vector_type(4)));
typedef unsigned u32x2 __attribute__((ext_vector_type(2)));

constexpr int BATCH = 8, SEQ = 4096, T = BATCH * SEQ, DM = 1024, DEPTH = 2;
constexpr int D_IN = 5064, NIN = 5120, DMIX = 1536;
constexpr float EPS = 1e-6f, LOG2E = 1.4426950408889634f;
constexpr float C2_64 = 0.125f * LOG2E;
constexpr float C2_192 = 0.07216878364870323f * LOG2E;
constexpr int NWAVES = 8, NTHREADS = 512;

constexpr size_t MiB = 1u << 20;
constexpr size_t WS_CTL = 0, CTL_ZERO_BYTES = 1 * MiB;
constexpr size_t WS_SSX = 1 * MiB;
constexpr size_t WS_KRF = 3 * MiB;
constexpr size_t WS_FFL = 11 * MiB;
constexpr size_t WS_RSCQ = 12 * MiB;
constexpr size_t WS_RSCKV = 12 * MiB + 256 * 1024;
constexpr size_t WS_RSX = 12 * MiB + 512 * 1024;
constexpr size_t WS_KPART = 13 * MiB;
constexpr size_t WS_BIASF = 14 * MiB;
constexpr size_t WS_SEL = 15 * MiB;
constexpr size_t WS_SSQA = 16 * MiB;
constexpr size_t WS_SSQB = 17 * MiB;
constexpr size_t WS_SSQC = 18 * MiB;
constexpr size_t WS_JSTART = 18 * MiB + 768 * 1024;
constexpr size_t WS_ROPE = 19 * MiB;
constexpr size_t WS_W = 24 * MiB, W_LAYER = 14 * MiB;
constexpr size_t W_IN_OFF = 0, W_UQ_OFF = 10 * MiB, W_UKV_OFF = 10 * MiB + 512 * 1024, W_OUT_OFF = 11 * MiB;
constexpr size_t WS_QG = 56 * MiB;
constexpr size_t WS_GATE = 152 * MiB;
constexpr size_t WS_FK = 248 * MiB, WS_FV = 280 * MiB, WS_BK = 312 * MiB, WS_BV = 344 * MiB;
constexpr size_t WS_R2 = 376 * MiB;
constexpr size_t WS_XB = WS_R2, WS_QM = WS_R2, WS_KM = WS_R2 + 48 * MiB, WS_VM = WS_R2 + 96 * MiB;
constexpr size_t WS_END = 504 * MiB;
constexpr int CW_NRM = 8192;
constexpr int CW_QCTR = 64;

constexpr int RING_BYTES = 131072, MISC_OFF = RING_BYTES + 256, SIDE_OFF = RING_BYTES + 1024  , LDS_BYTES = 147456;

__device__ __forceinline__ unsigned cvt_pk_bf16(float lo, float hi) { unsigned r; asm volatile("v_cvt_pk_bf16_f32 %0, %1, %2" : "=v"(r) : "v"(lo), "v"(hi)); return r; }
__device__ __forceinline__ float bf2f(unsigned short b) { return __uint_as_float(((unsigned)b) << 16); }
__device__ __forceinline__ void store8_bf16(bf16_t* p, f32x4 a, f32x4 b) {
    u32x4 w; w.x = cvt_pk_bf16(a[0], a[1]); w.y = cvt_pk_bf16(a[2], a[3]); w.z = cvt_pk_bf16(b[0], b[1]); w.w = cvt_pk_bf16(b[2], b[3]); *(u32x4*)p = w; }
__device__ __forceinline__ float silu_f(float v) { return v * __builtin_amdgcn_rcpf(1.0f + __builtin_amdgcn_exp2f(-v * LOG2E)); }
__device__ __forceinline__ f32x4 silu4(f32x4 v) { f32x4 o; o[0] = silu_f(v[0]); o[1] = silu_f(v[1]); o[2] = silu_f(v[2]); o[3] = silu_f(v[3]); return o; }
__device__ __forceinline__ float wave_sum(float v) {
#pragma unroll
    for (int o = 1; o < 64; o <<= 1) v += __shfl_xor(v, o);
    return v;
}
__device__ __forceinline__ float log_sigmoid_fast(float x) { return -0.6931471805599453f * __builtin_amdgcn_logf(1.0f + __builtin_amdgcn_exp2f(-x * LOG2E)); }
__device__ __forceinline__ float sum4(f32x4 a) { return (a[0] + a[1]) + (a[2] + a[3]); }
__device__ __forceinline__ float dot4(f32x4 a) { return (a[0] * a[0] + a[1] * a[1]) + (a[2] * a[2] + a[3] * a[3]); }

namespace pg8 {
constexpr int BM = 256, BK = 64, HALF = 128, HTB = HALF * BK * 2, STAGE_BYTES = 8 * HTB, NXCD = 8, WGM = 8;
__host__ __device__ __forceinline__ int lds_byte(int r, int c) { const int st = (r >> 4) * 2 + (c >> 5), rr = r & 15, cc = c & 31, ob = rr * 64 + cc * 2; return st * 1024 + (ob ^ (((ob >> 9) & 1) << 5)); }
__host__ __device__ __forceinline__ void stage_rc(int b, int& R, int& C) { const int st = b / 1024, sb = b % 1024, swz = sb ^ (((sb >> 9) & 1) << 5); R = (st >> 1) * 16 + swz / 64; C = (st & 1) * 32 + (swz % 64) / 2; }
__host__ __device__ __forceinline__ int perm32(int rho) { const int n = rho >> 4, i = rho & 15; return 8 * (i >> 2) + 4 * n + (i & 3); }

struct Unit { int pm, pn; };
struct Gemm { const bf16_t* A; const bf16_t* Bt; int M, N, K, lda; };

struct StaticOrder {
    int nM, nN, nwg, G, c;
    __host__ __device__ void init(int M, int N, int G_, int c_) { nM = M / BM; nN = N / BM; nwg = nM * nN; G = G_; c = c_; }
    __host__ __device__ bool next(int i, Unit& u) const {
        const long L = (long)i * G + c; if (L >= nwg) return false;
        int wgid = (int)L; { const int q = nwg / NXCD, r = nwg % NXCD, xcd = wgid % NXCD, off = wgid / NXCD; wgid = (xcd < r ? xcd * (q + 1) : r * (q + 1) + (xcd - r) * q) + off; }
        const int nig = WGM * nN, gid = wgid / nig, fm = gid * WGM, gsz = (nM - fm) < WGM ? (nM - fm) : WGM;
        u.pm = fm + ((wgid % nig) % gsz); u.pn = (wgid % nig) / gsz; return true;
    }
};

template <class Epi, bool ALIGN_EPI>
__device__ __forceinline__ void gemm_phase(LAS unsigned char* lds, const Gemm g, const StaticOrder& S, const Epi& E) {
    int tid_ = threadIdx.x; asm volatile("" : "+v"(tid_));
    const int tid = tid_, wid = __builtin_amdgcn_readfirstlane(tid >> 6), lane = tid & 63, wr = wid >> 2, wc = wid & 3, fr = lane & 15, fq = lane >> 4;
    const int K = g.K, nt = K / BK, lda = g.lda;
    unsigned voffA[2], voffB[2];
#pragma unroll
    for (int i = 0; i < 2; ++i) { int R, C; stage_rc(tid * 16 + i * 8192, R, C); const int Rb = Epi::PERM ? ((R & ~31) + perm32(R & 31)) : R;
        voffA[i] = (unsigned)(R * lda + C) * 2u; voffB[i] = (unsigned)(Rb * K + C) * 2u; }
    const size_t kstep = (size_t)(BK * 2);
    const size_t hstepA = (size_t)HALF * lda * 2, hstepB = (size_t)HALF * K * 2;
    const size_t tstepA = 2 * hstepA, tstepB = 2 * hstepB;
    const unsigned ldsw = (unsigned)wid * 1024u;
    const int aoff = lds_byte(wr * 64 + fr, fq * 8), boff = lds_byte(wc * 32 + fr, fq * 8);
#define PG8_SA(b, h) (((b) * 2 + (h)) * HTB)
#define PG8_SB(b, h) ((4 + (b) * 2 + (h)) * HTB)
#define PG8_STAGE(bufoff, gbase, voff) do { _Pragma("unroll") for (int _i = 0; _i < 2; ++_i) \
        __builtin_amdgcn_global_load_lds((const unsigned*)((const char*)(gbase) + (voff)[_i]), (LAS unsigned*)(lds + (bufoff) + ldsw + _i * 8192), 16, 0, 0); } while (0)
#define PG8_LDA(dst, b, h) do { _Pragma("unroll") for (int m = 0; m < 4; ++m) _Pragma("unroll") for (int k = 0; k < 2; ++k) dst[m][k] = *(const LAS bf16x8*)(lds + PG8_SA(b, h) + aoff + m * 2048 + k * 1024); } while (0)
#define PG8_LDB(dst, b, h) do { _Pragma("unroll") for (int n = 0; n < 2; ++n) _Pragma("unroll") for (int k = 0; k < 2; ++k) dst[n][k] = *(const LAS bf16x8*)(lds + PG8_SB(b, h) + boff + n * 2048 + k * 1024); } while (0)
#define PG8_MMA(ai, bj, At, Bt) do { __builtin_amdgcn_s_setprio(1); _Pragma("unroll") for (int m = 0; m < 4; ++m) _Pragma("unroll") for (int n = 0; n < 2; ++n) _Pragma("unroll") for (int k = 0; k < 2; ++k) \
        acc[ai][bj][m][n] = __builtin_amdgcn_mfma_f32_16x16x32_bf16(Bt[n][k], At[m][k], acc[ai][bj][m][n], 0, 0, 0); __builtin_amdgcn_s_setprio(0); } while (0)
#define PG8_WAIT_V(n) asm volatile("s_waitcnt vmcnt(" #n ")" ::: "memory")
#define PG8_WAIT_L(n) asm volatile("s_waitcnt lgkmcnt(" #n ")" ::: "memory")
#define PG8_BAR __builtin_amdgcn_s_barrier()
#define PG8_SCHED __builtin_amdgcn_sched_barrier(0)
    Unit cur, nxt; int ui = 0;
    if (!S.next(0, cur)) return;
    f32x4 acc[2][2][4][2];
#pragma unroll
    for (int a = 0; a < 2; ++a)
#pragma unroll
        for (int b = 0; b < 2; ++b)
#pragma unroll
            for (int m = 0; m < 4; ++m)
#pragma unroll
                for (int n = 0; n < 2; ++n) acc[a][b][m][n] = (f32x4){0.f, 0.f, 0.f, 0.f};
    bf16x8 At[4][2], B0[2][2], B1[2][2];
    const char* cA = (const char*)g.A + (size_t)cur.pm * tstepA; const char* cB = (const char*)g.Bt + (size_t)cur.pn * tstepB;
    PG8_STAGE(PG8_SB(0, 0), cB, voffB); PG8_STAGE(PG8_SB(0, 1), cB + hstepB, voffB); PG8_STAGE(PG8_SA(0, 0), cA, voffA); PG8_STAGE(PG8_SA(0, 1), cA + hstepA, voffA);
    if (wr == 1) PG8_BAR;
    PG8_WAIT_V(2); PG8_BAR;
    PG8_STAGE(PG8_SB(1, 0), cB + kstep, voffB); PG8_STAGE(PG8_SA(1, 0), cA + kstep, voffA); PG8_STAGE(PG8_SB(1, 1), cB + hstepB + kstep, voffB);
    PG8_WAIT_V(6); PG8_BAR;
    for (;;) {
        const bool has_next = S.next(ui + 1, nxt);
        const char* nA = has_next ? (const char*)g.A + (size_t)nxt.pm * tstepA : cA; const char* nB = has_next ? (const char*)g.Bt + (size_t)nxt.pn * tstepB : cB;
#pragma unroll 1
        for (int t = 0; t < nt; t += 2) {
            const bool last = (t == nt - 2);
            const char* a1 = cA + (size_t)(t + 1) * kstep;
            const char* a2 = last ? nA : cA + (size_t)(t + 2) * kstep; const char* b2 = last ? nB : cB + (size_t)(t + 2) * kstep;
            const char* a3 = a2 + kstep; const char* b3 = b2 + kstep;
            PG8_LDB(B0, 0, 0); PG8_LDB(B1, 0, 1); PG8_SCHED; PG8_LDA(At, 0, 0); PG8_STAGE(PG8_SA(1, 1), a1 + hstepA, voffA);
            PG8_WAIT_V(8); PG8_WAIT_L(0); PG8_BAR; PG8_MMA(0, 0, At, B0); PG8_MMA(0, 1, At, B1); PG8_BAR; PG8_SCHED;
            PG8_LDA(At, 0, 1); PG8_STAGE(PG8_SB(0, 0), b2, voffB); PG8_STAGE(PG8_SB(0, 1), b2 + hstepB, voffB); PG8_STAGE(PG8_SA(0, 0), a2, voffA);
            PG8_WAIT_V(8); PG8_WAIT_L(0); PG8_BAR; PG8_MMA(1, 0, At, B0); PG8_MMA(1, 1, At, B1); PG8_BAR; PG8_SCHED;
            PG8_LDB(B0, 1, 0); PG8_LDB(B1, 1, 1); PG8_SCHED; PG8_LDA(At, 1, 0); PG8_STAGE(PG8_SA(0, 1), a2 + hstepA, voffA);
            PG8_WAIT_V(8); PG8_WAIT_L(0); PG8_BAR; PG8_MMA(0, 0, At, B0); PG8_MMA(0, 1, At, B1); PG8_BAR; PG8_SCHED;
            PG8_LDA(At, 1, 1); PG8_STAGE(PG8_SB(1, 0), b3, voffB); PG8_STAGE(PG8_SB(1, 1), b3 + hstepB, voffB); PG8_STAGE(PG8_SA(1, 0), a3, voffA);
            PG8_WAIT_V(8); PG8_WAIT_L(0); PG8_BAR; PG8_MMA(1, 0, At, B0); PG8_MMA(1, 1, At, B1); PG8_BAR; PG8_SCHED;
        }
        if constexpr (ALIGN_EPI) { if (wr == 0) PG8_BAR; }
        E(acc, cur, wr, wc, fr, fq);
        if (!has_next) break;
#pragma unroll
        for (int a = 0; a < 2; ++a)
#pragma unroll
            for (int b = 0; b < 2; ++b)
#pragma unroll
                for (int m = 0; m < 4; ++m)
#pragma unroll
                    for (int n = 0; n < 2; ++n) acc[a][b][m][n] = (f32x4){0.f, 0.f, 0.f, 0.f};
        cur = nxt; cA = nA; cB = nB; ++ui;
        if constexpr (ALIGN_EPI) { if (wr == 1) PG8_BAR; }
    }
    PG8_WAIT_V(0);
    if constexpr (!ALIGN_EPI) { if (wr == 0) PG8_BAR; }
    PG8_BAR;
#undef PG8_SA
#undef PG8_SB
#undef PG8_STAGE
#undef PG8_LDA
#undef PG8_LDB
#undef PG8_MMA
#undef PG8_WAIT_V
#undef PG8_WAIT_L
#undef PG8_BAR
#undef PG8_SCHED
}
}

struct EpiA {
    static constexpr bool PERM = true;
    unsigned char* ws; LAS float* side; const float* bfp; unsigned* nrm;
    __device__ __forceinline__ void operator()(const f32x4 (&acc)[2][2][4][2], const pg8::Unit& u, int wr, int wc, int fr, int fq) const {
        const float* RSX = (const float*)(ws + WS_RSX);
        float rs[2][4];
#pragma unroll
        for (int ai = 0; ai < 2; ++ai)
#pragma unroll
            for (int m = 0; m < 4; ++m) rs[ai][m] = RSX[u.pm * 256 + ai * 128 + wr * 64 + m * 16 + fr];
        const int pn = u.pn, cw = wc * 32 + 8 * fq;
        bf16_t* dst; int pitch, coff, mode;
        if (pn < 2)       { dst = (bf16_t*)(ws + WS_QG);   pitch = 1536; coff = pn * 256;               mode = 1; }
        else if (pn < 4)  { dst = (bf16_t*)(ws + WS_FK);   pitch = 512;  coff = (pn - 2) * 256;         mode = 0; }
        else if (pn < 6)  { dst = (bf16_t*)(ws + WS_FV);   pitch = 512;  coff = (pn - 4) * 256;         mode = 0; }
        else if (pn < 8)  { dst = (bf16_t*)(ws + WS_GATE); pitch = 1536; coff = (pn - 6) * 256;         mode = 2; }
        else if (pn == 8) { dst = (bf16_t*)(ws + WS_QG);   pitch = 1536; coff = 512;                    mode = 0; }
        else if (pn == 9) { dst = (bf16_t*)(ws + WS_QG);   pitch = 1536; coff = 768;                    mode = 0; }
        else if (pn < 12) { dst = (bf16_t*)(ws + WS_GATE); pitch = 1536; coff = 512 + (pn - 10) * 256;  mode = 2; }
        else if (pn < 14) { dst = (bf16_t*)(ws + WS_QG);   pitch = 1536; coff = 1024 + (pn - 12) * 256; mode = 1; }
        else if (pn < 16) { dst = (bf16_t*)(ws + WS_BK);   pitch = 512;  coff = (pn - 14) * 256;        mode = 0; }
        else if (pn < 18) { dst = (bf16_t*)(ws + WS_BV);   pitch = 512;  coff = (pn - 16) * 256;        mode = 0; }
        else              { dst = (bf16_t*)(ws + WS_GATE); pitch = 1536; coff = 1024 + (pn - 18) * 256; mode = 2; }
        const float msc = (mode == 1) ? C2_64 : 1.0f;
        const bool want_nrm = pn < 4 || (pn >= 12 && pn < 16);
        float mx[2] = {0.f, 0.f};
#pragma unroll
        for (int ai = 0; ai < 2; ++ai)
#pragma unroll
            for (int m = 0; m < 4; ++m) { const int row = u.pm * 256 + ai * 128 + wr * 64 + m * 16 + fr; bf16_t* rowp = dst + (size_t)row * pitch + coff + cw; const float sc = rs[ai][m] * msc;
#pragma unroll
                for (int bj = 0; bj < 2; ++bj) { f32x4 v0 = acc[ai][bj][m][0] * sc, v1 = acc[ai][bj][m][1] * sc;
                    if (want_nrm) { float sq = dot4(v0) + dot4(v1); sq += __shfl_xor(sq, 16); sq += __shfl_xor(sq, 32); mx[bj] = fmaxf(mx[bj], sq); }
                    if (mode == 2) { v0 = silu4(v0); v1 = silu4(v1); }
                    store8_bf16(rowp + bj * 128, v0, v1); } }
        if (want_nrm) { const int kind = (pn < 2) ? 0 : (pn < 4) ? 1 : (pn < 14) ? 2 : 3; const int pb = (pn < 2) ? 0 : (pn < 4) ? 2 : (pn < 14) ? 12 : 14;
#pragma unroll
            for (int bj = 0; bj < 2; ++bj) { float v = mx[bj];
#pragma unroll
                for (int o = 1; o < 16; o <<= 1) v = fmaxf(v, __shfl_xor(v, o));
                const int col = (pn - pb) * 256 + bj * 128 + wc * 32;
                if ((threadIdx.x & 63) == 0) atomicMax(nrm + ((kind * 8 + (u.pm >> 4)) * 8 + (col >> 6)) * 2 + ((col >> 5) & 1), __float_as_uint(v)); } }
        if (pn == 8 || pn == 9) {
#pragma unroll
            for (int ai = 0; ai < 2; ++ai)
#pragma unroll
                for (int m = 0; m < 4; ++m) { const int rl = ai * 128 + wr * 64 + m * 16 + fr; const float sc = rs[ai][m];
                    float s = dot4(acc[ai][0][m][0] * sc) + dot4(acc[ai][0][m][1] * sc);
                    if (pn == 8) s += dot4(acc[ai][1][m][0] * sc) + dot4(acc[ai][1][m][1] * sc);
                    s += __shfl_xor(s, 16); s += __shfl_xor(s, 32);
                    if (fq == 0) side[rl * 4 + wc] = s; }
            asm volatile("s_waitcnt lgkmcnt(0)" ::: "memory"); __builtin_amdgcn_s_barrier(); asm volatile("" ::: "memory");
            if (threadIdx.x < 256) { const int rl = threadIdx.x; const f32x4 v = *(const LAS f32x4*)(side + rl * 4);
                float* RS = (float*)(ws + (pn == 8 ? WS_RSCQ : WS_RSCKV)); RS[u.pm * 256 + rl] = rsqrtf(sum4(v) * (pn == 8 ? 1.0f / 256.0f : 1.0f / 128.0f) + EPS); }
        }
        if (pn == 9) {
            float* KRF = (float*)(ws + WS_KRF); float* FFL = (float*)(ws + WS_FFL);
#pragma unroll
            for (int ai = 0; ai < 2; ++ai)
#pragma unroll
                for (int m = 0; m < 4; ++m) { const int row = u.pm * 256 + ai * 128 + wr * 64 + m * 16 + fr; const float sc = rs[ai][m];
                    const f32x4 v0 = acc[ai][1][m][0] * sc, v1 = acc[ai][1][m][1] * sc;
                    if (wc < 2) { float* p = KRF + (size_t)row * 64 + cw; *(f32x4*)p = v0; *(f32x4*)(p + 4) = v1; }
                    else if (wc == 2 && fq == 0) { float* p = FFL + (size_t)row * 8; const f32x4 b0 = *(const f32x4*)bfp, b1 = *(const f32x4*)(bfp + 4); f32x4 l0, l1;
#pragma unroll
                        for (int e = 0; e < 4; ++e) { l0[e] = log_sigmoid_fast(v0[e] + b0[e]); l1[e] = log_sigmoid_fast(v1[e] + b1[e]); }
                        *(f32x4*)p = l0; *(f32x4*)(p + 4) = l1; } }
        }
        if (pn == 14 || pn == 15) {
            float* KP = (float*)(ws + WS_KPART) + ((size_t)(u.pm * 2 + wr)) * 512 + (pn - 14) * 256;
#pragma unroll
            for (int bj = 0; bj < 2; ++bj)
#pragma unroll
                for (int n = 0; n < 2; ++n) { f32x4 s = (f32x4){0.f, 0.f, 0.f, 0.f};
#pragma unroll
                    for (int ai = 0; ai < 2; ++ai)
#pragma unroll
                        for (int m = 0; m < 4; ++m) s += acc[ai][bj][m][n] * rs[ai][m];
#pragma unroll
                    for (int o = 1; o < 16; o <<= 1) { s[0] += __shfl_xor(s[0], o); s[1] += __shfl_xor(s[1], o); s[2] += __shfl_xor(s[2], o); s[3] += __shfl_xor(s[3], o); }
                    if (fr == 0) *(f32x4*)(KP + bj * 128 + cw + 4 * n) = s; }
        }
    }
};

struct EpiQ {
    static constexpr bool PERM = true;
    unsigned char* ws;
    __device__ __forceinline__ void operator()(const f32x4 (&acc)[2][2][4][2], const pg8::Unit& u, int wr, int wc, int fr, int fq) const {
        const float* RS = (const float*)(ws + WS_RSCQ); bf16_t* QM = (bf16_t*)(ws + WS_QM);
        const float* COS = (const float*)(ws + WS_ROPE); const float* SIN = COS + SEQ * 32;
        const int pn = u.pn, cw = wc * 32 + 8 * fq;
#pragma unroll
        for (int ai = 0; ai < 2; ++ai)
#pragma unroll
            for (int m = 0; m < 4; ++m) { const int row = u.pm * 256 + ai * 128 + wr * 64 + m * 16 + fr;
                const float sc = RS[row] * C2_192;
                if (pn < 2) {
#pragma unroll
                    for (int bj = 0; bj < 2; ++bj) { const int head = pn * 2 + bj; store8_bf16(QM + (size_t)row * 768 + head * 192 + cw, acc[ai][bj][m][0] * sc, acc[ai][bj][m][1] * sc); }
                } else {
                    const int tpos = row & (SEQ - 1); const float* cp = COS + (size_t)tpos * 32 + 8 * fq; const float* sp = SIN + (size_t)tpos * 32 + 8 * fq;
                    const f32x4 c0 = *(const f32x4*)cp, c1 = *(const f32x4*)(cp + 4), s0 = *(const f32x4*)sp, s1 = *(const f32x4*)(sp + 4);
                    const f32x4 x10 = acc[ai][0][m][0] * sc, x11 = acc[ai][0][m][1] * sc, x20 = acc[ai][1][m][0] * sc, x21 = acc[ai][1][m][1] * sc;
                    bf16_t* p = QM + (size_t)row * 768 + wc * 192 + 128 + 8 * fq;
                    store8_bf16(p, x10 * c0 - x20 * s0, x11 * c1 - x21 * s1);
                    store8_bf16(p + 32, x20 * c0 + x10 * s0, x21 * c1 + x11 * s1);
                    if (m & 1) asm volatile("" ::: "memory");
                } }
    }
};
struct EpiKV {
    static constexpr bool PERM = true;
    unsigned char* ws;
    __device__ __forceinline__ void operator()(const f32x4 (&acc)[2][2][4][2], const pg8::Unit& u, int wr, int wc, int fr, int fq) const {
        const float* RS = (const float*)(ws + WS_RSCKV);
        const int pn = u.pn, cw = wc * 32 + 8 * fq;
        bf16_t* base = (pn < 2) ? (bf16_t*)(ws + WS_KM) + (pn * 2) * 192 + cw : (bf16_t*)(ws + WS_VM) + (pn - 2) * 256 + cw;
        const int pitch = (pn < 2) ? 768 : 512, bjs = (pn < 2) ? 192 : 128;
#pragma unroll
        for (int ai = 0; ai < 2; ++ai)
#pragma unroll
            for (int m = 0; m < 4; ++m) { const int row = u.pm * 256 + ai * 128 + wr * 64 + m * 16 + fr; const float sc = RS[row]; bf16_t* rowp = base + (size_t)row * pitch;
#pragma unroll
                for (int bj = 0; bj < 2; ++bj) store8_bf16(rowp + bj * bjs, acc[ai][bj][m][0] * sc, acc[ai][bj][m][1] * sc); }
    }
};
struct EpiC {
    static constexpr bool PERM = false;
    const float* xin; float* xout; unsigned char* ws; int last;
    __device__ __forceinline__ void operator()(const f32x4 (&acc)[2][2][4][2], const pg8::Unit& u, int wr, int wc, int fr, int fq) const {
        bf16_t* XB = (bf16_t*)(ws + WS_XB); float* SSX = (float*)(ws + WS_SSX);
#pragma unroll
        for (int ai = 0; ai < 2; ++ai)
#pragma unroll
            for (int m = 0; m < 4; ++m) { const int row = u.pm * 256 + ai * 128 + wr * 64 + m * 16 + fr; const size_t off = (size_t)row * DM + u.pn * 256 + wc * 32 + 4 * fq; float ss = 0.f;
#pragma unroll
                for (int bj = 0; bj < 2; ++bj)
#pragma unroll
                    for (int n = 0; n < 2; ++n) { const size_t o = off + bj * 128 + n * 16; const f32x4 v = acc[ai][bj][m][n] + *(const f32x4*)(xin + o); *(f32x4*)(xout + o) = v; ss += dot4(v);
                        if (!last) { u32x2 w; w.x = cvt_pk_bf16(v[0], v[1]); w.y = cvt_pk_bf16(v[2], v[3]); *(u32x2*)(XB + o) = w; } }
                if (!last) { ss += __shfl_xor(ss, 16); ss += __shfl_xor(ss, 32); if (fq == 0) SSX[(size_t)row * 16 + u.pn * 4 + wc] = ss; } }
    }
};

#define SBAR() __builtin_amdgcn_sched_barrier(0)
__device__ __forceinline__ int crow(int r, int hi) { return (r & 3) + 8 * (r >> 2) + 4 * hi; }
template <int OFF> __device__ __forceinline__ s16x4 tr_read(int vb) { s16x4 r; asm volatile("ds_read_b64_tr_b16 %0, %1 offset:%2" : "=&v"(r) : "v"(vb), "i"(OFF) : "memory"); return r; }
__device__ __forceinline__ int v_rd_base(int lane) { return ((lane & 3) << 3) | (((lane >> 2) & 3) << 6) | (((lane >> 4) & 1) << 5) | (((lane >> 5) & 1) << 8); }
template <int NCB> __device__ __forceinline__ int v_st(int k, int c) { const int kk = (k & ~0xC) | ((k & 4) << 1) | ((k & 8) >> 1); return ((kk >> 3) * NCB + (c >> 5)) * 512 + ((kk & 7) * 32 + (c & 31)) * 2; }
template <int NCB, int D0> __device__ __forceinline__ void pv_one(f32x16& od, int vb, bf16x8 pa0, bf16x8 pa1, bf16x8 pa2, bf16x8 pa3) {
#define VOFF(ks, half) (((2 * (ks) + (half)) * NCB + D0) * 512)
    const s16x4 l0 = tr_read<VOFF(0, 0)>(vb), h0 = tr_read<VOFF(0, 1)>(vb), l1 = tr_read<VOFF(1, 0)>(vb), h1 = tr_read<VOFF(1, 1)>(vb);
    const s16x4 l2 = tr_read<VOFF(2, 0)>(vb), h2 = tr_read<VOFF(2, 1)>(vb), l3 = tr_read<VOFF(3, 0)>(vb), h3 = tr_read<VOFF(3, 1)>(vb);
#undef VOFF
    asm volatile("s_waitcnt lgkmcnt(0)" ::: "memory"); SBAR();
#define PK(L, H) (bf16x8){L[0], L[1], L[2], L[3], H[0], H[1], H[2], H[3]}
    od = __builtin_amdgcn_mfma_f32_32x32x16_bf16(pa0, PK(l0, h0), od, 0, 0, 0);
    od = __builtin_amdgcn_mfma_f32_32x32x16_bf16(pa1, PK(l1, h1), od, 0, 0, 0);
    od = __builtin_amdgcn_mfma_f32_32x32x16_bf16(pa2, PK(l2, h2), od, 0, 0, 0);
    od = __builtin_amdgcn_mfma_f32_32x32x16_bf16(pa3, PK(l3, h3), od, 0, 0, 0);
#undef PK
}
struct AttnP {
    const bf16_t* Q; int ldq;
    const bf16_t* K; int ldk;
    const bf16_t* V; int ldv;
    bf16_t* O; int ldo;
    const bf16_t* G; int ldg;
    float* SSQ; int nh;
    const float* bias;
    const unsigned* sel;
    const float* nrm;
    const unsigned char* jstart;
};
template <int DK, int DV, int MODE>
__device__ __forceinline__ void attn_unit(const AttnP& P, int b, int h, int qb, char* lds) {
    constexpr int NKL = DK / 64, NVL = DV / 64, NCB = DV / 32, ND0 = DK / 16, KB = 64 * DK * 2, VB = 64 * DV * 2;
    constexpr float THR = 8.0f;
    int tid_ = threadIdx.x; asm volatile("" : "+v"(tid_));
    const int tid = tid_, lane = tid & 63, r32 = lane & 31, hi = lane >> 5; const int wid = __builtin_amdgcn_readfirstlane(tid >> 6);
    char* Kl = lds; char* Vl = lds + 2 * KB; float* wsf = (float*)(lds + 2 * KB + 2 * VB) + wid * 64;
    const int q0 = qb * 256; const size_t row0 = (size_t)b * SEQ;
    const int qrow = q0 + wid * 32 + r32;
    const int qlast = q0 + wid * 32 + 31;
    bf16x8 qr[ND0];
    { const bf16_t* Qw = P.Q + (row0 + qrow) * P.ldq + h * DK + hi * 8;
#pragma unroll
      for (int d0 = 0; d0 < ND0; ++d0) qr[d0] = *(const bf16x8*)(Qw + d0 * 16); }
    const int sr = tid >> 3, sc = (tid & 7) * 8;
    const bf16_t* Kg = P.K + (row0 + sr) * P.ldk + h * DK + sc;
    const bf16_t* Vg = P.V + (row0 + sr) * P.ldv + h * DV + sc;
    const int vb0 = (int)(uintptr_t)Vl + v_rd_base(lane);
    const int NT = 4 * (qb + 1);
    int jskip = 0;
    unsigned selw = 0u; float alpha_b = 0.f;
    if (MODE == 2) { selw = P.sel[(row0 + qrow) * 8 + h]; alpha_b = LOG2E * __builtin_amdgcn_exp2f(-(float)(h + 1));
        const float* nq = P.nrm + (((2 * 8 + b) * 8 + h) * 2); const float* nk = P.nrm + (((3 * 8 + b) * 8 + h) * 2);
        const float smax = 1.02f * sqrtf((nq[0] + nq[1]) * (nk[0] + nk[1]));
        const float dist = (40.0f + 2.0f * smax) / alpha_b;
        const float jf = ((float)(q0 - 63) - dist) * (1.0f / 64.0f);
        int js = (jf < 0.f) ? 0 : (int)jf + 1; if (js > 4 * qb) js = 4 * qb; jskip = __builtin_amdgcn_readfirstlane(js); }
    if (MODE == 0) { jskip = __builtin_amdgcn_readfirstlane((int)P.jstart[(b * 8 + h) * 16 + qb]); }
    const float* biasp = (MODE == 0) ? P.bias + (size_t)(b * 8 + h) * SEQ + 4 * hi : nullptr;
    const int NS = NT - jskip;
#define JOF(s_) ((MODE == 2) ? (((s_) < 4) ? (s_) : (s_) + jskip) : (s_) + jskip)
#define KEY0(j) ((MODE == 2) ? (((j) < 4) ? q0 + 64 * (j) : 64 * ((j) - 4)) : 64 * (j))
    bf16x8 ks[NKL], vs[NVL];
#define SLOAD(k0) do { _Pragma("unroll") for (int i_ = 0; i_ < NKL; ++i_) ks[i_] = *(const bf16x8*)(Kg + (size_t)(k0) * P.ldk + 64 * i_); \
                       _Pragma("unroll") for (int i_ = 0; i_ < NVL; ++i_) vs[i_] = *(const bf16x8*)(Vg + (size_t)(k0) * P.ldv + 64 * i_); } while (0)
#define SWRITE(bsel) do { _Pragma("unroll") for (int i_ = 0; i_ < NKL; ++i_) *(bf16x8*)(Kl + (bsel) * KB + sr * (DK * 2) + ((((sc + 64 * i_) * 2)) ^ ((sr & 7) << 4))) = ks[i_]; \
                          _Pragma("unroll") for (int i_ = 0; i_ < NVL; ++i_) *(bf16x8*)(Vl + (bsel) * VB + v_st<NCB>(sr, sc + 64 * i_)) = vs[i_]; } while (0)
    float m_reg = -1e30f, l_reg = 0.f; f32x16 o[NCB];
#pragma unroll
    for (int d = 0; d < NCB; ++d) o[d] = f32x16{};
    SLOAD(KEY0(JOF(0))); SWRITE(0);
    for (int st = 0; st < NS; ++st) { const int j = JOF(st);
        __syncthreads();
        const int key0 = KEY0(j); const int bsel = st & 1;
        if (st + 1 < NS) SLOAD(KEY0(JOF(st + 1)));
        bool active = true;
        if (MODE == 2 && j >= 4) { active = __any((int)((selw >> ((j - 4) >> 2)) & 1u)); }
        else { active = key0 <= qlast; }
        if (active) {
            f32x16 p0 = f32x16{}, p1 = f32x16{};
            const char* Kb = Kl + bsel * KB;
#pragma unroll
            for (int d0 = 0; d0 < ND0; ++d0) { const int cb = (d0 * 16 + hi * 8) * 2;
                const bf16x8 b0 = *(const bf16x8*)(Kb + r32 * (DK * 2) + (cb ^ ((r32 & 7) << 4)));
                const bf16x8 b1 = *(const bf16x8*)(Kb + (32 + r32) * (DK * 2) + (cb ^ ((r32 & 7) << 4)));
                p0 = __builtin_amdgcn_mfma_f32_32x32x16_bf16(b0, qr[d0], p0, 0, 0, 0);
                p1 = __builtin_amdgcn_mfma_f32_32x32x16_bf16(b1, qr[d0], p1, 0, 0, 0); }
            if (MODE == 0) {
#pragma unroll
                for (int g = 0; g < 4; ++g) { const f32x4 b0 = *(const f32x4*)(biasp + key0 + 8 * g), b1 = *(const f32x4*)(biasp + key0 + 32 + 8 * g);
#pragma unroll
                    for (int i = 0; i < 4; ++i) { p0[4 * g + i] += b0[i]; p1[4 * g + i] += b1[i]; } }
            }
            if (MODE == 2) { const float kb = (float)(key0 - q0 + 4 * hi);
#pragma unroll
                for (int r = 0; r < 16; ++r) { const float kk = kb + (float)((r & 3) + 8 * (r >> 2)); p0[r] = __builtin_fmaf(alpha_b, kk, p0[r]); p1[r] = __builtin_fmaf(alpha_b, kk + 32.0f, p1[r]); } }
            if (MODE == 2 && j >= 4) { if (!((selw >> ((j - 4) >> 2)) & 1u)) {
#pragma unroll
                for (int r = 0; r < 16; ++r) { p0[r] = -INFINITY; p1[r] = -INFINITY; } } }
            else if (key0 + 63 > q0 + wid * 32) { const int kb = key0 + 4 * hi;
#pragma unroll
                for (int r = 0; r < 16; ++r) { const int kv = kb + (r & 3) + 8 * (r >> 2); if (kv > qrow) p0[r] = -INFINITY; if (kv + 32 > qrow) p1[r] = -INFINITY; } }
            float pmax = p0[0];
#pragma unroll
            for (int r = 1; r < 16; ++r) pmax = fmaxf(pmax, p0[r]);
#pragma unroll
            for (int r = 0; r < 16; ++r) pmax = fmaxf(pmax, p1[r]);
            { auto rr = __builtin_amdgcn_permlane32_swap(__float_as_uint(pmax), __float_as_uint(pmax), false, false); pmax = fmaxf(__uint_as_float(rr[0]), __uint_as_float(rr[1])); }
            if (!__all(pmax - m_reg <= THR)) {
                const float mn = fmaxf(m_reg, pmax); const float al = __builtin_amdgcn_exp2f(m_reg - mn); m_reg = mn; l_reg *= al;
                if (hi == 0) wsf[r32] = al; asm volatile("s_waitcnt lgkmcnt(0)" ::: "memory");
#pragma unroll
                for (int r = 0; r < 16; ++r) { const float a = wsf[crow(r, hi)];
#pragma unroll
                    for (int d = 0; d < NCB; ++d) o[d][r] *= a; }
            }
            float ps = 0.f;
#pragma unroll
            for (int r = 0; r < 16; ++r) { p0[r] = __builtin_amdgcn_exp2f(p0[r] - m_reg); p1[r] = __builtin_amdgcn_exp2f(p1[r] - m_reg); ps += p0[r] + p1[r]; }
            { auto rr = __builtin_amdgcn_permlane32_swap(__float_as_uint(ps), __float_as_uint(ps), false, false); ps = __uint_as_float(rr[0]) + __uint_as_float(rr[1]); }
            l_reg += ps;
            bf16x8 pa0, pa1, pa2, pa3;
#define PK4(Pv, BASE, OUT) do { unsigned a0 = cvt_pk_bf16(Pv[BASE + 0], Pv[BASE + 1]), a1 = cvt_pk_bf16(Pv[BASE + 2], Pv[BASE + 3]); \
    unsigned b0_ = cvt_pk_bf16(Pv[BASE + 4], Pv[BASE + 5]), b1_ = cvt_pk_bf16(Pv[BASE + 6], Pv[BASE + 7]); \
    auto r0 = __builtin_amdgcn_permlane32_swap(a0, b0_, false, false); auto r1 = __builtin_amdgcn_permlane32_swap(a1, b1_, false, false); \
    u32x4 w = {r0[0], r1[0], r0[1], r1[1]}; OUT = *reinterpret_cast<bf16x8*>(&w); } while (0)
            PK4(p0, 0, pa0); PK4(p0, 8, pa1); PK4(p1, 0, pa2); PK4(p1, 8, pa3);
#undef PK4
            const int vb = vb0 + bsel * VB;
            pv_one<NCB, 0>(o[0], vb, pa0, pa1, pa2, pa3); pv_one<NCB, 1>(o[1], vb, pa0, pa1, pa2, pa3);
            if constexpr (NCB == 4) { pv_one<NCB, 2>(o[2], vb, pa0, pa1, pa2, pa3); pv_one<NCB, 3>(o[3], vb, pa0, pa1, pa2, pa3); }
        }
        if (st + 1 < NS) SWRITE((st + 1) & 1);
    }
    if (hi == 0) wsf[32 + r32] = l_reg; asm volatile("s_waitcnt lgkmcnt(0)" ::: "memory");
    const size_t orow0 = row0 + q0 + wid * 32;
#pragma unroll
    for (int r = 0; r < 16; ++r) { const int orow = crow(r, hi); const float rl = __builtin_amdgcn_rcpf(wsf[32 + orow]); float ss = 0.f;
        float y[NCB];
#pragma unroll
        for (int d = 0; d < NCB; ++d) { y[d] = o[d][r] * rl; ss += y[d] * y[d]; }
#pragma unroll
        for (int sh = 1; sh < 32; sh <<= 1) ss += __shfl_xor(ss, sh);
        if (r32 == 0) P.SSQ[(orow0 + orow) * P.nh + h] = ss;
#pragma unroll
        for (int d = 0; d < NCB; ++d) { const size_t gi = (orow0 + orow) * P.ldg + h * DV + d * 32 + r32; const float gt = bf2f(P.G[gi]);
            const size_t oi = (orow0 + orow) * P.ldo + h * DV + d * 32 + r32; P.O[oi] = (bf16_t)(cvt_pk_bf16(y[d] * gt, 0.f) & 0xffffu); } }
    __syncthreads();
#undef KEY0
#undef JOF
#undef SLOAD
#undef SWRITE
}


#define XB_TMO      128
#define XB_XCNT(j)  (256  + 64 * (j))
#define XB_XSUB(j)  (1280 + 64 * (j))
#define XB_XGEN(j)  (2304 + 64 * (j))
#define XB_TOP      3328
#define XB_TOPGEN   3392
#define XCD_BAR_WORDS 3456
#define XB_SPIN_CAP (1u << 18)
__device__ __forceinline__ unsigned xb_ld(unsigned* p)              { return __hip_atomic_load(p, __ATOMIC_RELAXED, __HIP_MEMORY_SCOPE_AGENT); }
__device__ __forceinline__ unsigned xb_add(unsigned* p, unsigned v) { return __hip_atomic_fetch_add(p, v, __ATOMIC_RELAXED, __HIP_MEMORY_SCOPE_AGENT); }
__device__ __forceinline__ unsigned xb_xcc_id() { return (unsigned)__builtin_amdgcn_s_getreg((3 << 11) | 20) & 0xFu; }
#define XB_SPIN(cond, bar) do { unsigned _sp = 0; while (cond) { __builtin_amdgcn_s_sleep(1); \
    if ((++_sp & 255u) == 0u) { if (xb_ld(&(bar)[XB_TMO])) break; if (_sp > XB_SPIN_CAP) { atomicAdd(&(bar)[XB_TMO], 1u); break; } } } } while (0)
struct XcdBarrier { unsigned* bar; unsigned x; volatile LAS unsigned* st; };
__device__ __forceinline__ XcdBarrier xcd_barrier_post(unsigned* bar, volatile LAS unsigned* st) {
    XcdBarrier b; b.bar = bar; b.x = xb_xcc_id(); b.st = st;
    if (threadIdx.x == 0) (void)xb_add(&bar[XB_XCNT(b.x)], 1u);
    return b;
}
__device__ __forceinline__ void xcd_barrier_complete(unsigned* bar, unsigned x, unsigned& nloc, unsigned& nx) {
    const unsigned G = gridDim.x * gridDim.y * gridDim.z;
    unsigned sum, cnt, mine, sp = 0u;
    for (;;) {
        sum = 0u; cnt = 0u; mine = 0u;
#pragma unroll
        for (unsigned j = 0; j < 16; ++j) { const unsigned c = xb_ld(&bar[XB_XCNT(j)]); sum += c; cnt += (c > 0u) ? 1u : 0u; mine = (j == x) ? c : mine; }
        if (sum == G) break;
        __builtin_amdgcn_s_sleep(1);
        if ((++sp & 255u) == 0u) { if (xb_ld(&bar[XB_TMO])) break; if (sp > XB_SPIN_CAP) { atomicAdd(&bar[XB_TMO], 1u); break; } }
    }
    nloc = mine > 0u ? mine : 1u; nx = cnt > 0u ? cnt : 1u;
}
__device__ __forceinline__ void xcd_barrier(const XcdBarrier& b) {
    asm volatile("s_waitcnt vmcnt(0)" ::: "memory");
    __syncthreads();
    if (threadIdx.x == 0) {
        unsigned* bar = b.bar;
        __builtin_amdgcn_s_waitcnt(0);
        unsigned nloc = b.st[0], nx = b.st[1];
        if (nloc == 0u) { xcd_barrier_complete(bar, b.x, nloc, nx); b.st[0] = nloc; b.st[1] = nx; }
        const unsigned old = xb_add(&bar[XB_XSUB(b.x)], 1u);
        const unsigned gen = old / nloc;
        if (old + 1u == (gen + 1u) * nloc) {
            __builtin_amdgcn_fence(__ATOMIC_RELEASE, "agent");
            asm volatile("s_waitcnt vmcnt(0)" ::: "memory");
            const unsigned og = xb_add(&bar[XB_TOP], 1u);
            const unsigned tg = og / nx;
            if (og + 1u == (tg + 1u) * nx) xb_add(&bar[XB_TOPGEN], 1u);
            else XB_SPIN(xb_ld(&bar[XB_TOPGEN]) == tg, bar);
            __builtin_amdgcn_fence(__ATOMIC_ACQUIRE, "agent");
            xb_add(&bar[XB_XGEN(b.x)], 1u);
            asm volatile("s_waitcnt vmcnt(0)" ::: "memory");
        } else {
            XB_SPIN(xb_ld(&bar[XB_XGEN(b.x)]) == gen, bar);
            __builtin_amdgcn_fence(__ATOMIC_ACQUIRE, "agent");
            asm volatile("s_waitcnt vmcnt(0)" ::: "memory");
        }
    }
    __syncthreads();
}
constexpr int CW_BAR = 4096;

struct UTab { unsigned short v[2560]; };
constexpr UTab make_utab() {
    UTab t{}; int k = 0;
    for (int c = 80; c >= 1; --c) {
        if (c % 5 == 0 && c / 5 <= 16) { const int qb = c / 5 - 1; for (int b = 0; b < 8; ++b) for (int h = 0; h < 4; ++h) t.v[k++] = (unsigned short)((1 << 12) | (b << 8) | (h << 4) | qb); }
        if (c % 2 == 0 && c / 2 <= 16) { const int qb = c / 2 - 1; for (int ty = 0; ty <= 2; ty += 2) for (int b = 0; b < 8; ++b) for (int h = 0; h < 8; ++h) t.v[k++] = (unsigned short)((ty << 12) | (b << 8) | (h << 4) | qb); }
    }
    return t;
}
__device__ const UTab g_utab = make_utab();
constexpr int N_ATT_UNITS = 2560;

struct Args { const float* in[11]; float* out; unsigned char* ws; int ph_lo, ph_hi, coop, pad; };
#ifndef PHM
#define PHM 127
#endif
#ifndef B1M
#define B1M 31
#endif
#ifndef DBL
#define DBL 0
#endif
constexpr int NPHASES = 13;

__device__ __forceinline__ int src_in(int n) {
    const int t = n >> 8, j = n & 255;
    if (t < 6) return n;
    if (t < 8) return 1544 + (n - 1536);
    if (t == 8) return 2056 + j;
    if (t == 9) return j < 128 ? 2312 + j : (j < 192 ? 2440 + (j - 128) : (j < 200 ? 1536 + (j - 192) : -1));
    if (t < 12) return 2504 + (n - 2560);
    return 3016 + (n - 3072);
}
__device__ __forceinline__ int src_uq(int n) {
    if (n < 512) return (n >> 7) * 192 + (n & 127);
    const int p = n - 512; return p < 128 ? (p >> 5) * 192 + 128 + (p & 31) : ((p - 128) >> 5) * 192 + 160 + ((p - 128) & 31);
}
__device__ __forceinline__ int src_ukv(int n) {
    return n < 512 ? (n >> 7) * 256 + (n & 127) : ((n - 512) >> 7) * 256 + 128 + ((n - 512) & 127);
}
__device__ __forceinline__ void transpose_item(const float* W, int Ksrc, int Nsrc, const float* gain, bf16_t* WT, int Kdst, int mat, LAS float* scr, int kb, int nb, int lane) {
    const int k0 = 64 * kb, n0 = 32 * nb; const int nn = n0 + (lane & 31);
    const int sc = (mat == 0) ? src_in(nn) : (mat == 1) ? src_uq(nn) : (mat == 2) ? src_ukv(nn) : nn;
#pragma unroll 8
    for (int i = 0; i < 32; ++i) { const int kk = 2 * i + (lane >> 5); const int k = k0 + kk;
        float v = 0.f; if (sc >= 0 && k < Ksrc) v = W[(size_t)k * Nsrc + sc] * gain[k];
        scr[kk * 33 + (lane & 31)] = v; }
    asm volatile("s_waitcnt lgkmcnt(0)" ::: "memory");
    const int c = lane & 7;
#pragma unroll
    for (int j = 0; j < 4; ++j) { const int n = (lane >> 3) + 8 * j; const LAS float* s = scr + (8 * c) * 33 + n;
        u32x4 o; o.x = cvt_pk_bf16(s[0 * 33], s[1 * 33]); o.y = cvt_pk_bf16(s[2 * 33], s[3 * 33]); o.z = cvt_pk_bf16(s[4 * 33], s[5 * 33]); o.w = cvt_pk_bf16(s[6 * 33], s[7 * 33]);
        *(u32x4*)(WT + (size_t)(n0 + n) * Kdst + k0 + 8 * c) = o; }
    asm volatile("s_waitcnt lgkmcnt(0)" ::: "memory");
}

__device__ __forceinline__ float log_sigmoid_f(float x) { return fminf(x, 0.f) - log1pf(expf(-fabsf(x))); }

__device__ __forceinline__ void phase_p0(const Args& args, const int layer, LAS unsigned char* lds, unsigned char* lds_raw, const int G, const int bid) {
    unsigned char* ws = args.ws; asm volatile("" : "+s"(ws));
    int tid = threadIdx.x; asm volatile("" : "+v"(tid));
    const int lane = tid & 63, wave = __builtin_amdgcn_readfirstlane(tid >> 6);
    const int gw = bid * NWAVES + wave, NGW = G * NWAVES;
    unsigned char* wl = ws + WS_W + (size_t)layer * W_LAYER;
    (void)lane; (void)gw; (void)NGW; (void)wl; (void)lds_raw;
            LAS float* scr = (LAS float*)(lds + wave * 16384);
            constexpr int I_IN = 16 * 160, I_UQ = 4 * 24, I_UKV = 4 * 32, I_OUT = 24 * 32, I_L = I_IN + I_UQ + I_UKV + I_OUT;
            for (int it = gw; it < 2 * I_L; it += NGW) {
                const int l = it / I_L; int r = it % I_L; unsigned char* w = ws + WS_W + (size_t)l * W_LAYER;
                if (r < I_IN) { transpose_item(args.in[2] + (size_t)l * DM * D_IN, DM, D_IN, args.in[1] + l * DM, (bf16_t*)(w + W_IN_OFF), DM, 0, scr, r / 160, r % 160, lane); continue; } r -= I_IN;
                if (r < I_UQ) { transpose_item(args.in[5] + (size_t)l * 256 * 768, 256, 768, args.in[4] + l * 256, (bf16_t*)(w + W_UQ_OFF), 256, 1, scr, r / 24, r % 24, lane); continue; } r -= I_UQ;
                if (r < I_UKV) { transpose_item(args.in[7] + (size_t)l * 128 * 1024, 128, 1024, args.in[6] + l * 128, (bf16_t*)(w + W_UKV_OFF), 256, 2, scr, r / 32, r % 32, lane); continue; } r -= I_UKV;
                transpose_item(args.in[9] + (size_t)l * DMIX * DM, DMIX, DM, args.in[8] + l * DMIX, (bf16_t*)(w + W_OUT_OFF), DMIX, 3, scr, r / 32, r % 32, lane);
            }
            { const float* x = args.in[0]; bf16_t* XB = (bf16_t*)(ws + WS_XB); float* RSX = (float*)(ws + WS_RSX);
              for (int m = gw; m < T; m += NGW) { const f32x4* xr = (const f32x4*)(x + (size_t)m * DM) + lane; f32x4 v[4]; float s = 0.f;
#pragma unroll
                  for (int j = 0; j < 4; ++j) { v[j] = xr[64 * j]; s += dot4(v[j]); }
                  s = wave_sum(s);
                  u32x2* o8 = (u32x2*)(XB + (size_t)m * DM) + lane;
#pragma unroll
                  for (int j = 0; j < 4; ++j) { u32x2 w; w.x = cvt_pk_bf16(v[j][0], v[j][1]); w.y = cvt_pk_bf16(v[j][2], v[j][3]); o8[64 * j] = w; }
                  if (lane == 0) RSX[m] = rsqrtf(s * (1.0f / 1024.0f) + EPS); } }
            { float* COS = (float*)(ws + WS_ROPE); float* SIN = COS + SEQ * 32;
              for (int i = bid * NTHREADS + tid; i < SEQ * 32; i += G * NTHREADS) { const int t = i >> 5, f = i & 31;
                  const float inv = powf(10000.0f, -(float)(2 * f) / 64.0f); const float ang = (float)t * inv;
                  COS[i] = (float)cos((double)ang); SIN[i] = (float)sin((double)ang); } }
}

__device__ __forceinline__ void phase_a(const Args& args, const int layer, LAS unsigned char* lds, unsigned char* lds_raw, const int G, const int bid) {
    unsigned char* ws = args.ws; asm volatile("" : "+s"(ws));
    int tid = threadIdx.x; asm volatile("" : "+v"(tid));
    const int lane = tid & 63, wave = __builtin_amdgcn_readfirstlane(tid >> 6);
    const int gw = bid * NWAVES + wave, NGW = G * NWAVES;
    unsigned char* wl = ws + WS_W + (size_t)layer * W_LAYER;
    (void)lane; (void)gw; (void)NGW; (void)wl; (void)lds_raw;
            pg8::Gemm g{(const bf16_t*)(ws + WS_XB), (const bf16_t*)(wl + W_IN_OFF), T, NIN, DM, DM}; pg8::StaticOrder S; S.init(T, NIN, G, bid);
            EpiA E{ws, (LAS float*)(lds + SIDE_OFF), args.in[3] + layer * 8, (unsigned*)(ws + WS_CTL) + CW_NRM + layer * 512};
            pg8::gemm_phase<EpiA, true>(lds, g, S, E);
}

__device__ __forceinline__ void phase_b1(const Args& args, const int layer, LAS unsigned char* lds, unsigned char* lds_raw, const int G, const int bid) {
    unsigned char* ws = args.ws; asm volatile("" : "+s"(ws));
    int tid = threadIdx.x; asm volatile("" : "+v"(tid));
    const int lane = tid & 63, wave = __builtin_amdgcn_readfirstlane(tid >> 6);
    const int gw = bid * NWAVES + wave, NGW = G * NWAVES;
    unsigned char* wl = ws + WS_W + (size_t)layer * W_LAYER;
    (void)lane; (void)gw; (void)NGW; (void)wl; (void)lds_raw;
            if (B1M & 1) { pg8::Gemm g{(const bf16_t*)(ws + WS_QG) + 512, (const bf16_t*)(wl + W_UQ_OFF), T, 768, 256, 1536}; pg8::StaticOrder S; S.init(T, 768, G, bid);
              EpiQ E{ws}; pg8::gemm_phase<EpiQ, true>(lds, g, S, E); }
            if (B1M & 2) { pg8::Gemm g{(const bf16_t*)(ws + WS_QG) + 768, (const bf16_t*)(wl + W_UKV_OFF), T, 1024, 256, 1536}; pg8::StaticOrder S; S.init(T, 1024, G, bid);
              EpiKV E{ws}; pg8::gemm_phase<EpiKV, true>(lds, g, S, E); }
            if (B1M & 4) { const float* KRF = (const float*)(ws + WS_KRF); bf16_t* KM = (bf16_t*)(ws + WS_KM); const float* COS = (const float*)(ws + WS_ROPE); const float* SIN = COS + SEQ * 32;
              for (int i = bid * NTHREADS + tid; i < T * 8; i += G * NTHREADS) { const int t = i >> 3, c4 = (i & 7) * 4; const int tp = t & (SEQ - 1);
                  const f32x4 x1 = *(const f32x4*)(KRF + (size_t)t * 64 + c4), x2 = *(const f32x4*)(KRF + (size_t)t * 64 + 32 + c4);
                  const f32x4 c = *(const f32x4*)(COS + tp * 32 + c4), s = *(const f32x4*)(SIN + tp * 32 + c4);
                  const f32x4 o1 = x1 * c - x2 * s, o2 = x2 * c + x1 * s;
                  u32x2 w1, w2; w1.x = cvt_pk_bf16(o1[0], o1[1]); w1.y = cvt_pk_bf16(o1[2], o1[3]); w2.x = cvt_pk_bf16(o2[0], o2[1]); w2.y = cvt_pk_bf16(o2[2], o2[3]);
#pragma unroll
                  for (int hh = 0; hh < 4; ++hh) { bf16_t* p = KM + (size_t)t * 768 + hh * 192 + 128 + c4; *(u32x2*)p = w1; *(u32x2*)(p + 32) = w2; } } }
            if (B1M & 8) { const float* FFL = (const float*)(ws + WS_FFL); float* BF = (float*)(ws + WS_BIASF); LAS float* xs = (LAS float*)lds;
              for (int b = bid; b < BATCH; b += G) {
                  const float* src = FFL + ((size_t)b * SEQ + tid * 8) * 8; float v[8][8];
#pragma unroll
                  for (int i = 0; i < 8; ++i) { const f32x4 a = *(const f32x4*)(src + i * 8), c = *(const f32x4*)(src + i * 8 + 4);
#pragma unroll
                      for (int e = 0; e < 4; ++e) { v[i][e] = a[e]; v[i][4 + e] = c[e]; } }
#pragma unroll
                  for (int i = 1; i < 8; ++i)
#pragma unroll
                      for (int h = 0; h < 8; ++h) v[i][h] += v[i - 1][h];
                  float off[8];
#pragma unroll
                  for (int h = 0; h < 8; ++h) { const float tot = v[7][h]; float incl = tot;
#pragma unroll
                      for (int o = 1; o < 64; o <<= 1) { const float n = __shfl_up(incl, o); if (lane >= o) incl += n; }
                      off[h] = incl - tot; if (lane == 63) xs[wave * 8 + h] = incl; }
                  __syncthreads();
#pragma unroll
                  for (int h = 0; h < 8; ++h) { float wo = 0.f; for (int w = 0; w < wave; ++w) wo += xs[w * 8 + h]; off[h] += wo; }
#pragma unroll
                  for (int h = 0; h < 8; ++h) { float* dst = BF + (size_t)(b * 8 + h) * SEQ + tid * 8; f32x4 o0, o1;
#pragma unroll
                      for (int e = 0; e < 4; ++e) { o0[e] = -LOG2E * (v[e][h] + off[h]); o1[e] = -LOG2E * (v[4 + e][h] + off[h]); }
                      *(f32x4*)dst = o0; *(f32x4*)(dst + 4) = o1;
                      if ((tid & 7) == 7) xs[64 + h * 64 + (tid >> 3)] = o1[3];
                      if ((tid & 31) == 0) xs[64 + 512 + h * 16 + (tid >> 5)] = o0[0]; }
                  __syncthreads();
                  if (tid < 128) { const int h = tid >> 4, qb = tid & 15; const float* nq = (const float*)(ws + WS_CTL) + CW_NRM + layer * 512 + ((0 * 8 + b) * 8 + h) * 2; const float* nk = nq + 8 * 8 * 2;
                      const float smax = 1.02f * sqrtf((nq[0] + nq[1]) * (nk[0] + nk[1])); const float thr = -(40.0f + 2.0f * smax); const float bq0 = xs[64 + 512 + h * 16 + qb];
                      int j = 4 * qb - 1; while (j >= 0 && xs[64 + h * 64 + j] - bq0 > thr) --j;
                      ((unsigned char*)(ws + WS_JSTART))[(b * 8 + h) * 16 + qb] = (unsigned char)(j + 1); }
                  __syncthreads(); } }
            if (B1M & 16) { const float* KP = (const float*)(ws + WS_KPART); const bf16_t* QG = (const bf16_t*)(ws + WS_QG); unsigned* SEL = (unsigned*)(ws + WS_SEL);
              LAS float* km = (LAS float*)lds;
              for (int job = bid; job < 512; job += G) { const int b = job >> 6, h = (job >> 3) & 7, tb = job & 7;
                  __syncthreads();
                  for (int i = tid; i < 1024; i += NTHREADS) { const int n = i >> 6, d = i & 63; const float* p = KP + ((size_t)((b * 16 + n) * 2)) * 512 + h * 64 + d; km[i] = (p[0] + p[512]) * (1.0f / 256.0f); }
                  __syncthreads();
                  const int t = tb * 512 + tid; const int cur = t >> 8; const size_t row = (size_t)b * SEQ + t;
                  float q[64];
                  { const bf16x8* qp = (const bf16x8*)(QG + row * 1536 + 1024 + h * 64);
#pragma unroll
                    for (int c = 0; c < 8; ++c) { const bf16x8 v = qp[c];
#pragma unroll
                        for (int e = 0; e < 8; ++e) q[c * 8 + e] = bf2f((unsigned short)v[e]); } }
                  float g1 = -INFINITY, g2 = -INFINITY, g3 = -INFINITY; int i1 = -1, i2 = -1, i3 = -1;
                  for (int n = 0; n < cur; ++n) { float gsum = 0.f;
#pragma unroll
                      for (int d = 0; d < 64; ++d) gsum = __builtin_fmaf(q[d], km[n * 64 + d], gsum);
                      if (gsum > g1) { g3 = g2; i3 = i2; g2 = g1; i2 = i1; g1 = gsum; i1 = n; }
                      else if (gsum > g2) { g3 = g2; i3 = i2; g2 = gsum; i2 = n; }
                      else if (gsum > g3) { g3 = gsum; i3 = n; } }
                  unsigned m = 0u; if (i1 >= 0) m |= 1u << i1; if (i2 >= 0) m |= 1u << i2; if (i3 >= 0) m |= 1u << i3;
                  SEL[row * 8 + h] = m; }
              __syncthreads(); }
}

__device__ __forceinline__ void phase_b2(const Args& args, const int layer, LAS unsigned char* lds, unsigned char* lds_raw, const int G, const int bid) {
    unsigned char* ws = args.ws; asm volatile("" : "+s"(ws));
    int tid = threadIdx.x; asm volatile("" : "+v"(tid));
    const int lane = tid & 63, wave = __builtin_amdgcn_readfirstlane(tid >> 6);
    const int gw = bid * NWAVES + wave, NGW = G * NWAVES;
    unsigned char* wl = ws + WS_W + (size_t)layer * W_LAYER;
    (void)lane; (void)gw; (void)NGW; (void)wl; (void)lds_raw;
    volatile LAS unsigned* MISC = (volatile LAS unsigned*)(lds + MISC_OFF); unsigned* ctl = (unsigned*)(ws + WS_CTL);
            unsigned* qctr = ctl + CW_QCTR * (1 + layer);
            for (;;) {
                if (tid == 0) MISC[0] = __hip_atomic_fetch_add(qctr, 1u, __ATOMIC_RELAXED, __HIP_MEMORY_SCOPE_AGENT);
                __syncthreads();
                const unsigned k = MISC[0];
                __syncthreads();
                if (k >= (unsigned)N_ATT_UNITS) break;
                const unsigned e = g_utab.v[k]; const int ty = e >> 12, b = (e >> 8) & 7, h = (e >> 4) & 7, qb = e & 15;
                if (ty == 0) { const AttnP PF{(const bf16_t*)(ws + WS_QG), 1536, (const bf16_t*)(ws + WS_FK), 512, (const bf16_t*)(ws + WS_FV), 512, (bf16_t*)(ws + WS_QG), 1536,
                                   (const bf16_t*)(ws + WS_GATE), 1536, (float*)(ws + WS_SSQA), 8, (const float*)(ws + WS_BIASF), nullptr, nullptr, (const unsigned char*)(ws + WS_JSTART)};
                    attn_unit<64, 64, 0>(PF, b, h, qb, (char*)lds_raw); }
                else if (ty == 1) { const AttnP PM{(const bf16_t*)(ws + WS_QM), 768, (const bf16_t*)(ws + WS_KM), 768, (const bf16_t*)(ws + WS_VM), 512, (bf16_t*)(ws + WS_QG) + 512, 1536,
                                   (const bf16_t*)(ws + WS_GATE) + 512, 1536, (float*)(ws + WS_SSQB), 4, nullptr, nullptr, nullptr, nullptr};
                    attn_unit<192, 128, 1>(PM, b, h, qb, (char*)lds_raw); }
                else { const AttnP PB{(const bf16_t*)(ws + WS_QG) + 1024, 1536, (const bf16_t*)(ws + WS_BK), 512, (const bf16_t*)(ws + WS_BV), 512, (bf16_t*)(ws + WS_QG) + 1024, 1536,
                                   (const bf16_t*)(ws + WS_GATE) + 1024, 1536, (float*)(ws + WS_SSQC), 8, nullptr, (const unsigned*)(ws + WS_SEL), (const float*)(ws + WS_CTL) + CW_NRM + layer * 512, nullptr};
                    attn_unit<64, 64, 2>(PB, b, h, qb, (char*)lds_raw); }
            }
}

__device__ __forceinline__ void phase_n(const Args& args, const int layer, LAS unsigned char* lds, unsigned char* lds_raw, const int G, const int bid) {
    unsigned char* ws = args.ws; asm volatile("" : "+s"(ws));
    int tid = threadIdx.x; asm volatile("" : "+v"(tid));
    const int lane = tid & 63, wave = __builtin_amdgcn_readfirstlane(tid >> 6);
    const int gw = bid * NWAVES + wave, NGW = G * NWAVES;
    unsigned char* wl = ws + WS_W + (size_t)layer * W_LAYER;
    (void)lane; (void)gw; (void)NGW; (void)wl; (void)lds_raw;
            bf16_t* Y = (bf16_t*)(ws + WS_QG); const float* SA = (const float*)(ws + WS_SSQA); const float* SB = (const float*)(ws + WS_SSQB); const float* SC = (const float*)(ws + WS_SSQC);
            for (int m = gw; m < T; m += NGW) {
                const f32x4 a0 = *(const f32x4*)(SA + (size_t)m * 8), a1 = *(const f32x4*)(SA + (size_t)m * 8 + 4), b0 = *(const f32x4*)(SB + (size_t)m * 4);
                const f32x4 c0 = *(const f32x4*)(SC + (size_t)m * 8), c1 = *(const f32x4*)(SC + (size_t)m * 8 + 4);
                const float ra = rsqrtf((sum4(a0) + sum4(a1)) * (1.0f / 512.0f) + EPS), rb = rsqrtf(sum4(b0) * (1.0f / 512.0f) + EPS), rc = rsqrtf((sum4(c0) + sum4(c1)) * (1.0f / 512.0f) + EPS);
                u32x4* yp = (u32x4*)(Y + (size_t)m * 1536);
#pragma unroll
                for (int j = 0; j < 3; ++j) { const float r = (j == 0) ? ra : (j == 1) ? rb : rc; u32x4 v = yp[64 * j + lane]; u32x4 o;
#pragma unroll
                    for (int e = 0; e < 4; ++e) { const unsigned w = v[e]; o[e] = cvt_pk_bf16(__uint_as_float(w << 16) * r, __uint_as_float(w & 0xffff0000u) * r); }
                    yp[64 * j + lane] = o; }
            }
}

__device__ __forceinline__ void phase_c(const Args& args, const int layer, LAS unsigned char* lds, unsigned char* lds_raw, const int G, const int bid) {
    unsigned char* ws = args.ws; asm volatile("" : "+s"(ws));
    int tid = threadIdx.x; asm volatile("" : "+v"(tid));
    const int lane = tid & 63, wave = __builtin_amdgcn_readfirstlane(tid >> 6);
    const int gw = bid * NWAVES + wave, NGW = G * NWAVES;
    unsigned char* wl = ws + WS_W + (size_t)layer * W_LAYER;
    (void)lane; (void)gw; (void)NGW; (void)wl; (void)lds_raw;
            pg8::Gemm g{(const bf16_t*)(ws + WS_QG), (const bf16_t*)(wl + W_OUT_OFF), T, DM, DMIX, DMIX}; pg8::StaticOrder S; S.init(T, DM, G, bid);
            EpiC E{layer == 0 ? args.in[0] : (const float*)args.out, args.out, ws, layer == DEPTH - 1 ? 1 : 0};
            pg8::gemm_phase<EpiC, true>(lds, g, S, E);
}

__device__ __forceinline__ void phase_r(const Args& args, const int layer, LAS unsigned char* lds, unsigned char* lds_raw, const int G, const int bid) {
    unsigned char* ws = args.ws; asm volatile("" : "+s"(ws));
    int tid = threadIdx.x; asm volatile("" : "+v"(tid));
    const int lane = tid & 63, wave = __builtin_amdgcn_readfirstlane(tid >> 6);
    const int gw = bid * NWAVES + wave, NGW = G * NWAVES;
    unsigned char* wl = ws + WS_W + (size_t)layer * W_LAYER;
    (void)lane; (void)gw; (void)NGW; (void)wl; (void)lds_raw;
            const float* SSX = (const float*)(ws + WS_SSX); float* RSX = (float*)(ws + WS_RSX);
            for (int m = bid * NTHREADS + tid; m < T; m += G * NTHREADS) { const f32x4* p = (const f32x4*)(SSX + (size_t)m * 16);
                const float sm = (sum4(p[0]) + sum4(p[1])) + (sum4(p[2]) + sum4(p[3])); RSX[m] = rsqrtf(sm * (1.0f / 1024.0f) + EPS); }
}

__device__ __forceinline__ void phase_f(const Args& args, const int layer, LAS unsigned char* lds, unsigned char* lds_raw, const int G, const int bid) {
    unsigned char* ws = args.ws; asm volatile("" : "+s"(ws));
    int tid = threadIdx.x; asm volatile("" : "+v"(tid));
    const int lane = tid & 63, wave = __builtin_amdgcn_readfirstlane(tid >> 6);
    const int gw = bid * NWAVES + wave, NGW = G * NWAVES;
    unsigned char* wl = ws + WS_W + (size_t)layer * W_LAYER;
    (void)lane; (void)gw; (void)NGW; (void)wl; (void)lds_raw;
            float* X = args.out; const float* gf = args.in[10];
            for (int m = gw; m < T; m += NGW) { f32x4* xr = (f32x4*)(X + (size_t)m * DM) + lane; f32x4 v[4]; float s = 0.f;
#pragma unroll
                for (int j = 0; j < 4; ++j) { v[j] = xr[64 * j]; s += dot4(v[j]); }
                const float r = rsqrtf(wave_sum(s) * (1.0f / 1024.0f) + EPS);
#pragma unroll
                for (int j = 0; j < 4; ++j) { const f32x4 gg = *((const f32x4*)gf + 64 * j + lane); xr[64 * j] = v[j] * r * gg; } }
}

__global__ void __launch_bounds__(NTHREADS, 2) fwd_kernel(Args args) {
    extern __shared__ __attribute__((aligned(16))) unsigned char lds_raw[];
    LAS unsigned char* lds = (LAS unsigned char*)lds_raw;
    const int G = gridDim.x, bid = blockIdx.x;
    const int lo = args.ph_lo, hi = args.ph_hi;
    volatile LAS unsigned* MISCW = (volatile LAS unsigned*)(lds + MISC_OFF);
    XcdBarrier xbar; xbar.bar = (unsigned*)(args.ws + WS_CTL) + CW_BAR; xbar.x = 0; xbar.st = MISCW + 8;
    if (args.coop) { if (threadIdx.x == 0) { MISCW[8] = 0u; MISCW[9] = 0u; } __syncthreads(); xbar = xcd_barrier_post((unsigned*)(args.ws + WS_CTL) + CW_BAR, MISCW + 8); }
#define IN(k) (lo <= (k) && (k) < hi)
#define SEAM(k) do { if (IN(k) && IN((k) + 1) && args.coop) { if ((k) == 0) cg::this_grid().sync(); else xcd_barrier(xbar); } } while (0)
    if (IN(0) && (PHM & 1)) phase_p0(args, 0, lds, lds_raw, G, bid);
    if (DBL & 1) { __syncthreads(); phase_p0(args, 0, lds, lds_raw, G, bid); }
    SEAM(0);
    if (IN(1) && (PHM & 2)) phase_a(args, 0, lds, lds_raw, G, bid);
    if (DBL & 2) { __syncthreads(); phase_a(args, 0, lds, lds_raw, G, bid); }
    SEAM(1);
    if (IN(2) && (PHM & 4)) phase_b1(args, 0, lds, lds_raw, G, bid);
    if (DBL & 4) { __syncthreads(); phase_b1(args, 0, lds, lds_raw, G, bid); }
    SEAM(2);
    if (IN(3) && (PHM & 8)) phase_b2(args, 0, lds, lds_raw, G, bid);
    SEAM(3);
    if (IN(4) && (PHM & 16)) phase_n(args, 0, lds, lds_raw, G, bid);
    SEAM(4);
    if (IN(5) && (PHM & 32)) phase_c(args, 0, lds, lds_raw, G, bid);
    if (DBL & 32) { __syncthreads(); phase_c(args, 0, lds, lds_raw, G, bid); }
    SEAM(5);
    if (IN(6)) phase_r(args, 0, lds, lds_raw, G, bid);
    SEAM(6);
    if (IN(7) && (PHM & 2)) phase_a(args, 1, lds, lds_raw, G, bid);
    SEAM(7);
    if (IN(8) && (PHM & 4)) phase_b1(args, 1, lds, lds_raw, G, bid);
    SEAM(8);
    if (IN(9) && (PHM & 8)) phase_b2(args, 1, lds, lds_raw, G, bid);
    SEAM(9);
    if (IN(10) && (PHM & 16)) phase_n(args, 1, lds, lds_raw, G, bid);
    SEAM(10);
    if (IN(11) && (PHM & 32)) phase_c(args, 1, lds, lds_raw, G, bid);
    SEAM(11);
    if (IN(12) && (PHM & 64)) phase_f(args, 0, lds, lds_raw, G, bid);
#undef IN
#undef SEAM
}

extern "C" void kernel_launch(void* const* d_in, const int* in_sizes, int n_in, void* d_out, int out_size, void* d_ws, size_t ws_size, hipStream_t stream) {
    static int grid = 0;
    if (grid == 0) {
        if (n_in != 11 || in_sizes[0] != T * DM || out_size != T * DM || ws_size < WS_END) {
            fprintf(stderr, "kernel_launch: shape mismatch (n_in %d, in0 %d, out %d, ws %zu; need ws >= %zu)\n", n_in, n_in > 0 ? in_sizes[0] : -1, out_size, ws_size, (size_t)WS_END); grid = -1; return; }
        int dev = 0, cus = 0, per_cu = 0;
        hipGetDevice(&dev); hipDeviceGetAttribute(&cus, hipDeviceAttributeMultiprocessorCount, dev);
        if (hipFuncSetAttribute((const void*)fwd_kernel, hipFuncAttributeMaxDynamicSharedMemorySize, LDS_BYTES) != hipSuccess) { fprintf(stderr, "kernel_launch: hipFuncSetAttribute failed\n"); grid = -1; return; }
        hipOccupancyMaxActiveBlocksPerMultiprocessor(&per_cu, (const void*)fwd_kernel, NTHREADS, LDS_BYTES);
        (void)hipGetLastError();
        if (per_cu < 1) { fprintf(stderr, "kernel_launch: occupancy query says %d blocks/CU\n", per_cu); per_cu = 1; }
        grid = cus * 1;
    }
    if (grid < 0) return;
    hipMemsetAsync((char*)d_ws + WS_CTL, 0, CTL_ZERO_BYTES, stream);
    Args a{};
    for (int i = 0; i < 11; ++i) a.in[i] = (const float*)d_in[i];
    a.out = (float*)d_out; a.ws = (unsigned char*)d_ws;
#ifndef ONE_LAUNCH
#define ONE_LAUNCH 1
#endif
    if (ONE_LAUNCH) {
        a.ph_lo = 0; a.ph_hi = NPHASES; a.coop = 1;
        void* kargs[] = {&a};
        hipError_t e = hipLaunchCooperativeKernel((const void*)fwd_kernel, dim3(grid), dim3(NTHREADS), kargs, LDS_BYTES, stream);
        if (e != hipSuccess) fprintf(stderr, "kernel_launch: cooperative launch failed: %s (grid %d)\n", hipGetErrorString(e), grid);
    } else {
        for (int ph = 0; ph < NPHASES; ++ph) { a.ph_lo = ph; a.ph_hi = ph + 1; a.coop = 0;
            hipLaunchKernelGGL(fwd_kernel, dim3(grid), dim3(NTHREADS), LDS_BYTES, stream, a); }
    }
}
```

```cpp
#include <hip/hip_runtime.h>
#include <hip/hip_cooperative_groups.h>
#include <cstdio>
#include <cstdint>
#include <cmath>
namespace cg = cooperative_groups;

#define LAS __attribute__((address_space(3)))
typedef unsigned short bf16_t;
typedef short bf16x8 __attribute__((ext_vector_type(8)));
typedef short s16x4 __attribute__((ext_vector_type(4)));
typedef float f32x4 __attribute__((ext_vector_type(4)));
typedef float f32x2 __attribute__((ext_vector_type(2)));
typedef float f32x16 __attribute__((ext_vector_type(16)));
typedef unsigned u32x4 __attribute__((ext_vector_type(4)));
typedef unsigned u32x2 __attribute__((ext_vector_type(2)));

constexpr int BATCH = 8, SEQ = 4096, T = BATCH * SEQ, DM = 1024, DEPTH = 2;
constexpr int D_IN = 5064, NIN = 5120, DMIX = 1536;
constexpr float EPS = 1e-6f, LOG2E = 1.4426950408889634f;
constexpr float C2_64 = 0.125f * LOG2E;
constexpr float C2_192 = 0.07216878364870323f * LOG2E;
constexpr int NWAVES = 8, NTHREADS = 512;

constexpr size_t MiB = 1u << 20;
constexpr size_t WS_CTL = 0, CTL_ZERO_BYTES = 1 * MiB;
constexpr size_t WS_SSX = 1 * MiB;
constexpr size_t WS_KRF = 3 * MiB;
constexpr size_t WS_FFL = 11 * MiB;
constexpr size_t WS_RSCQ = 12 * MiB;
constexpr size_t WS_RSCKV = 12 * MiB + 256 * 1024;
constexpr size_t WS_RSX = 12 * MiB + 512 * 1024;
constexpr size_t WS_KPART = 13 * MiB;
constexpr size_t WS_BIASF = 14 * MiB;
constexpr size_t WS_SEL = 15 * MiB;
constexpr size_t WS_SSQA = 16 * MiB;
constexpr size_t WS_SSQB = 17 * MiB;
constexpr size_t WS_SSQC = 18 * MiB;
constexpr size_t WS_JSTART = 18 * MiB + 768 * 1024;
constexpr size_t WS_ROPE = 19 * MiB;
constexpr size_t WS_W = 24 * MiB, W_LAYER = 14 * MiB;
constexpr size_t W_IN_OFF = 0, W_UQ_OFF = 10 * MiB, W_UKV_OFF = 10 * MiB + 512 * 1024, W_OUT_OFF = 11 * MiB;
constexpr size_t WS_QG = 56 * MiB;
constexpr size_t WS_GATE = 152 * MiB;
constexpr size_t WS_FK = 248 * MiB, WS_FV = 280 * MiB, WS_BK = 312 * MiB, WS_BV = 344 * MiB;
constexpr size_t WS_R2 = 376 * MiB;
constexpr size_t WS_XB = WS_R2, WS_QM = WS_R2, WS_KM = WS_R2 + 48 * MiB, WS_VM = WS_R2 + 96 * MiB;
constexpr size_t WS_END = 504 * MiB;
constexpr int CW_NRM = 8192;
constexpr int CW_QCTR = 64;

constexpr int RING_BYTES = 131072, MISC_OFF = RING_BYTES + 256, SIDE_OFF = RING_BYTES + 1024  , LDS_BYTES = 147456;

__device__ __forceinline__ unsigned cvt_pk_bf16(float lo, float hi) { unsigned r; asm volatile("v_cvt_pk_bf16_f32 %0, %1, %2" : "=v"(r) : "v"(lo), "v"(hi)); return r; }
__device__ __forceinline__ float bf2f(unsigned short b) { return __uint_as_float(((unsigned)b) << 16); }
__device__ __forceinline__ void store8_bf16(bf16_t* p, f32x4 a, f32x4 b) {
    u32x4 w; w.x = cvt_pk_bf16(a[0], a[1]); w.y = cvt_pk_bf16(a[2], a[3]); w.z = cvt_pk_bf16(b[0], b[1]); w.w = cvt_pk_bf16(b[2], b[3]); *(u32x4*)p = w; }
__device__ __forceinline__ float silu_f(float v) { return v * __builtin_amdgcn_rcpf(1.0f + __builtin_amdgcn_exp2f(-v * LOG2E)); }
__device__ __forceinline__ f32x4 silu4(f32x4 v) { f32x4 o; o[0] = silu_f(v[0]); o[1] = silu_f(v[1]); o[2] = silu_f(v[2]); o[3] = silu_f(v[3]); return o; }
__device__ __forceinline__ float wave_sum(float v) {
#pragma unroll
    for (int o = 1; o < 64; o <<= 1) v += __shfl_xor(v, o);
    return v;
}
__device__ __forceinline__ float log_sigmoid_fast(float x) { return -0.6931471805599453f * __builtin_amdgcn_logf(1.0f + __builtin_amdgcn_exp2f(-x * LOG2E)); }
__device__ __forceinline__ float sum4(f32x4 a) { return (a[0] + a[1]) + (a[2] + a[3]); }
__device__ __forceinline__ float dot4(f32x4 a) { return (a[0] * a[0] + a[1] * a[1]) + (a[2] * a[2] + a[3] * a[3]); }

namespace pg8 {
constexpr int BM = 256, BK = 64, HALF = 128, HTB = HALF * BK * 2, STAGE_BYTES = 8 * HTB, NXCD = 8, WGM = 8;
__host__ __device__ __forceinline__ int lds_byte(int r, int c) { const int st = (r >> 4) * 2 + (c >> 5), rr = r & 15, cc = c & 31, ob = rr * 64 + cc * 2; return st * 1024 + (ob ^ (((ob >> 9) & 1) << 5)); }
__host__ __device__ __forceinline__ void stage_rc(int b, int& R, int& C) { const int st = b / 1024, sb = b % 1024, swz = sb ^ (((sb >> 9) & 1) << 5); R = (st >> 1) * 16 + swz / 64; C = (st & 1) * 32 + (swz % 64) / 2; }
__host__ __device__ __forceinline__ int perm32(int rho) { const int n = rho >> 4, i = rho & 15; return 8 * (i >> 2) + 4 * n + (i & 3); }

struct Unit { int pm, pn; };
struct Gemm { const bf16_t* A; const bf16_t* Bt; int M, N, K, lda; };

struct StaticOrder {
    int nM, nN, nwg, G, c;
    __host__ __device__ void init(int M, int N, int G_, int c_) { nM = M / BM; nN = N / BM; nwg = nM * nN; G = G_; c = c_; }
    __host__ __device__ bool next(int i, Unit& u) const {
        const long L = (long)i * G + c; if (L >= nwg) return false;
        int wgid = (int)L; { const int q = nwg / NXCD, r = nwg % NXCD, xcd = wgid % NXCD, off = wgid / NXCD; wgid = (xcd < r ? xcd * (q + 1) : r * (q + 1) + (xcd - r) * q) + off; }
        const int nig = WGM * nN, gid = wgid / nig, fm = gid * WGM, gsz = (nM - fm) < WGM ? (nM - fm) : WGM;
        u.pm = fm + ((wgid % nig) % gsz); u.pn = (wgid % nig) / gsz; return true;
    }
};

template <class Epi, bool ALIGN_EPI>
__device__ __forceinline__ void gemm_phase(LAS unsigned char* lds, const Gemm g, const StaticOrder& S, const Epi& E) {
    int tid_ = threadIdx.x; asm volatile("" : "+v"(tid_));
    const int tid = tid_, wid = __builtin_amdgcn_readfirstlane(tid >> 6), lane = tid & 63, wr = wid >> 2, wc = wid & 3, fr = lane & 15, fq = lane >> 4;
    const int K = g.K, nt = K / BK, lda = g.lda;
    unsigned voffA[2], voffB[2];
#pragma unroll
    for (int i = 0; i < 2; ++i) { int R, C; stage_rc(tid * 16 + i * 8192, R, C); const int Rb = Epi::PERM ? ((R & ~31) + perm32(R & 31)) : R;
        voffA[i] = (unsigned)(R * lda + C) * 2u; voffB[i] = (unsigned)(Rb * K + C) * 2u; }
    const size_t kstep = (size_t)(BK * 2);
    const size_t hstepA = (size_t)HALF * lda * 2, hstepB = (size_t)HALF * K * 2;
    const size_t tstepA = 2 * hstepA, tstepB = 2 * hstepB;
    const unsigned ldsw = (unsigned)wid * 1024u;
    const int aoff = lds_byte(wr * 64 + fr, fq * 8), boff = lds_byte(wc * 32 + fr, fq * 8);
#define PG8_SA(b, h) (((b) * 2 + (h)) * HTB)
#define PG8_SB(b, h) ((4 + (b) * 2 + (h)) * HTB)
#define PG8_STAGE(bufoff, gbase, voff) do { _Pragma("unroll") for (int _i = 0; _i < 2; ++_i) \
        __builtin_amdgcn_global_load_lds((const unsigned*)((const char*)(gbase) + (voff)[_i]), (LAS unsigned*)(lds + (bufoff) + ldsw + _i * 8192), 16, 0, 0); } while (0)
#define PG8_LDA(dst, b, h) do { _Pragma("unroll") for (int m = 0; m < 4; ++m) _Pragma("unroll") for (int k = 0; k < 2; ++k) dst[m][k] = *(const LAS bf16x8*)(lds + PG8_SA(b, h) + aoff + m * 2048 + k * 1024); } while (0)
#define PG8_LDB(dst, b, h) do { _Pragma("unroll") for (int n = 0; n < 2; ++n) _Pragma("unroll") for (int k = 0; k < 2; ++k) dst[n][k] = *(const LAS bf16x8*)(lds + PG8_SB(b, h) + boff + n * 2048 + k * 1024); } while (0)
#define PG8_MMA(ai, bj, At, Bt) do { __builtin_amdgcn_s_setprio(1); _Pragma("unroll") for (int m = 0; m < 4; ++m) _Pragma("unroll") for (int n = 0; n < 2; ++n) _Pragma("unroll") for (int k = 0; k < 2; ++k) \
        acc[ai][bj][m][n] = __builtin_amdgcn_mfma_f32_16x16x32_bf16(Bt[n][k], At[m][k], acc[ai][bj][m][n], 0, 0, 0); __builtin_amdgcn_s_setprio(0); } while (0)
#define PG8_WAIT_V(n) asm volatile("s_waitcnt vmcnt(" #n ")" ::: "memory")
#define PG8_WAIT_L(n) asm volatile("s_waitcnt lgkmcnt(" #n ")" ::: "memory")
#define PG8_BAR __builtin_amdgcn_s_barrier()
#define PG8_SCHED __builtin_amdgcn_sched_barrier(0)
    Unit cur, nxt; int ui = 0;
    if (!S.next(0, cur)) return;
    f32x4 acc[2][2][4][2];
#pragma unroll
    for (int a = 0; a < 2; ++a)
#pragma unroll
        for (int b = 0; b < 2; ++b)
#pragma unroll
            for (int m = 0; m < 4; ++m)
#pragma unroll
                for (int n = 0; n < 2; ++n) acc[a][b][m][n] = (f32x4){0.f, 0.f, 0.f, 0.f};
    bf16x8 At[4][2], B0[2][2], B1[2][2];
    const char* cA = (const char*)g.A + (size_t)cur.pm * tstepA; const char* cB = (const char*)g.Bt + (size_t)cur.pn * tstepB;
    PG8_STAGE(PG8_SB(0, 0), cB, voffB); PG8_STAGE(PG8_SB(0, 1), cB + hstepB, voffB); PG8_STAGE(PG8_SA(0, 0), cA, voffA); PG8_STAGE(PG8_SA(0, 1), cA + hstepA, voffA);
    if (wr == 1) PG8_BAR;
    PG8_WAIT_V(2); PG8_BAR;
    PG8_STAGE(PG8_SB(1, 0), cB + kstep, voffB); PG8_STAGE(PG8_SA(1, 0), cA + kstep, voffA); PG8_STAGE(PG8_SB(1, 1), cB + hstepB + kstep, voffB);
    PG8_WAIT_V(6); PG8_BAR;
    for (;;) {
        const bool has_next = S.next(ui + 1, nxt);
        const char* nA = has_next ? (const char*)g.A + (size_t)nxt.pm * tstepA : cA; const char* nB = has_next ? (const char*)g.Bt + (size_t)nxt.pn * tstepB : cB;
#pragma unroll 1
        for (int t = 0; t < nt; t += 2) {
            const bool last = (t == nt - 2);
            const char* a1 = cA + (size_t)(t + 1) * kstep;
            const char* a2 = last ? nA : cA + (size_t)(t + 2) * kstep; const char* b2 = last ? nB : cB + (size_t)(t + 2) * kstep;
            const char* a3 = a2 + kstep; const char* b3 = b2 + kstep;
            PG8_LDB(B0, 0, 0); PG8_LDB(B1, 0, 1); PG8_SCHED; PG8_LDA(At, 0, 0); PG8_STAGE(PG8_SA(1, 1), a1 + hstepA, voffA);
            PG8_WAIT_V(8); PG8_WAIT_L(0); PG8_BAR; PG8_MMA(0, 0, At, B0); PG8_MMA(0, 1, At, B1); PG8_BAR; PG8_SCHED;
            PG8_LDA(At, 0, 1); PG8_STAGE(PG8_SB(0, 0), b2, voffB); PG8_STAGE(PG8_SB(0, 1), b2 + hstepB, voffB); PG8_STAGE(PG8_SA(0, 0), a2, voffA);
            PG8_WAIT_V(8); PG8_WAIT_L(0); PG8_BAR; PG8_MMA(1, 0, At, B0); PG8_MMA(1, 1, At, B1); PG8_BAR; PG8_SCHED;
            PG8_LDB(B0, 1, 0); PG8_LDB(B1, 1, 1); PG8_SCHED; PG8_LDA(At, 1, 0); PG8_STAGE(PG8_SA(0, 1), a2 + hstepA, voffA);
            PG8_WAIT_V(8); PG8_WAIT_L(0); PG8_BAR; PG8_MMA(0, 0, At, B0); PG8_MMA(0, 1, At, B1); PG8_BAR; PG8_SCHED;
            PG8_LDA(At, 1, 1); PG8_STAGE(PG8_SB(1, 0), b3, voffB); PG8_STAGE(PG8_SB(1, 1), b3 + hstepB, voffB); PG8_STAGE(PG8_SA(1, 0), a3, voffA);
            PG8_WAIT_V(8); PG8_WAIT_L(0); PG8_BAR; PG8_MMA(1, 0, At, B0); PG8_MMA(1, 1, At, B1); PG8_BAR; PG8_SCHED;
        }
        if constexpr (ALIGN_EPI) { if (wr == 0) PG8_BAR; }
        E(acc, cur, wr, wc, fr, fq);
        if (!has_next) break;
#pragma unroll
        for (int a = 0; a < 2; ++a)
#pragma unroll
            for (int b = 0; b < 2; ++b)
#pragma unroll
                for (int m = 0; m < 4; ++m)
#pragma unroll
                    for (int n = 0; n < 2; ++n) acc[a][b][m][n] = (f32x4){0.f, 0.f, 0.f, 0.f};
        cur = nxt; cA = nA; cB = nB; ++ui;
        if constexpr (ALIGN_EPI) { if (wr == 1) PG8_BAR; }
    }
    PG8_WAIT_V(0);
    if constexpr (!ALIGN_EPI) { if (wr == 0) PG8_BAR; }
    PG8_BAR;
#undef PG8_SA
#undef PG8_SB
#undef PG8_STAGE
#undef PG8_LDA
#undef PG8_LDB
#undef PG8_MMA
#undef PG8_WAIT_V
#undef PG8_WAIT_L
#undef PG8_BAR
#undef PG8_SCHED
}
}

struct EpiA {
    static constexpr bool PERM = true;
    unsigned char* ws; LAS float* side; const float* bfp; unsigned* nrm;
    __device__ __forceinline__ void operator()(const f32x4 (&acc)[2][2][4][2], const pg8::Unit& u, int wr, int wc, int fr, int fq) const {
        const float* RSX = (const float*)(ws + WS_RSX);
        float rs[2][4];
#pragma unroll
        for (int ai = 0; ai < 2; ++ai)
#pragma unroll
            for (int m = 0; m < 4; ++m) rs[ai][m] = RSX[u.pm * 256 + ai * 128 + wr * 64 + m * 16 + fr];
        const int pn = u.pn, cw = wc * 32 + 8 * fq;
        bf16_t* dst; int pitch, coff, mode;
        if (pn < 2)       { dst = (bf16_t*)(ws + WS_QG);   pitch = 1536; coff = pn * 256;               mode = 1; }
        else if (pn < 4)  { dst = (bf16_t*)(ws + WS_FK);   pitch = 512;  coff = (pn - 2) * 256;         mode = 0; }
        else if (pn < 6)  { dst = (bf16_t*)(ws + WS_FV);   pitch = 512;  coff = (pn - 4) * 256;         mode = 0; }
        else if (pn < 8)  { dst = (bf16_t*)(ws + WS_GATE); pitch = 1536; coff = (pn - 6) * 256;         mode = 2; }
        else if (pn == 8) { dst = (bf16_t*)(ws + WS_QG);   pitch = 1536; coff = 512;                    mode = 0; }
        else if (pn == 9) { dst = (bf16_t*)(ws + WS_QG);   pitch = 1536; coff = 768;                    mode = 0; }
        else if (pn < 12) { dst = (bf16_t*)(ws + WS_GATE); pitch = 1536; coff = 512 + (pn - 10) * 256;  mode = 2; }
        else if (pn < 14) { dst = (bf16_t*)(ws + WS_QG);   pitch = 1536; coff = 1024 + (pn - 12) * 256; mode = 1; }
        else if (pn < 16) { dst = (bf16_t*)(ws + WS_BK);   pitch = 512;  coff = (pn - 14) * 256;        mode = 0; }
        else if (pn < 18) { dst = (bf16_t*)(ws + WS_BV);   pitch = 512;  coff = (pn - 16) * 256;        mode = 0; }
        else              { dst = (bf16_t*)(ws + WS_GATE); pitch = 1536; coff = 1024 + (pn - 18) * 256; mode = 2; }
        const float msc = (mode == 1) ? C2_64 : 1.0f;
        const bool want_nrm = pn < 4 || (pn >= 12 && pn < 16);
        float mx[2] = {0.f, 0.f};
#pragma unroll
        for (int ai = 0; ai < 2; ++ai)
#pragma unroll
            for (int m = 0; m < 4; ++m) { const int row = u.pm * 256 + ai * 128 + wr * 64 + m * 16 + fr; bf16_t* rowp = dst + (size_t)row * pitch + coff + cw; const float sc = rs[ai][m] * msc;
#pragma unroll
                for (int bj = 0; bj < 2; ++bj) { f32x4 v0 = acc[ai][bj][m][0] * sc, v1 = acc[ai][bj][m][1] * sc;
                    if (want_nrm) { float sq = dot4(v0) + dot4(v1); sq += __shfl_xor(sq, 16); sq += __shfl_xor(sq, 32); mx[bj] = fmaxf(mx[bj], sq); }
                    if (mode == 2) { v0 = silu4(v0); v1 = silu4(v1); }
                    store8_bf16(rowp + bj * 128, v0, v1); } }
        if (want_nrm) { const int kind = (pn < 2) ? 0 : (pn < 4) ? 1 : (pn < 14) ? 2 : 3; const int pb = (pn < 2) ? 0 : (pn < 4) ? 2 : (pn < 14) ? 12 : 14;
#pragma unroll
            for (int bj = 0; bj < 2; ++bj) { float v = mx[bj];
#pragma unroll
                for (int o = 1; o < 16; o <<= 1) v = fmaxf(v, __shfl_xor(v, o));
                const int col = (pn - pb) * 256 + bj * 128 + wc * 32;
                if ((threadIdx.x & 63) == 0) atomicMax(nrm + ((kind * 8 + (u.pm >> 4)) * 8 + (col >> 6)) * 2 + ((col >> 5) & 1), __float_as_uint(v)); } }
        if (pn == 8 || pn == 9) {
#pragma unroll
            for (int ai = 0; ai < 2; ++ai)
#pragma unroll
                for (int m = 0; m < 4; ++m) { const int rl = ai * 128 + wr * 64 + m * 16 + fr; const float sc = rs[ai][m];
                    float s = dot4(acc[ai][0][m][0] * sc) + dot4(acc[ai][0][m][1] * sc);
                    if (pn == 8) s += dot4(acc[ai][1][m][0] * sc) + dot4(acc[ai][1][m][1] * sc);
                    s += __shfl_xor(s, 16); s += __shfl_xor(s, 32);
                    if (fq == 0) side[rl * 4 + wc] = s; }
            asm volatile("s_waitcnt lgkmcnt(0)" ::: "memory"); __builtin_amdgcn_s_barrier(); asm volatile("" ::: "memory");
            if (threadIdx.x < 256) { const int rl = threadIdx.x; const f32x4 v = *(const LAS f32x4*)(side + rl * 4);
                float* RS = (float*)(ws + (pn == 8 ? WS_RSCQ : WS_RSCKV)); RS[u.pm * 256 + rl] = rsqrtf(sum4(v) * (pn == 8 ? 1.0f / 256.0f : 1.0f / 128.0f) + EPS); }
        }
        if (pn == 9) {
            float* KRF = (float*)(ws + WS_KRF); float* FFL = (float*)(ws + WS_FFL);
#pragma unroll
            for (int ai = 0; ai < 2; ++ai)
#pragma unroll
                for (int m = 0; m < 4; ++m) { const int row = u.pm * 256 + ai * 128 + wr * 64 + m * 16 + fr; const float sc = rs[ai][m];
                    const f32x4 v0 = acc[ai][1][m][0] * sc, v1 = acc[ai][1][m][1] * sc;
                    if (wc < 2) { float* p = KRF + (size_t)row * 64 + cw; *(f32x4*)p = v0; *(f32x4*)(p + 4) = v1; }
                    else if (wc == 2 && fq == 0) { float* p = FFL + (size_t)row * 8; const f32x4 b0 = *(const f32x4*)bfp, b1 = *(const f32x4*)(bfp + 4); f32x4 l0, l1;
#pragma unroll
                        for (int e = 0; e < 4; ++e) { l0[e] = log_sigmoid_fast(v0[e] + b0[e]); l1[e] = log_sigmoid_fast(v1[e] + b1[e]); }
                        *(f32x4*)p = l0; *(f32x4*)(p + 4) = l1; } }
        }
        if (pn == 14 || pn == 15) {
            float* KP = (float*)(ws + WS_KPART) + ((size_t)(u.pm * 2 + wr)) * 512 + (pn - 14) * 256;
#pragma unroll
            for (int bj = 0; bj < 2; ++bj)
#pragma unroll
                for (int n = 0; n < 2; ++n) { f32x4 s = (f32x4){0.f, 0.f, 0.f, 0.f};
#pragma unroll
                    for (int ai = 0; ai < 2; ++ai)
#pragma unroll
                        for (int m = 0; m < 4; ++m) s += acc[ai][bj][m][n] * rs[ai][m];
#pragma unroll
                    for (int o = 1; o < 16; o <<= 1) { s[0] += __shfl_xor(s[0], o); s[1] += __shfl_xor(s[1], o); s[2] += __shfl_xor(s[2], o); s[3] += __shfl_xor(s[3], o); }
                    if (fr == 0) *(f32x4*)(KP + bj * 128 + cw + 4 * n) = s; }
        }
    }
};

struct EpiQ {
    static constexpr bool PERM = true;
    unsigned char* ws;
    __device__ __forceinline__ void operator()(const f32x4 (&acc)[2][2][4][2], const pg8::Unit& u, int wr, int wc, int fr, int fq) const {
        const float* RS = (const float*)(ws + WS_RSCQ); bf16_t* QM = (bf16_t*)(ws + WS_QM);
        const float* COS = (const float*)(ws + WS_ROPE); const float* SIN = COS + SEQ * 32;
        const int pn = u.pn, cw = wc * 32 + 8 * fq;
#pragma unroll
        for (int ai = 0; ai < 2; ++ai)
#pragma unroll
            for (int m = 0; m < 4; ++m) { const int row = u.pm * 256 + ai * 128 + wr * 64 + m * 16 + fr;
                const float sc = RS[row] * C2_192;
                if (pn < 2) {
#pragma unroll
                    for (int bj = 0; bj < 2; ++bj) { const int head = pn * 2 + bj; store8_bf16(QM + (size_t)row * 768 + head * 192 + cw, acc[ai][bj][m][0] * sc, acc[ai][bj][m][1] * sc); }
                } else {
                    const int tpos = row & (SEQ - 1); const float* cp = COS + (size_t)tpos * 32 + 8 * fq; const float* sp = SIN + (size_t)tpos * 32 + 8 * fq;
                    const f32x4 c0 = *(const f32x4*)cp, c1 = *(const f32x4*)(cp + 4), s0 = *(const f32x4*)sp, s1 = *(const f32x4*)(sp + 4);
                    const f32x4 x10 = acc[ai][0][m][0] * sc, x11 = acc[ai][0][m][1] * sc, x20 = acc[ai][1][m][0] * sc, x21 = acc[ai][1][m][1] * sc;
                    bf16_t* p = QM + (size_t)row * 768 + wc * 192 + 128 + 8 * fq;
                    store8_bf16(p, x10 * c0 - x20 * s0, x11 * c1 - x21 * s1);
                    store8_bf16(p + 32, x20 * c0 + x10 * s0, x21 * c1 + x11 * s1);
                    if (m & 1) asm volatile("" ::: "memory");
                } }
    }
};
struct EpiKV {
    static constexpr bool PERM = true;
    unsigned char* ws;
    __device__ __forceinline__ void operator()(const f32x4 (&acc)[2][2][4][2], const pg8::Unit& u, int wr, int wc, int fr, int fq) const {
        const float* RS = (const float*)(ws + WS_RSCKV);
        const int pn = u.pn, cw = wc * 32 + 8 * fq;
        bf16_t* base = (pn < 2) ? (bf16_t*)(ws + WS_KM) + (pn * 2) * 192 + cw : (bf16_t*)(ws + WS_VM) + (pn - 2) * 256 + cw;
        const int pitch = (pn < 2) ? 768 : 512, bjs = (pn < 2) ? 192 : 128;
#pragma unroll
        for (int ai = 0; ai < 2; ++ai)
#pragma unroll
            for (int m = 0; m < 4; ++m) { const int row = u.pm * 256 + ai * 128 + wr * 64 + m * 16 + fr; const float sc = RS[row]; bf16_t* rowp = base + (size_t)row * pitch;
#pragma unroll
                for (int bj = 0; bj < 2; ++bj) store8_bf16(rowp + bj * bjs, acc[ai][bj][m][0] * sc, acc[ai][bj][m][1] * sc); }
    }
};
struct EpiC {
    static constexpr bool PERM = false;
    const float* xin; const bf16_t* xbin; bf16_t* xbout; unsigned char* ws; int last;
    __device__ __forceinline__ void operator()(const f32x4 (&acc)[2][2][4][2], const pg8::Unit& u, int wr, int wc, int fr, int fq) const {
        float* SSX = (float*)(ws + WS_SSX);
#pragma unroll
        for (int ai = 0; ai < 2; ++ai)
#pragma unroll
            for (int m = 0; m < 4; ++m) { const int row = u.pm * 256 + ai * 128 + wr * 64 + m * 16 + fr; const size_t off = (size_t)row * DM + u.pn * 256 + wc * 32 + 4 * fq; float ss = 0.f;
#pragma unroll
                for (int bj = 0; bj < 2; ++bj)
#pragma unroll
                    for (int n = 0; n < 2; ++n) { const size_t o = off + bj * 128 + n * 16; f32x4 r;
                        if (xin) r = *(const f32x4*)(xin + o);
                        else { const u32x2 w = *(const u32x2*)(xbin + o); r[0] = __uint_as_float(w.x << 16); r[1] = __uint_as_float(w.x & 0xffff0000u); r[2] = __uint_as_float(w.y << 16); r[3] = __uint_as_float(w.y & 0xffff0000u); }
                        const f32x4 v = acc[ai][bj][m][n] + r; ss += dot4(v);
                        u32x2 w; w.x = cvt_pk_bf16(v[0], v[1]); w.y = cvt_pk_bf16(v[2], v[3]); *(u32x2*)(xbout + o) = w; }
                if (!last) { ss += __shfl_xor(ss, 16); ss += __shfl_xor(ss, 32); if (fq == 0) SSX[(size_t)row * 16 + u.pn * 4 + wc] = ss; } }
    }
};

#define SBAR() __builtin_amdgcn_sched_barrier(0)
__device__ __forceinline__ int crow(int r, int hi) { return (r & 3) + 8 * (r >> 2) + 4 * hi; }
template <int OFF> __device__ __forceinline__ s16x4 tr_read(int vb) { s16x4 r; asm volatile("ds_read_b64_tr_b16 %0, %1 offset:%2" : "=&v"(r) : "v"(vb), "i"(OFF) : "memory"); return r; }
__device__ __forceinline__ int v_rd_base(int lane) { return ((lane & 3) << 3) | (((lane >> 2) & 3) << 6) | (((lane >> 4) & 1) << 5) | (((lane >> 5) & 1) << 8); }
template <int NCB> __device__ __forceinline__ int v_st(int k, int c) { const int kk = (k & ~0xC) | ((k & 4) << 1) | ((k & 8) >> 1); return ((kk >> 3) * NCB + (c >> 5)) * 512 + ((kk & 7) * 32 + (c & 31)) * 2; }
template <int NCB, int D0> __device__ __forceinline__ void pv_one(f32x16& od, int vb, bf16x8 pa0, bf16x8 pa1, bf16x8 pa2, bf16x8 pa3) {
#define VOFF(ks, half) (((2 * (ks) + (half)) * NCB + D0) * 512)
    const s16x4 l0 = tr_read<VOFF(0, 0)>(vb), h0 = tr_read<VOFF(0, 1)>(vb), l1 = tr_read<VOFF(1, 0)>(vb), h1 = tr_read<VOFF(1, 1)>(vb);
    const s16x4 l2 = tr_read<VOFF(2, 0)>(vb), h2 = tr_read<VOFF(2, 1)>(vb), l3 = tr_read<VOFF(3, 0)>(vb), h3 = tr_read<VOFF(3, 1)>(vb);
#undef VOFF
    asm volatile("s_waitcnt lgkmcnt(0)" ::: "memory"); SBAR();
#define PK(L, H) (bf16x8){L[0], L[1], L[2], L[3], H[0], H[1], H[2], H[3]}
    od = __builtin_amdgcn_mfma_f32_32x32x16_bf16(pa0, PK(l0, h0), od, 0, 0, 0);
    od = __builtin_amdgcn_mfma_f32_32x32x16_bf16(pa1, PK(l1, h1), od, 0, 0, 0);
    od = __builtin_amdgcn_mfma_f32_32x32x16_bf16(pa2, PK(l2, h2), od, 0, 0, 0);
    od = __builtin_amdgcn_mfma_f32_32x32x16_bf16(pa3, PK(l3, h3), od, 0, 0, 0);
#undef PK
}
struct AttnP {
    const bf16_t* Q; int ldq;
    const bf16_t* K; int ldk;
    const bf16_t* V; int ldv;
    bf16_t* O; int ldo;
    const bf16_t* G; int ldg;
    float* SSQ; int nh;
    const float* bias;
    const unsigned* sel;
    const float* nrm;
    const unsigned char* jstart;
};
template <int DK, int DV, int MODE>
__device__ __forceinline__ void attn_unit(const AttnP& P, int b, int h, int qb, char* lds) {
    constexpr int NKL = DK / 64, NVL = DV / 64, NCB = DV / 32, ND0 = DK / 16, KB = 64 * DK * 2, VB = 64 * DV * 2;
    constexpr float THR = 8.0f;
    int tid_ = threadIdx.x; asm volatile("" : "+v"(tid_));
    const int tid = tid_, lane = tid & 63, r32 = lane & 31, hi = lane >> 5; const int wid = __builtin_amdgcn_readfirstlane(tid >> 6);
    char* Kl = lds; char* Vl = lds + 2 * KB; float* wsf = (float*)(lds + 2 * KB + 2 * VB) + wid * 64;
    const int q0 = qb * 256; const size_t row0 = (size_t)b * SEQ;
    const int qrow = q0 + wid * 32 + r32;
    const int qlast = q0 + wid * 32 + 31;
    bf16x8 qr[ND0];
    { const bf16_t* Qw = P.Q + (row0 + qrow) * P.ldq + h * DK + hi * 8;
#pragma unroll
      for (int d0 = 0; d0 < ND0; ++d0) qr[d0] = *(const bf16x8*)(Qw + d0 * 16); }
    const int sr = tid >> 3, sc = (tid & 7) * 8;
    const bf16_t* Kg = P.K + (row0 + sr) * P.ldk + h * DK + sc;
    const bf16_t* Vg = P.V + (row0 + sr) * P.ldv + h * DV + sc;
    const int vb0 = (int)(uintptr_t)Vl + v_rd_base(lane);
    const int NT = 4 * (qb + 1);
    int jskip = 0;
    unsigned selw = 0u; float alpha_b = 0.f;
    if (MODE == 2) { selw = P.sel[(row0 + qrow) * 8 + h]; alpha_b = LOG2E * __builtin_amdgcn_exp2f(-(float)(h + 1));
        const float* nq = P.nrm + (((2 * 8 + b) * 8 + h) * 2); const float* nk = P.nrm + (((3 * 8 + b) * 8 + h) * 2);
        const float smax = 1.02f * sqrtf((nq[0] + nq[1]) * (nk[0] + nk[1]));
        const float dist = (40.0f + 2.0f * smax) / alpha_b;
        const float jf = ((float)(q0 - 63) - dist) * (1.0f / 64.0f);
        int js = (jf < 0.f) ? 0 : (int)jf + 1; if (js > 4 * qb) js = 4 * qb; jskip = __builtin_amdgcn_readfirstlane(js); }
    if (MODE == 0) { jskip = __builtin_amdgcn_readfirstlane((int)P.jstart[(b * 8 + h) * 16 + qb]); }
    const float* biasp = (MODE == 0) ? P.bias + (size_t)(b * 8 + h) * SEQ + 4 * hi : nullptr;
    const int NS = NT - jskip;
#define JOF(s_) ((MODE == 2) ? (((s_) < 4) ? (s_) : (s_) + jskip) : (s_) + jskip)
#define KEY0(j) ((MODE == 2) ? (((j) < 4) ? q0 + 64 * (j) : 64 * ((j) - 4)) : 64 * (j))
    bf16x8 ks[NKL], vs[NVL];
#define SLOAD(k0) do { _Pragma("unroll") for (int i_ = 0; i_ < NKL; ++i_) ks[i_] = *(const bf16x8*)(Kg + (size_t)(k0) * P.ldk + 64 * i_); \
                       _Pragma("unroll") for (int i_ = 0; i_ < NVL; ++i_) vs[i_] = *(const bf16x8*)(Vg + (size_t)(k0) * P.ldv + 64 * i_); } while (0)
#define SWRITE(bsel) do { _Pragma("unroll") for (int i_ = 0; i_ < NKL; ++i_) *(bf16x8*)(Kl + (bsel) * KB + sr * (DK * 2) + ((((sc + 64 * i_) * 2)) ^ ((sr & 7) << 4))) = ks[i_]; \
                          _Pragma("unroll") for (int i_ = 0; i_ < NVL; ++i_) *(bf16x8*)(Vl + (bsel) * VB + v_st<NCB>(sr, sc + 64 * i_)) = vs[i_]; } while (0)
    float m_reg = -1e30f, l_reg = 0.f; f32x16 o[NCB];
#pragma unroll
    for (int d = 0; d < NCB; ++d) o[d] = f32x16{};
    SLOAD(KEY0(JOF(0))); SWRITE(0);
    for (int st = 0; st < NS; ++st) { const int j = JOF(st);
        __syncthreads();
        const int key0 = KEY0(j); const int bsel = st & 1;
        if (st + 1 < NS) SLOAD(KEY0(JOF(st + 1)));
        bool active = true;
        if (MODE == 2 && j >= 4) { active = __any((int)((selw >> ((j - 4) >> 2)) & 1u)); }
        else { active = key0 <= qlast; }
        if (active) {
            f32x16 p0 = f32x16{}, p1 = f32x16{};
            const char* Kb = Kl + bsel * KB;
#pragma unroll
            for (int d0 = 0; d0 < ND0; ++d0) { const int cb = (d0 * 16 + hi * 8) * 2;
                const bf16x8 b0 = *(const bf16x8*)(Kb + r32 * (DK * 2) + (cb ^ ((r32 & 7) << 4)));
                const bf16x8 b1 = *(const bf16x8*)(Kb + (32 + r32) * (DK * 2) + (cb ^ ((r32 & 7) << 4)));
                p0 = __builtin_amdgcn_mfma_f32_32x32x16_bf16(b0, qr[d0], p0, 0, 0, 0);
                p1 = __builtin_amdgcn_mfma_f32_32x32x16_bf16(b1, qr[d0], p1, 0, 0, 0); }
            if (MODE == 0) {
#pragma unroll
                for (int g = 0; g < 4; ++g) { const f32x4 b0 = *(const f32x4*)(biasp + key0 + 8 * g), b1 = *(const f32x4*)(biasp + key0 + 32 + 8 * g);
#pragma unroll
                    for (int i = 0; i < 4; ++i) { p0[4 * g + i] += b0[i]; p1[4 * g + i] += b1[i]; } }
            }
            if (MODE == 2) { const float kb = (float)(key0 - q0 + 4 * hi);
#pragma unroll
                for (int r = 0; r < 16; ++r) { const float kk = kb + (float)((r & 3) + 8 * (r >> 2)); p0[r] = __builtin_fmaf(alpha_b, kk, p0[r]); p1[r] = __builtin_fmaf(alpha_b, kk + 32.0f, p1[r]); } }
            if (MODE == 2 && j >= 4) { if (!((selw >> ((j - 4) >> 2)) & 1u)) {
#pragma unroll
                for (int r = 0; r < 16; ++r) { p0[r] = -INFINITY; p1[r] = -INFINITY; } } }
            else if (key0 + 63 > q0 + wid * 32) { const int kb = key0 + 4 * hi;
#pragma unroll
                for (int r = 0; r < 16; ++r) { const int kv = kb + (r & 3) + 8 * (r >> 2); if (kv > qrow) p0[r] = -INFINITY; if (kv + 32 > qrow) p1[r] = -INFINITY; } }
            float pmax = p0[0];
#pragma unroll
            for (int r = 1; r < 16; ++r) pmax = fmaxf(pmax, p0[r]);
#pragma unroll
            for (int r = 0; r < 16; ++r) pmax = fmaxf(pmax, p1[r]);
            { auto rr = __builtin_amdgcn_permlane32_swap(__float_as_uint(pmax), __float_as_uint(pmax), false, false); pmax = fmaxf(__uint_as_float(rr[0]), __uint_as_float(rr[1])); }
            if (!__all(pmax - m_reg <= THR)) {
                const float mn = fmaxf(m_reg, pmax); const float al = __builtin_amdgcn_exp2f(m_reg - mn); m_reg = mn; l_reg *= al;
                if (hi == 0) wsf[r32] = al; asm volatile("s_waitcnt lgkmcnt(0)" ::: "memory");
#pragma unroll
                for (int r = 0; r < 16; ++r) { const float a = wsf[crow(r, hi)];
#pragma unroll
                    for (int d = 0; d < NCB; ++d) o[d][r] *= a; }
            }
            float ps = 0.f;
#pragma unroll
            for (int r = 0; r < 16; ++r) { p0[r] = __builtin_amdgcn_exp2f(p0[r] - m_reg); p1[r] = __builtin_amdgcn_exp2f(p1[r] - m_reg); ps += p0[r] + p1[r]; }
            { auto rr = __builtin_amdgcn_permlane32_swap(__float_as_uint(ps), __float_as_uint(ps), false, false); ps = __uint_as_float(rr[0]) + __uint_as_float(rr[1]); }
            l_reg += ps;
            bf16x8 pa0, pa1, pa2, pa3;
#define PK4(Pv, BASE, OUT) do { unsigned a0 = cvt_pk_bf16(Pv[BASE + 0], Pv[BASE + 1]), a1 = cvt_pk_bf16(Pv[BASE + 2], Pv[BASE + 3]); \
    unsigned b0_ = cvt_pk_bf16(Pv[BASE + 4], Pv[BASE + 5]), b1_ = cvt_pk_bf16(Pv[BASE + 6], Pv[BASE + 7]); \
    auto r0 = __builtin_amdgcn_permlane32_swap(a0, b0_, false, false); auto r1 = __builtin_amdgcn_permlane32_swap(a1, b1_, false, false); \
    u32x4 w = {r0[0], r1[0], r0[1], r1[1]}; OUT = *reinterpret_cast<bf16x8*>(&w); } while (0)
            PK4(p0, 0, pa0); PK4(p0, 8, pa1); PK4(p1, 0, pa2); PK4(p1, 8, pa3);
#undef PK4
            const int vb = vb0 + bsel * VB;
            pv_one<NCB, 0>(o[0], vb, pa0, pa1, pa2, pa3); pv_one<NCB, 1>(o[1], vb, pa0, pa1, pa2, pa3);
            if constexpr (NCB == 4) { pv_one<NCB, 2>(o[2], vb, pa0, pa1, pa2, pa3); pv_one<NCB, 3>(o[3], vb, pa0, pa1, pa2, pa3); }
        }
        if (st + 1 < NS) SWRITE((st + 1) & 1);
    }
    if (hi == 0) wsf[32 + r32] = l_reg; asm volatile("s_waitcnt lgkmcnt(0)" ::: "memory");
    const size_t orow0 = row0 + q0 + wid * 32;
#pragma unroll
    for (int r = 0; r < 16; ++r) { const int orow = crow(r, hi); const float rl = __builtin_amdgcn_rcpf(wsf[32 + orow]); float ss = 0.f;
        float y[NCB];
#pragma unroll
        for (int d = 0; d < NCB; ++d) { y[d] = o[d][r] * rl; ss += y[d] * y[d]; }
#pragma unroll
        for (int sh = 1; sh < 32; sh <<= 1) ss += __shfl_xor(ss, sh);
        if (r32 == 0) P.SSQ[(orow0 + orow) * P.nh + h] = ss;
#pragma unroll
        for (int d = 0; d < NCB; ++d) { const size_t gi = (orow0 + orow) * P.ldg + h * DV + d * 32 + r32; const float gt = bf2f(P.G[gi]);
            const size_t oi = (orow0 + orow) * P.ldo + h * DV + d * 32 + r32; P.O[oi] = (bf16_t)(cvt_pk_bf16(y[d] * gt, 0.f) & 0xffffu); } }
    __syncthreads();
#undef KEY0
#undef JOF
#undef SLOAD
#undef SWRITE
}


#define XB_TMO      128
#define XB_XCNT(j)  (256  + 64 * (j))
#define XB_XSUB(j)  (1280 + 64 * (j))
#define XB_XGEN(j)  (2304 + 64 * (j))
#define XB_TOP      3328
#define XB_TOPGEN   3392
#define XCD_BAR_WORDS 3456
#define XB_SPIN_CAP (1u << 18)
__device__ __forceinline__ unsigned xb_ld(unsigned* p)              { return __hip_atomic_load(p, __ATOMIC_RELAXED, __HIP_MEMORY_SCOPE_AGENT); }
__device__ __forceinline__ unsigned xb_add(unsigned* p, unsigned v) { return __hip_atomic_fetch_add(p, v, __ATOMIC_RELAXED, __HIP_MEMORY_SCOPE_AGENT); }
__device__ __forceinline__ unsigned xb_xcc_id() { return (unsigned)__builtin_amdgcn_s_getreg((3 << 11) | 20) & 0xFu; }
#define XB_SPIN(cond, bar) do { unsigned _sp = 0; while (cond) { __builtin_amdgcn_s_sleep(1); \
    if ((++_sp & 255u) == 0u) { if (xb_ld(&(bar)[XB_TMO])) break; if (_sp > XB_SPIN_CAP) { atomicAdd(&(bar)[XB_TMO], 1u); break; } } } } while (0)
struct XcdBarrier { unsigned* bar; unsigned x; volatile LAS unsigned* st; };
__device__ __forceinline__ XcdBarrier xcd_barrier_post(unsigned* bar, volatile LAS unsigned* st) {
    XcdBarrier b; b.bar = bar; b.x = xb_xcc_id(); b.st = st;
    if (threadIdx.x == 0) (void)xb_add(&bar[XB_XCNT(b.x)], 1u);
    return b;
}
__device__ __forceinline__ void xcd_barrier_complete(unsigned* bar, unsigned x, unsigned& nloc, unsigned& nx) {
    const unsigned G = gridDim.x * gridDim.y * gridDim.z;
    unsigned sum, cnt, mine, sp = 0u;
    for (;;) {
        sum = 0u; cnt = 0u; mine = 0u;
#pragma unroll
        for (unsigned j = 0; j < 16; ++j) { const unsigned c = xb_ld(&bar[XB_XCNT(j)]); sum += c; cnt += (c > 0u) ? 1u : 0u; mine = (j == x) ? c : mine; }
        if (sum == G) break;
        __builtin_amdgcn_s_sleep(1);
        if ((++sp & 255u) == 0u) { if (xb_ld(&bar[XB_TMO])) break; if (sp > XB_SPIN_CAP) { atomicAdd(&bar[XB_TMO], 1u); break; } }
    }
    nloc = mine > 0u ? mine : 1u; nx = cnt > 0u ? cnt : 1u;
}
__device__ __forceinline__ void xcd_barrier(const XcdBarrier& b) {
    asm volatile("s_waitcnt vmcnt(0)" ::: "memory");
    __syncthreads();
    if (threadIdx.x == 0) {
        unsigned* bar = b.bar;
        __builtin_amdgcn_s_waitcnt(0);
        unsigned nloc = b.st[0], nx = b.st[1];
        if (nloc == 0u) { xcd_barrier_complete(bar, b.x, nloc, nx); b.st[0] = nloc; b.st[1] = nx; }
        const unsigned old = xb_add(&bar[XB_XSUB(b.x)], 1u);
        const unsigned gen = old / nloc;
        if (old + 1u == (gen + 1u) * nloc) {
            __builtin_amdgcn_fence(__ATOMIC_RELEASE, "agent");
            asm volatile("s_waitcnt vmcnt(0)" ::: "memory");
            const unsigned og = xb_add(&bar[XB_TOP], 1u);
            const unsigned tg = og / nx;
            if (og + 1u == (tg + 1u) * nx) xb_add(&bar[XB_TOPGEN], 1u);
            else XB_SPIN(xb_ld(&bar[XB_TOPGEN]) == tg, bar);
            __builtin_amdgcn_fence(__ATOMIC_ACQUIRE, "agent");
            xb_add(&bar[XB_XGEN(b.x)], 1u);
            asm volatile("s_waitcnt vmcnt(0)" ::: "memory");
        } else {
            XB_SPIN(xb_ld(&bar[XB_XGEN(b.x)]) == gen, bar);
            __builtin_amdgcn_fence(__ATOMIC_ACQUIRE, "agent");
            asm volatile("s_waitcnt vmcnt(0)" ::: "memory");
        }
    }
    __syncthreads();
}
constexpr int CW_BAR = 4096;

struct UTab { unsigned short v[2560]; };
constexpr UTab make_utab() {
    UTab t{}; int k = 0;
    for (int c = 80; c >= 1; --c) {
        if (c % 5 == 0 && c / 5 <= 16) { const int qb = c / 5 - 1; for (int b = 0; b < 8; ++b) for (int h = 0; h < 4; ++h) t.v[k++] = (unsigned short)((1 << 12) | (b << 8) | (h << 4) | qb); }
        if (c % 2 == 0 && c / 2 <= 16) { const int qb = c / 2 - 1; for (int ty = 0; ty <= 2; ty += 2) for (int b = 0; b < 8; ++b) for (int h = 0; h < 8; ++h) t.v[k++] = (unsigned short)((ty << 12) | (b << 8) | (h << 4) | qb); }
    }
    return t;
}
__device__ const UTab g_utab = make_utab();
constexpr int N_ATT_UNITS = 2560;

struct Args { const float* in[11]; float* out; unsigned char* ws; int ph_lo, ph_hi, coop, pad; };
#ifndef PHM
#define PHM 127
#endif
#ifndef B1M
#define B1M 31
#endif
#ifndef DBL
#define DBL 0
#endif
constexpr int NPHASES = 13;

__device__ __forceinline__ int src_in(int n) {
    const int t = n >> 8, j = n & 255;
    if (t < 6) return n;
    if (t < 8) return 1544 + (n - 1536);
    if (t == 8) return 2056 + j;
    if (t == 9) return j < 128 ? 2312 + j : (j < 192 ? 2440 + (j - 128) : (j < 200 ? 1536 + (j - 192) : -1));
    if (t < 12) return 2504 + (n - 2560);
    return 3016 + (n - 3072);
}
__device__ __forceinline__ int src_uq(int n) {
    if (n < 512) return (n >> 7) * 192 + (n & 127);
    const int p = n - 512; return p < 128 ? (p >> 5) * 192 + 128 + (p & 31) : ((p - 128) >> 5) * 192 + 160 + ((p - 128) & 31);
}
__device__ __forceinline__ int src_ukv(int n) {
    return n < 512 ? (n >> 7) * 256 + (n & 127) : ((n - 512) >> 7) * 256 + 128 + ((n - 512) & 127);
}
__device__ __forceinline__ void transpose_item(const float* W, int Ksrc, int Nsrc, const float* gain, bf16_t* WT, int Kdst, int mat, LAS float* scr, int kb, int nb, int lane) {
    const int k0 = 64 * kb, n0 = 32 * nb; const int nn = n0 + (lane & 31);
    const int sc = (mat == 0) ? src_in(nn) : (mat == 1) ? src_uq(nn) : (mat == 2) ? src_ukv(nn) : nn;
#pragma unroll 8
    for (int i = 0; i < 32; ++i) { const int kk = 2 * i + (lane >> 5); const int k = k0 + kk;
        float v = 0.f; if (sc >= 0 && k < Ksrc) v = W[(size_t)k * Nsrc + sc] * gain[k];
        scr[kk * 33 + (lane & 31)] = v; }
    asm volatile("s_waitcnt lgkmcnt(0)" ::: "memory");
    const int c = lane & 7;
#pragma unroll
    for (int j = 0; j < 4; ++j) { const int n = (lane >> 3) + 8 * j; const LAS float* s = scr + (8 * c) * 33 + n;
        u32x4 o; o.x = cvt_pk_bf16(s[0 * 33], s[1 * 33]); o.y = cvt_pk_bf16(s[2 * 33], s[3 * 33]); o.z = cvt_pk_bf16(s[4 * 33], s[5 * 33]); o.w = cvt_pk_bf16(s[6 * 33], s[7 * 33]);
        *(u32x4*)(WT + (size_t)(n0 + n) * Kdst + k0 + 8 * c) = o; }
    asm volatile("s_waitcnt lgkmcnt(0)" ::: "memory");
}

__device__ __forceinline__ float log_sigmoid_f(float x) { return fminf(x, 0.f) - log1pf(expf(-fabsf(x))); }

__device__ __forceinline__ void phase_p0(const Args& args, const int layer, LAS unsigned char* lds, unsigned char* lds_raw, const int G, const int bid) {
    unsigned char* ws = args.ws; asm volatile("" : "+s"(ws));
    int tid = threadIdx.x; asm volatile("" : "+v"(tid));
    const int lane = tid & 63, wave = __builtin_amdgcn_readfirstlane(tid >> 6);
    const int gw = bid * NWAVES + wave, NGW = G * NWAVES;
    unsigned char* wl = ws + WS_W + (size_t)layer * W_LAYER;
    (void)lane; (void)gw; (void)NGW; (void)wl; (void)lds_raw;
            LAS float* scr = (LAS float*)(lds + wave * 16384);
            constexpr int I_IN = 16 * 160, I_UQ = 4 * 24, I_UKV = 4 * 32, I_OUT = 24 * 32, I_L = I_IN + I_UQ + I_UKV + I_OUT;
            for (int it = gw; it < 2 * I_L; it += NGW) {
                const int l = it / I_L; int r = it % I_L; unsigned char* w = ws + WS_W + (size_t)l * W_LAYER;
                if (r < I_IN) { transpose_item(args.in[2] + (size_t)l * DM * D_IN, DM, D_IN, args.in[1] + l * DM, (bf16_t*)(w + W_IN_OFF), DM, 0, scr, r / 160, r % 160, lane); continue; } r -= I_IN;
                if (r < I_UQ) { transpose_item(args.in[5] + (size_t)l * 256 * 768, 256, 768, args.in[4] + l * 256, (bf16_t*)(w + W_UQ_OFF), 256, 1, scr, r / 24, r % 24, lane); continue; } r -= I_UQ;
                if (r < I_UKV) { transpose_item(args.in[7] + (size_t)l * 128 * 1024, 128, 1024, args.in[6] + l * 128, (bf16_t*)(w + W_UKV_OFF), 256, 2, scr, r / 32, r % 32, lane); continue; } r -= I_UKV;
                transpose_item(args.in[9] + (size_t)l * DMIX * DM, DMIX, DM, args.in[8] + l * DMIX, (bf16_t*)(w + W_OUT_OFF), DMIX, 3, scr, r / 32, r % 32, lane);
            }
            { const float* x = args.in[0]; bf16_t* XB = (bf16_t*)(ws + WS_XB); float* RSX = (float*)(ws + WS_RSX);
              for (int m = gw; m < T; m += NGW) { const f32x4* xr = (const f32x4*)(x + (size_t)m * DM) + lane; f32x4 v[4]; float s = 0.f;
#pragma unroll
                  for (int j = 0; j < 4; ++j) { v[j] = xr[64 * j]; s += dot4(v[j]); }
                  s = wave_sum(s);
                  u32x2* o8 = (u32x2*)(XB + (size_t)m * DM) + lane;
#pragma unroll
                  for (int j = 0; j < 4; ++j) { u32x2 w; w.x = cvt_pk_bf16(v[j][0], v[j][1]); w.y = cvt_pk_bf16(v[j][2], v[j][3]); o8[64 * j] = w; }
                  if (lane == 0) RSX[m] = rsqrtf(s * (1.0f / 1024.0f) + EPS); } }
            { float* COS = (float*)(ws + WS_ROPE); float* SIN = COS + SEQ * 32;
              for (int i = bid * NTHREADS + tid; i < SEQ * 32; i += G * NTHREADS) { const int t = i >> 5, f = i & 31;
                  const float inv = powf(10000.0f, -(float)(2 * f) / 64.0f); const float ang = (float)t * inv;
                  COS[i] = (float)cos((double)ang); SIN[i] = (float)sin((double)ang); } }
}

__device__ __forceinline__ void phase_a(const Args& args, const int layer, LAS unsigned char* lds, unsigned char* lds_raw, const int G, const int bid) {
    unsigned char* ws = args.ws; asm volatile("" : "+s"(ws));
    int tid = threadIdx.x; asm volatile("" : "+v"(tid));
    const int lane = tid & 63, wave = __builtin_amdgcn_readfirstlane(tid >> 6);
    const int gw = bid * NWAVES + wave, NGW = G * NWAVES;
    unsigned char* wl = ws + WS_W + (size_t)layer * W_LAYER;
    (void)lane; (void)gw; (void)NGW; (void)wl; (void)lds_raw;
            pg8::Gemm g{layer == 0 ? (const bf16_t*)(ws + WS_XB) : (const bf16_t*)args.out, (const bf16_t*)(wl + W_IN_OFF), T, NIN, DM, DM}; pg8::StaticOrder S; S.init(T, NIN, G, bid);
            EpiA E{ws, (LAS float*)(lds + SIDE_OFF), args.in[3] + layer * 8, (unsigned*)(ws + WS_CTL) + CW_NRM + layer * 512};
            pg8::gemm_phase<EpiA, true>(lds, g, S, E);
}

__device__ __forceinline__ void phase_b1(const Args& args, const int layer, LAS unsigned char* lds, unsigned char* lds_raw, const int G, const int bid) {
    unsigned char* ws = args.ws; asm volatile("" : "+s"(ws));
    int tid = threadIdx.x; asm volatile("" : "+v"(tid));
    const int lane = tid & 63, wave = __builtin_amdgcn_readfirstlane(tid >> 6);
    const int gw = bid * NWAVES + wave, NGW = G * NWAVES;
    unsigned char* wl = ws + WS_W + (size_t)layer * W_LAYER;
    (void)lane; (void)gw; (void)NGW; (void)wl; (void)lds_raw;
            if (B1M & 1) { pg8::Gemm g{(const bf16_t*)(ws + WS_QG) + 512, (const bf16_t*)(wl + W_UQ_OFF), T, 768, 256, 1536}; pg8::StaticOrder S; S.init(T, 768, G, bid);
              EpiQ E{ws}; pg8::gemm_phase<EpiQ, true>(lds, g, S, E); }
            if (B1M & 2) { pg8::Gemm g{(const bf16_t*)(ws + WS_QG) + 768, (const bf16_t*)(wl + W_UKV_OFF), T, 1024, 256, 1536}; pg8::StaticOrder S; S.init(T, 1024, G, bid);
              EpiKV E{ws}; pg8::gemm_phase<EpiKV, true>(lds, g, S, E); }
            if (B1M & 4) { const float* KRF = (const float*)(ws + WS_KRF); bf16_t* KM = (bf16_t*)(ws + WS_KM); const float* COS = (const float*)(ws + WS_ROPE); const float* SIN = COS + SEQ * 32;
              for (int i = bid * NTHREADS + tid; i < T * 8; i += G * NTHREADS) { const int t = i >> 3, c4 = (i & 7) * 4; const int tp = t & (SEQ - 1);
                  const f32x4 x1 = *(const f32x4*)(KRF + (size_t)t * 64 + c4), x2 = *(const f32x4*)(KRF + (size_t)t * 64 + 32 + c4);
                  const f32x4 c = *(const f32x4*)(COS + tp * 32 + c4), s = *(const f32x4*)(SIN + tp * 32 + c4);
                  const f32x4 o1 = x1 * c - x2 * s, o2 = x2 * c + x1 * s;
                  u32x2 w1, w2; w1.x = cvt_pk_bf16(o1[0], o1[1]); w1.y = cvt_pk_bf16(o1[2], o1[3]); w2.x = cvt_pk_bf16(o2[0], o2[1]); w2.y = cvt_pk_bf16(o2[2], o2[3]);
#pragma unroll
                  for (int hh = 0; hh < 4; ++hh) { bf16_t* p = KM + (size_t)t * 768 + hh * 192 + 128 + c4; *(u32x2*)p = w1; *(u32x2*)(p + 32) = w2; } } }
            if (B1M & 8) { const float* FFL = (const float*)(ws + WS_FFL); float* BF = (float*)(ws + WS_BIASF); LAS float* xs = (LAS float*)lds;
              for (int b = bid; b < BATCH; b += G) {
                  const float* src = FFL + ((size_t)b * SEQ + tid * 8) * 8; float v[8][8];
#pragma unroll
                  for (int i = 0; i < 8; ++i) { const f32x4 a = *(const f32x4*)(src + i * 8), c = *(const f32x4*)(src + i * 8 + 4);
#pragma unroll
                      for (int e = 0; e < 4; ++e) { v[i][e] = a[e]; v[i][4 + e] = c[e]; } }
#pragma unroll
                  for (int i = 1; i < 8; ++i)
#pragma unroll
                      for (int h = 0; h < 8; ++h) v[i][h] += v[i - 1][h];
                  float off[8];
#pragma unroll
                  for (int h = 0; h < 8; ++h) { const float tot = v[7][h]; float incl = tot;
#pragma unroll
                      for (int o = 1; o < 64; o <<= 1) { const float n = __shfl_up(incl, o); if (lane >= o) incl += n; }
                      off[h] = incl - tot; if (lane == 63) xs[wave * 8 + h] = incl; }
                  __syncthreads();
#pragma unroll
                  for (int h = 0; h < 8; ++h) { float wo = 0.f; for (int w = 0; w < wave; ++w) wo += xs[w * 8 + h]; off[h] += wo; }
#pragma unroll
                  for (int h = 0; h < 8; ++h) { float* dst = BF + (size_t)(b * 8 + h) * SEQ + tid * 8; f32x4 o0, o1;
#pragma unroll
                      for (int e = 0; e < 4; ++e) { o0[e] = -LOG2E * (v[e][h] + off[h]); o1[e] = -LOG2E * (v[4 + e][h] + off[h]); }
                      *(f32x4*)dst = o0; *(f32x4*)(dst + 4) = o1;
                      if ((tid & 7) == 7) xs[64 + h * 64 + (tid >> 3)] = o1[3];
                      if ((tid & 31) == 0) xs[64 + 512 + h * 16 + (tid >> 5)] = o0[0]; }
                  __syncthreads();
                  if (tid < 128) { const int h = tid >> 4, qb = tid & 15; const float* nq = (const float*)(ws + WS_CTL) + CW_NRM + layer * 512 + ((0 * 8 + b) * 8 + h) * 2; const float* nk = nq + 8 * 8 * 2;
                      const float smax = 1.02f * sqrtf((nq[0] + nq[1]) * (nk[0] + nk[1])); const float thr = -(40.0f + 2.0f * smax); const float bq0 = xs[64 + 512 + h * 16 + qb];
                      int j = 4 * qb - 1; while (j >= 0 && xs[64 + h * 64 + j] - bq0 > thr) --j;
                      ((unsigned char*)(ws + WS_JSTART))[(b * 8 + h) * 16 + qb] = (unsigned char)(j + 1); }
                  __syncthreads(); } }
            if (B1M & 16) { const float* KP = (const float*)(ws + WS_KPART); const bf16_t* QG = (const bf16_t*)(ws + WS_QG); unsigned* SEL = (unsigned*)(ws + WS_SEL);
              LAS float* km = (LAS float*)lds;
              for (int job = bid; job < 512; job += G) { const int b = job >> 6, h = (job >> 3) & 7, tb = job & 7;
                  __syncthreads();
                  for (int i = tid; i < 1024; i += NTHREADS) { const int n = i >> 6, d = i & 63; const float* p = KP + ((size_t)((b * 16 + n) * 2)) * 512 + h * 64 + d; km[i] = (p[0] + p[512]) * (1.0f / 256.0f); }
                  __syncthreads();
                  const int t = tb * 512 + tid; const int cur = t >> 8; const size_t row = (size_t)b * SEQ + t;
                  float q[64];
                  { const bf16x8* qp = (const bf16x8*)(QG + row * 1536 + 1024 + h * 64);
#pragma unroll
                    for (int c = 0; c < 8; ++c) { const bf16x8 v = qp[c];
#pragma unroll
                        for (int e = 0; e < 8; ++e) q[c * 8 + e] = bf2f((unsigned short)v[e]); } }
                  float g1 = -INFINITY, g2 = -INFINITY, g3 = -INFINITY; int i1 = -1, i2 = -1, i3 = -1;
                  for (int n = 0; n < cur; ++n) { float gsum = 0.f;
#pragma unroll
                      for (int d = 0; d < 64; ++d) gsum = __builtin_fmaf(q[d], km[n * 64 + d], gsum);
                      if (gsum > g1) { g3 = g2; i3 = i2; g2 = g1; i2 = i1; g1 = gsum; i1 = n; }
                      else if (gsum > g2) { g3 = g2; i3 = i2; g2 = gsum; i2 = n; }
                      else if (gsum > g3) { g3 = gsum; i3 = n; } }
                  unsigned m = 0u; if (i1 >= 0) m |= 1u << i1; if (i2 >= 0) m |= 1u << i2; if (i3 >= 0) m |= 1u << i3;
                  SEL[row * 8 + h] = m; }
              __syncthreads(); }
}

__device__ __forceinline__ void phase_b2(const Args& args, const int layer, LAS unsigned char* lds, unsigned char* lds_raw, const int G, const int bid) {
    unsigned char* ws = args.ws; asm volatile("" : "+s"(ws));
    int tid = threadIdx.x; asm volatile("" : "+v"(tid));
    const int lane = tid & 63, wave = __builtin_amdgcn_readfirstlane(tid >> 6);
    const int gw = bid * NWAVES + wave, NGW = G * NWAVES;
    unsigned char* wl = ws + WS_W + (size_t)layer * W_LAYER;
    (void)lane; (void)gw; (void)NGW; (void)wl; (void)lds_raw;
    volatile LAS unsigned* MISC = (volatile LAS unsigned*)(lds + MISC_OFF); unsigned* ctl = (unsigned*)(ws + WS_CTL);
            unsigned* qctr = ctl + CW_QCTR * (1 + layer);
            for (;;) {
                if (tid == 0) MISC[0] = __hip_atomic_fetch_add(qctr, 1u, __ATOMIC_RELAXED, __HIP_MEMORY_SCOPE_AGENT);
                __syncthreads();
                const unsigned k = MISC[0];
                __syncthreads();
                if (k >= (unsigned)N_ATT_UNITS) break;
                const unsigned e = g_utab.v[k]; const int ty = e >> 12, b = (e >> 8) & 7, h = (e >> 4) & 7, qb = e & 15;
                if (ty == 0) { const AttnP PF{(const bf16_t*)(ws + WS_QG), 1536, (const bf16_t*)(ws + WS_FK), 512, (const bf16_t*)(ws + WS_FV), 512, (bf16_t*)(ws + WS_QG), 1536,
                                   (const bf16_t*)(ws + WS_GATE), 1536, (float*)(ws + WS_SSQA), 8, (const float*)(ws + WS_BIASF), nullptr, nullptr, (const unsigned char*)(ws + WS_JSTART)};
                    attn_unit<64, 64, 0>(PF, b, h, qb, (char*)lds_raw); }
                else if (ty == 1) { const AttnP PM{(const bf16_t*)(ws + WS_QM), 768, (const bf16_t*)(ws + WS_KM), 768, (const bf16_t*)(ws + WS_VM), 512, (bf16_t*)(ws + WS_QG) + 512, 1536,
                                   (const bf16_t*)(ws + WS_GATE) + 512, 1536, (float*)(ws + WS_SSQB), 4, nullptr, nullptr, nullptr, nullptr};
                    attn_unit<192, 128, 1>(PM, b, h, qb, (char*)lds_raw); }
                else { const AttnP PB{(const bf16_t*)(ws + WS_QG) + 1024, 1536, (const bf16_t*)(ws + WS_BK), 512, (const bf16_t*)(ws + WS_BV), 512, (bf16_t*)(ws + WS_QG) + 1024, 1536,
                                   (const bf16_t*)(ws + WS_GATE) + 1024, 1536, (float*)(ws + WS_SSQC), 8, nullptr, (const unsigned*)(ws + WS_SEL), (const float*)(ws + WS_CTL) + CW_NRM + layer * 512, nullptr};
                    attn_unit<64, 64, 2>(PB, b, h, qb, (char*)lds_raw); }
            }
}

__device__ __forceinline__ void phase_n(const Args& args, const int layer, LAS unsigned char* lds, unsigned char* lds_raw, const int G, const int bid) {
    unsigned char* ws = args.ws; asm volatile("" : "+s"(ws));
    int tid = threadIdx.x; asm volatile("" : "+v"(tid));
    const int lane = tid & 63, wave = __builtin_amdgcn_readfirstlane(tid >> 6);
    const int gw = bid * NWAVES + wave, NGW = G * NWAVES;
    unsigned char* wl = ws + WS_W + (size_t)layer * W_LAYER;
    (void)lane; (void)gw; (void)NGW; (void)wl; (void)lds_raw;
            bf16_t* Y = (bf16_t*)(ws + WS_QG); const float* SA = (const float*)(ws + WS_SSQA); const float* SB = (const float*)(ws + WS_SSQB); const float* SC = (const float*)(ws + WS_SSQC);
            for (int m = gw; m < T; m += NGW) {
                const f32x4 a0 = *(const f32x4*)(SA + (size_t)m * 8), a1 = *(const f32x4*)(SA + (size_t)m * 8 + 4), b0 = *(const f32x4*)(SB + (size_t)m * 4);
                const f32x4 c0 = *(const f32x4*)(SC + (size_t)m * 8), c1 = *(const f32x4*)(SC + (size_t)m * 8 + 4);
                const float ra = rsqrtf((sum4(a0) + sum4(a1)) * (1.0f / 512.0f) + EPS), rb = rsqrtf(sum4(b0) * (1.0f / 512.0f) + EPS), rc = rsqrtf((sum4(c0) + sum4(c1)) * (1.0f / 512.0f) + EPS);
                u32x4* yp = (u32x4*)(Y + (size_t)m * 1536);
#pragma unroll
                for (int j = 0; j < 3; ++j) { const float r = (j == 0) ? ra : (j == 1) ? rb : rc; u32x4 v = yp[64 * j + lane]; u32x4 o;
#pragma unroll
                    for (int e = 0; e < 4; ++e) { const unsigned w = v[e]; o[e] = cvt_pk_bf16(__uint_as_float(w << 16) * r, __uint_as_float(w & 0xffff0000u) * r); }
                    yp[64 * j + lane] = o; }
            }
}

__device__ __forceinline__ void phase_c(const Args& args, const int layer, LAS unsigned char* lds, unsigned char* lds_raw, const int G, const int bid) {
    unsigned char* ws = args.ws; asm volatile("" : "+s"(ws));
    int tid = threadIdx.x; asm volatile("" : "+v"(tid));
    const int lane = tid & 63, wave = __builtin_amdgcn_readfirstlane(tid >> 6);
    const int gw = bid * NWAVES + wave, NGW = G * NWAVES;
    unsigned char* wl = ws + WS_W + (size_t)layer * W_LAYER;
    (void)lane; (void)gw; (void)NGW; (void)wl; (void)lds_raw;
            pg8::Gemm g{(const bf16_t*)(ws + WS_QG), (const bf16_t*)(wl + W_OUT_OFF), T, DM, DMIX, DMIX}; pg8::StaticOrder S; S.init(T, DM, G, bid);
            EpiC E{layer == 0 ? args.in[0] : (const float*)nullptr, (const bf16_t*)args.out, layer == 0 ? (bf16_t*)args.out : (bf16_t*)(ws + WS_FK), ws, layer == DEPTH - 1 ? 1 : 0};
            pg8::gemm_phase<EpiC, true>(lds, g, S, E);
}

__device__ __forceinline__ void phase_r(const Args& args, const int layer, LAS unsigned char* lds, unsigned char* lds_raw, const int G, const int bid) {
    unsigned char* ws = args.ws; asm volatile("" : "+s"(ws));
    int tid = threadIdx.x; asm volatile("" : "+v"(tid));
    const int lane = tid & 63, wave = __builtin_amdgcn_readfirstlane(tid >> 6);
    const int gw = bid * NWAVES + wave, NGW = G * NWAVES;
    unsigned char* wl = ws + WS_W + (size_t)layer * W_LAYER;
    (void)lane; (void)gw; (void)NGW; (void)wl; (void)lds_raw;
            const float* SSX = (const float*)(ws + WS_SSX); float* RSX = (float*)(ws + WS_RSX);
            for (int m = bid * NTHREADS + tid; m < T; m += G * NTHREADS) { const f32x4* p = (const f32x4*)(SSX + (size_t)m * 16);
                const float sm = (sum4(p[0]) + sum4(p[1])) + (sum4(p[2]) + sum4(p[3])); RSX[m] = rsqrtf(sm * (1.0f / 1024.0f) + EPS); }
}

__device__ __forceinline__ void phase_f(const Args& args, const int layer, LAS unsigned char* lds, unsigned char* lds_raw, const int G, const int bid) {
    unsigned char* ws = args.ws; asm volatile("" : "+s"(ws));
    int tid = threadIdx.x; asm volatile("" : "+v"(tid));
    const int lane = tid & 63, wave = __builtin_amdgcn_readfirstlane(tid >> 6);
    const int gw = bid * NWAVES + wave, NGW = G * NWAVES;
    unsigned char* wl = ws + WS_W + (size_t)layer * W_LAYER;
    (void)lane; (void)gw; (void)NGW; (void)wl; (void)lds_raw;
            float* X = args.out; const float* gf = args.in[10]; const bf16_t* XB = (const bf16_t*)(ws + WS_FK);
            for (int m = gw; m < T; m += NGW) { const u32x4* xr = (const u32x4*)(XB + (size_t)m * DM) + lane; float v[16]; float s = 0.f;
#pragma unroll
                for (int j = 0; j < 2; ++j) { const u32x4 w = xr[64 * j];
#pragma unroll
                    for (int e = 0; e < 4; ++e) { v[j * 8 + 2 * e] = __uint_as_float(w[e] << 16); v[j * 8 + 2 * e + 1] = __uint_as_float(w[e] & 0xffff0000u); } }
#pragma unroll
                for (int e = 0; e < 16; ++e) s += v[e] * v[e];
                const float r = rsqrtf(wave_sum(s) * (1.0f / 1024.0f) + EPS);
#pragma unroll
                for (int j = 0; j < 2; ++j) { const int c0 = (64 * j + lane) * 8; const f32x4 g0 = *(const f32x4*)(gf + c0), g1 = *(const f32x4*)(gf + c0 + 4);
                    f32x4 o0, o1;
#pragma unroll
                    for (int e = 0; e < 4; ++e) { o0[e] = v[j * 8 + e] * r * g0[e]; o1[e] = v[j * 8 + 4 + e] * r * g1[e]; }
                    float* op = X + (size_t)m * DM + c0; *(f32x4*)op = o0; *(f32x4*)(op + 4) = o1; } }
}

__global__ void __launch_bounds__(NTHREADS, 2) fwd_kernel(Args args) {
    extern __shared__ __attribute__((aligned(16))) unsigned char lds_raw[];
    LAS unsigned char* lds = (LAS unsigned char*)lds_raw;
    const int G = gridDim.x, bid = blockIdx.x;
    const int lo = args.ph_lo, hi = args.ph_hi;
    volatile LAS unsigned* MISCW = (volatile LAS unsigned*)(lds + MISC_OFF);
    XcdBarrier xbar; xbar.bar = (unsigned*)(args.ws + WS_CTL) + CW_BAR; xbar.x = 0; xbar.st = MISCW + 8;
    if (args.coop) { if (threadIdx.x == 0) { MISCW[8] = 0u; MISCW[9] = 0u; } __syncthreads(); xbar = xcd_barrier_post((unsigned*)(args.ws + WS_CTL) + CW_BAR, MISCW + 8); }
#define IN(k) (lo <= (k) && (k) < hi)
#define SEAM(k) do { if (IN(k) && IN((k) + 1) && args.coop) { if ((k) == 0) cg::this_grid().sync(); else xcd_barrier(xbar); } } while (0)
    if (IN(0) && (PHM & 1)) phase_p0(args, 0, lds, lds_raw, G, bid);
    if (DBL & 1) { __syncthreads(); phase_p0(args, 0, lds, lds_raw, G, bid); }
    SEAM(0);
    if (IN(1) && (PHM & 2)) phase_a(args, 0, lds, lds_raw, G, bid);
    if (DBL & 2) { __syncthreads(); phase_a(args, 0, lds, lds_raw, G, bid); }
    SEAM(1);
    if (IN(2) && (PHM & 4)) phase_b1(args, 0, lds, lds_raw, G, bid);
    if (DBL & 4) { __syncthreads(); phase_b1(args, 0, lds, lds_raw, G, bid); }
    SEAM(2);
    if (IN(3) && (PHM & 8)) phase_b2(args, 0, lds, lds_raw, G, bid);
    SEAM(3);
    if (IN(4) && (PHM & 16)) phase_n(args, 0, lds, lds_raw, G, bid);
    SEAM(4);
    if (IN(5) && (PHM & 32)) phase_c(args, 0, lds, lds_raw, G, bid);
    if (DBL & 32) { __syncthreads(); phase_c(args, 0, lds, lds_raw, G, bid); }
    SEAM(5);
    if (IN(6)) phase_r(args, 0, lds, lds_raw, G, bid);
    SEAM(6);
    if (IN(7) && (PHM & 2)) phase_a(args, 1, lds, lds_raw, G, bid);
    SEAM(7);
    if (IN(8) && (PHM & 4)) phase_b1(args, 1, lds, lds_raw, G, bid);
    SEAM(8);
    if (IN(9) && (PHM & 8)) phase_b2(args, 1, lds, lds_raw, G, bid);
    SEAM(9);
    if (IN(10) && (PHM & 16)) phase_n(args, 1, lds, lds_raw, G, bid);
    SEAM(10);
    if (IN(11) && (PHM & 32)) phase_c(args, 1, lds, lds_raw, G, bid);
    SEAM(11);
    if (IN(12) && (PHM & 64)) phase_f(args, 0, lds, lds_raw, G, bid);
#undef IN
#undef SEAM
}

extern "C" void kernel_launch(void* const* d_in, const int* in_sizes, int n_in, void* d_out, int out_size, void* d_ws, size_t ws_size, hipStream_t stream) {
    static int grid = 0;
    if (grid == 0) {
        if (n_in != 11 || in_sizes[0] != T * DM || out_size != T * DM || ws_size < WS_END) {
            fprintf(stderr, "kernel_launch: shape mismatch (n_in %d, in0 %d, out %d, ws %zu; need ws >= %zu)\n", n_in, n_in > 0 ? in_sizes[0] : -1, out_size, ws_size, (size_t)WS_END); grid = -1; return; }
        int dev = 0, cus = 0, per_cu = 0;
        hipGetDevice(&dev); hipDeviceGetAttribute(&cus, hipDeviceAttributeMultiprocessorCount, dev);
        if (hipFuncSetAttribute((const void*)fwd_kernel, hipFuncAttributeMaxDynamicSharedMemorySize, LDS_BYTES) != hipSuccess) { fprintf(stderr, "kernel_launch: hipFuncSetAttribute failed\n"); grid = -1; return; }
        hipOccupancyMaxActiveBlocksPerMultiprocessor(&per_cu, (const void*)fwd_kernel, NTHREADS, LDS_BYTES);
        (void)hipGetLastError();
        if (per_cu < 1) { fprintf(stderr, "kernel_launch: occupancy query says %d blocks/CU\n", per_cu); per_cu = 1; }
        grid = cus * 1;
    }
    if (grid < 0) return;
    hipMemsetAsync((char*)d_ws + WS_CTL, 0, CTL_ZERO_BYTES, stream);
    Args a{};
    for (int i = 0; i < 11; ++i) a.in[i] = (const float*)d_in[i];
    a.out = (float*)d_out; a.ws = (unsigned char*)d_ws;
#ifndef ONE_LAUNCH
#define ONE_LAUNCH 1
#endif
    if (ONE_LAUNCH) {
        a.ph_lo = 0; a.ph_hi = NPHASES; a.coop = 1;
        void* kargs[] = {&a};
        hipError_t e = hipLaunchCooperativeKernel((const void*)fwd_kernel, dim3(grid), dim3(NTHREADS), kargs, LDS_BYTES, stream);
        if (e != hipSuccess) fprintf(stderr, "kernel_launch: cooperative launch failed: %s (grid %d)\n", hipGetErrorString(e), grid);
    } else {
        for (int ph = 0; ph < NPHASES; ++ph) { a.ph_lo = ph; a.ph_hi = ph + 1; a.coop = 0;
            hipLaunchKernelGGL(fwd_kernel, dim3(grid), dim3(NTHREADS), LDS_BYTES, stream, a); }
    }
}
```

```cpp
#include <hip/hip_runtime.h>
#include <hip/hip_cooperative_groups.h>
#include <cstdio>
#include <cstdint>
#include <cmath>
namespace cg = cooperative_groups;

#define LAS __attribute__((address_space(3)))
typedef unsigned short bf16_t;
typedef short bf16x8 __attribute__((ext_vector_type(8)));
typedef short s16x4 __attribute__((ext_vector_type(4)));
typedef float f32x4 __attribute__((ext_vector_type(4)));
typedef float f32x2 __attribute__((ext_vector_type(2)));
typedef float f32x16 __attribute__((ext_vector_type(16)));
typedef unsigned u32x4 __attribute__((ext_vector_type(4)));
typedef unsigned u32x2 __attribute__((ext_vector_type(2)));

constexpr int BATCH = 8, SEQ = 4096, T = BATCH * SEQ, DM = 1024, DEPTH = 2;
constexpr int D_IN = 5064, NIN = 5120, DMIX = 1536;
constexpr float EPS = 1e-6f, LOG2E = 1.4426950408889634f;
constexpr float C2_64 = 0.125f * LOG2E;
constexpr float C2_192 = 0.07216878364870323f * LOG2E;
constexpr int NWAVES = 8, NTHREADS = 512;

constexpr size_t MiB = 1u << 20;
constexpr size_t WS_CTL = 0, CTL_ZERO_BYTES = 1 * MiB;
constexpr size_t WS_SSX = 1 * MiB;
constexpr size_t WS_KAUGF = 3 * MiB;
constexpr size_t WS_KAUGM = 7 * MiB;
constexpr size_t WS_FFL = 11 * MiB;
constexpr size_t WS_RSCQ = 12 * MiB;
constexpr size_t WS_RSCKV = 12 * MiB + 256 * 1024;
constexpr size_t WS_RSX = 12 * MiB + 512 * 1024;
constexpr size_t WS_KPART = 13 * MiB;
constexpr size_t WS_BIASF = 14 * MiB;
constexpr size_t WS_SEL = 15 * MiB;
constexpr size_t WS_SSQA = 16 * MiB;
constexpr size_t WS_SSQB = 17 * MiB;
constexpr size_t WS_SSQC = 18 * MiB;
constexpr size_t WS_JSTART = 20 * MiB;
constexpr size_t WS_ROPE = 19 * MiB;
constexpr size_t WS_W = 24 * MiB, W_LAYER = 14 * MiB;
constexpr size_t W_IN_OFF = 0, W_UQ_OFF = 10 * MiB, W_UKV_OFF = 10 * MiB + 512 * 1024, W_OUT_OFF = 11 * MiB;
constexpr size_t WS_QG = 56 * MiB;
constexpr size_t WS_GATE = 152 * MiB;
constexpr size_t WS_FK = 248 * MiB, WS_FV = 280 * MiB, WS_BK = 312 * MiB, WS_BV = 344 * MiB;
constexpr size_t WS_R2 = 376 * MiB;
constexpr size_t WS_XB = WS_R2, WS_QM = WS_R2, WS_KM = WS_R2 + 48 * MiB, WS_VM = WS_R2 + 80 * MiB, WS_KR = WS_R2 + 112 * MiB;
constexpr size_t WS_END = 504 * MiB;
constexpr int CW_NRM = 8192;
#ifndef TPROBE
#define TPROBE 0
#endif
#ifndef TWAVE
#define TWAVE 0
#endif
constexpr int CW_T = 24576;
constexpr int CW_QCTR = 16384;

constexpr int RING_BYTES = 131072, MISC_OFF = RING_BYTES + 256, SIDE_OFF = RING_BYTES + 1024  , LDS_BYTES = 147456;

__device__ __forceinline__ unsigned cvt_pk_bf16(float lo, float hi) { unsigned r; asm volatile("v_cvt_pk_bf16_f32 %0, %1, %2" : "=v"(r) : "v"(lo), "v"(hi)); return r; }
__device__ __forceinline__ float bf2f(unsigned short b) { return __uint_as_float(((unsigned)b) << 16); }
__device__ __forceinline__ void store8_bf16(bf16_t* p, f32x4 a, f32x4 b) {
    u32x4 w; w.x = cvt_pk_bf16(a[0], a[1]); w.y = cvt_pk_bf16(a[2], a[3]); w.z = cvt_pk_bf16(b[0], b[1]); w.w = cvt_pk_bf16(b[2], b[3]); *(u32x4*)p = w; }
__device__ __forceinline__ void store8_bf16_nt(bf16_t* p, f32x4 a, f32x4 b) {
    u32x4 w; w.x = cvt_pk_bf16(a[0], a[1]); w.y = cvt_pk_bf16(a[2], a[3]); w.z = cvt_pk_bf16(b[0], b[1]); w.w = cvt_pk_bf16(b[2], b[3]); __builtin_nontemporal_store(w, (u32x4*)p); }
__device__ __forceinline__ float silu_f(float v) { return v * __builtin_amdgcn_rcpf(1.0f + __builtin_amdgcn_exp2f(-v * LOG2E)); }
__device__ __forceinline__ f32x4 silu4(f32x4 v) { f32x4 o; o[0] = silu_f(v[0]); o[1] = silu_f(v[1]); o[2] = silu_f(v[2]); o[3] = silu_f(v[3]); return o; }
__device__ __forceinline__ float wave_sum(float v) {
#pragma unroll
    for (int o = 1; o < 64; o <<= 1) v += __shfl_xor(v, o);
    return v;
}
__device__ __forceinline__ float log_sigmoid_fast(float x) { return -0.6931471805599453f * __builtin_amdgcn_logf(1.0f + __builtin_amdgcn_exp2f(-x * LOG2E)); }
__device__ __forceinline__ void split3_bf16(float x, unsigned& p1, unsigned& p2, unsigned& p3) {
    p1 = cvt_pk_bf16(x, 0.f) & 0xffffu; const float r1 = x - __uint_as_float(p1 << 16);
    p2 = cvt_pk_bf16(r1, 0.f) & 0xffffu; const float r2 = r1 - __uint_as_float(p2 << 16);
    p3 = cvt_pk_bf16(r2, 0.f) & 0xffffu; }
__device__ __forceinline__ u32x4 kaug_pack(float bias) { unsigned a, b, c; split3_bf16(bias, a, b, c); return (u32x4){a | (b << 16), c | (0x3F80u << 16), 0u, 0u}; }
__device__ __forceinline__ float sum4(f32x4 a) { return (a[0] + a[1]) + (a[2] + a[3]); }
__device__ __forceinline__ float dot4(f32x4 a) { return (a[0] * a[0] + a[1] * a[1]) + (a[2] * a[2] + a[3] * a[3]); }

namespace pg8 {
constexpr int BM = 256, BK = 64, HALF = 128, HTB = HALF * BK * 2, STAGE_BYTES = 8 * HTB, NXCD = 8, WGM = 8;
__host__ __device__ __forceinline__ int lds_byte(int r, int c) { const int st = (r >> 4) * 2 + (c >> 5), rr = r & 15, cc = c & 31, ob = rr * 64 + cc * 2; return st * 1024 + (ob ^ (((ob >> 9) & 1) << 5)); }
__host__ __device__ __forceinline__ void stage_rc(int b, int& R, int& C) { const int st = b / 1024, sb = b % 1024, swz = sb ^ (((sb >> 9) & 1) << 5); R = (st >> 1) * 16 + swz / 64; C = (st & 1) * 32 + (swz % 64) / 2; }
__host__ __device__ __forceinline__ int perm32(int rho) { const int n = rho >> 4, i = rho & 15; return 8 * (i >> 2) + 4 * n + (i & 3); }

struct Unit { int pm, pn; };
struct Gemm { const bf16_t* A; const bf16_t* Bt; int M, N, K, lda; };

struct StaticOrder {
    int nM, nN, nwg, G, c;
    __host__ __device__ void init(int M, int N, int G_, int c_) { nM = M / BM; nN = N / BM; nwg = nM * nN; G = G_; c = c_; }
    __host__ __device__ bool next(int i, Unit& u) const {
        const long L = (long)i * G + c; if (L >= nwg) return false;
        int wgid = (int)L; { const int q = nwg / NXCD, r = nwg % NXCD, xcd = wgid % NXCD, off = wgid / NXCD; wgid = (xcd < r ? xcd * (q + 1) : r * (q + 1) + (xcd - r) * q) + off; }
        const int nig = WGM * nN, gid = wgid / nig, fm = gid * WGM, gsz = (nM - fm) < WGM ? (nM - fm) : WGM;
        u.pm = fm + ((wgid % nig) % gsz); u.pn = (wgid % nig) / gsz; return true;
    }
};

template <class Epi, bool ALIGN_EPI, bool KSC = false>
__device__ __forceinline__ void gemm_phase(LAS unsigned char* lds, const Gemm g, const StaticOrder& S, const Epi& E, LAS float* side = nullptr) {
    int tid_ = threadIdx.x; asm volatile("" : "+v"(tid_));
    const int tid = tid_, wid = __builtin_amdgcn_readfirstlane(tid >> 6), lane = tid & 63, wr = wid >> 2, wc = wid & 3, fr = lane & 15, fq = lane >> 4;
    const int K = g.K, nt = K / BK, lda = g.lda;
    unsigned voffA[2], voffB[2];
#pragma unroll
    for (int i = 0; i < 2; ++i) { int R, C; stage_rc(tid * 16 + i * 8192, R, C); const int Rb = Epi::PERM ? ((R & ~31) + perm32(R & 31)) : R;
        voffA[i] = (unsigned)(R * lda + C) * 2u; voffB[i] = (unsigned)(Rb * K + C) * 2u; }
    const size_t kstep = (size_t)(BK * 2);
    const size_t hstepA = (size_t)HALF * lda * 2, hstepB = (size_t)HALF * K * 2;
    const size_t tstepA = 2 * hstepA, tstepB = 2 * hstepB;
    const unsigned ldsw = (unsigned)wid * 1024u;
    const int aoff = lds_byte(wr * 64 + fr, fq * 8), boff = lds_byte(wc * 32 + fr, fq * 8);
#define PG8_SA(b, h) (((b) * 2 + (h)) * HTB)
#define PG8_SB(b, h) ((4 + (b) * 2 + (h)) * HTB)
#define PG8_STAGE(bufoff, gbase, voff) do { _Pragma("unroll") for (int _i = 0; _i < 2; ++_i) \
        __builtin_amdgcn_global_load_lds((const unsigned*)((const char*)(gbase) + (voff)[_i]), (LAS unsigned*)(lds + (bufoff) + ldsw + _i * 8192), 16, 0, 0); } while (0)
#define PG8_LDA(dst, b, h) do { _Pragma("unroll") for (int m = 0; m < 4; ++m) _Pragma("unroll") for (int k = 0; k < 2; ++k) dst[m][k] = *(const LAS bf16x8*)(lds + PG8_SA(b, h) + aoff + m * 2048 + k * 1024); } while (0)
#define PG8_LDB(dst, b, h) do { _Pragma("unroll") for (int n = 0; n < 2; ++n) _Pragma("unroll") for (int k = 0; k < 2; ++k) dst[n][k] = *(const LAS bf16x8*)(lds + PG8_SB(b, h) + boff + n * 2048 + k * 1024); } while (0)
#define PG8_MMA(ai, bj, At, Bt) do { __builtin_amdgcn_s_setprio(1); _Pragma("unroll") for (int m = 0; m < 4; ++m) _Pragma("unroll") for (int n = 0; n < 2; ++n) _Pragma("unroll") for (int k = 0; k < 2; ++k) \
        acc[ai][bj][m][n] = __builtin_amdgcn_mfma_f32_16x16x32_bf16(Bt[n][k], At[m][k], acc[ai][bj][m][n], 0, 0, 0); __builtin_amdgcn_s_setprio(0); } while (0)
#define PG8_WAIT_V(n) asm volatile("s_waitcnt vmcnt(" #n ")" ::: "memory")
#define PG8_WAIT_L(n) asm volatile("s_waitcnt lgkmcnt(" #n ")" ::: "memory")
#define PG8_BAR __builtin_amdgcn_s_barrier()
#define PG8_SCHED __builtin_amdgcn_sched_barrier(0)
    Unit cur, nxt; int ui = 0;
    if (!S.next(0, cur)) return;
    f32x4 acc[2][2][4][2];
#pragma unroll
    for (int a = 0; a < 2; ++a)
#pragma unroll
        for (int b = 0; b < 2; ++b)
#pragma unroll
            for (int m = 0; m < 4; ++m)
#pragma unroll
                for (int n = 0; n < 2; ++n) acc[a][b][m][n] = (f32x4){0.f, 0.f, 0.f, 0.f};
    bf16x8 At[4][2], B0[2][2], B1[2][2];
    const char* cA = (const char*)g.A + (size_t)cur.pm * tstepA; const char* cB = (const char*)g.Bt + (size_t)cur.pn * tstepB;
    if constexpr (KSC) E.fill(cur, side, tid);
    PG8_STAGE(PG8_SB(0, 0), cB, voffB); PG8_STAGE(PG8_SB(0, 1), cB + hstepB, voffB); PG8_STAGE(PG8_SA(0, 0), cA, voffA); PG8_STAGE(PG8_SA(0, 1), cA + hstepA, voffA);
    if (wr == 1) PG8_BAR;
    PG8_WAIT_V(2); PG8_BAR;
    PG8_STAGE(PG8_SB(1, 0), cB + kstep, voffB); PG8_STAGE(PG8_SA(1, 0), cA + kstep, voffA); PG8_STAGE(PG8_SB(1, 1), cB + hstepB + kstep, voffB);
    PG8_WAIT_V(6); PG8_BAR;
    for (;;) {
        const bool has_next = S.next(ui + 1, nxt);
        const char* nA = has_next ? (const char*)g.A + (size_t)nxt.pm * tstepA : cA; const char* nB = has_next ? (const char*)g.Bt + (size_t)nxt.pn * tstepB : cB;
#pragma unroll 1
        for (int t = 0; t < nt; t += 2) {
            const bool last = (t == nt - 2);
            if constexpr (KSC) { if (t == 8 || t == 16) {
                const LAS float* sp = side + (ui & 1) * 1024 + (t == 16 ? 1 : 0);
#pragma unroll
                for (int a = 0; a < 2; ++a)
#pragma unroll
                    for (int m = 0; m < 4; ++m) { const float f = sp[(a * 128 + wr * 64 + m * 16 + fr) * 4];
#pragma unroll
                        for (int b = 0; b < 2; ++b)
#pragma unroll
                            for (int n = 0; n < 2; ++n) acc[a][b][m][n] *= f; } } }
            const char* a1 = cA + (size_t)(t + 1) * kstep;
            const char* a2 = last ? nA : cA + (size_t)(t + 2) * kstep; const char* b2 = last ? nB : cB + (size_t)(t + 2) * kstep;
            const char* a3 = a2 + kstep; const char* b3 = b2 + kstep;
            PG8_LDB(B0, 0, 0); PG8_LDB(B1, 0, 1); PG8_SCHED; PG8_LDA(At, 0, 0); PG8_STAGE(PG8_SA(1, 1), a1 + hstepA, voffA);
            PG8_WAIT_V(8); PG8_WAIT_L(0); PG8_BAR; PG8_MMA(0, 0, At, B0); PG8_MMA(0, 1, At, B1); PG8_BAR; PG8_SCHED;
            PG8_LDA(At, 0, 1); PG8_STAGE(PG8_SB(0, 0), b2, voffB); PG8_STAGE(PG8_SB(0, 1), b2 + hstepB, voffB); PG8_STAGE(PG8_SA(0, 0), a2, voffA);
            PG8_WAIT_V(8); PG8_WAIT_L(0); PG8_BAR; PG8_MMA(1, 0, At, B0); PG8_MMA(1, 1, At, B1); PG8_BAR; PG8_SCHED;
            PG8_LDB(B0, 1, 0); PG8_LDB(B1, 1, 1); PG8_SCHED; PG8_LDA(At, 1, 0); PG8_STAGE(PG8_SA(0, 1), a2 + hstepA, voffA);
            PG8_WAIT_V(8); PG8_WAIT_L(0); PG8_BAR; PG8_MMA(0, 0, At, B0); PG8_MMA(0, 1, At, B1); PG8_BAR; PG8_SCHED;
            PG8_LDA(At, 1, 1); PG8_STAGE(PG8_SB(1, 0), b3, voffB); PG8_STAGE(PG8_SB(1, 1), b3 + hstepB, voffB); PG8_STAGE(PG8_SA(1, 0), a3, voffA);
            PG8_WAIT_V(8); PG8_WAIT_L(0); PG8_BAR; PG8_MMA(1, 0, At, B0); PG8_MMA(1, 1, At, B1); PG8_BAR; PG8_SCHED;
        }
        if constexpr (ALIGN_EPI) { if (wr == 0) PG8_BAR; }
        if constexpr (KSC) { E.scaled(acc, cur, wr, wc, fr, fq, side + (ui & 1) * 1024); if (has_next) E.fill(nxt, side + ((ui + 1) & 1) * 1024, tid); }
        else E(acc, cur, wr, wc, fr, fq);
        if (!has_next) break;
#pragma unroll
        for (int a = 0; a < 2; ++a)
#pragma unroll
            for (int b = 0; b < 2; ++b)
#pragma unroll
                for (int m = 0; m < 4; ++m)
#pragma unroll
                    for (int n = 0; n < 2; ++n) acc[a][b][m][n] = (f32x4){0.f, 0.f, 0.f, 0.f};
        cur = nxt; cA = nA; cB = nB; ++ui;
        if constexpr (ALIGN_EPI) { if (wr == 1) PG8_BAR; }
    }
    PG8_WAIT_V(0);
    if constexpr (!ALIGN_EPI) { if (wr == 0) PG8_BAR; }
    PG8_BAR;
#undef PG8_SA
#undef PG8_SB
#undef PG8_STAGE
#undef PG8_LDA
#undef PG8_LDB
#undef PG8_MMA
#undef PG8_WAIT_V
#undef PG8_WAIT_L
#undef PG8_BAR
#undef PG8_SCHED
}
}

struct EpiA {
    static constexpr bool PERM = true;
    unsigned char* ws; LAS float* side; const float* bfp; unsigned* nrm;
    __device__ __forceinline__ void operator()(const f32x4 (&acc)[2][2][4][2], const pg8::Unit& u, int wr, int wc, int fr, int fq) const {
        const float* RSX = (const float*)(ws + WS_RSX);
        float rs[2][4];
#pragma unroll
        for (int ai = 0; ai < 2; ++ai)
#pragma unroll
            for (int m = 0; m < 4; ++m) rs[ai][m] = RSX[u.pm * 256 + ai * 128 + wr * 64 + m * 16 + fr];
        const int pn = u.pn, cw = wc * 32 + 8 * fq;
        bf16_t* dst; int pitch, coff, mode;
        if (pn < 2)       { dst = (bf16_t*)(ws + WS_QG);   pitch = 1536; coff = pn * 256;               mode = 1; }
        else if (pn < 4)  { dst = (bf16_t*)(ws + WS_FK);   pitch = 512;  coff = (pn - 2) * 256;         mode = 0; }
        else if (pn < 6)  { dst = (bf16_t*)(ws + WS_FV);   pitch = 512;  coff = (pn - 4) * 256;         mode = 0; }
        else if (pn < 8)  { dst = (bf16_t*)(ws + WS_GATE); pitch = 1536; coff = (pn - 6) * 256;         mode = 2; }
        else if (pn == 8) { dst = (bf16_t*)(ws + WS_QG);   pitch = 1536; coff = 512;                    mode = 0; }
        else if (pn == 9) { dst = (bf16_t*)(ws + WS_QG);   pitch = 1536; coff = 768;                    mode = 0; }
        else if (pn < 12) { dst = (bf16_t*)(ws + WS_GATE); pitch = 1536; coff = 512 + (pn - 10) * 256;  mode = 2; }
        else if (pn < 14) { dst = (bf16_t*)(ws + WS_QG);   pitch = 1536; coff = 1024 + (pn - 12) * 256; mode = 1; }
        else if (pn < 16) { dst = (bf16_t*)(ws + WS_BK);   pitch = 512;  coff = (pn - 14) * 256;        mode = 0; }
        else if (pn < 18) { dst = (bf16_t*)(ws + WS_BV);   pitch = 512;  coff = (pn - 16) * 256;        mode = 0; }
        else              { dst = (bf16_t*)(ws + WS_GATE); pitch = 1536; coff = 1024 + (pn - 18) * 256; mode = 2; }
        const float msc = (mode == 1) ? C2_64 : 1.0f;
        const bool want_nrm = pn < 4 || (pn >= 12 && pn < 16);
        float mx[2] = {0.f, 0.f};
#pragma unroll
        for (int ai = 0; ai < 2; ++ai)
#pragma unroll
            for (int m = 0; m < 4; ++m) { const int row = u.pm * 256 + ai * 128 + wr * 64 + m * 16 + fr; bf16_t* rowp = dst + (size_t)row * pitch + coff + cw; const float sc = rs[ai][m] * msc;
#pragma unroll
                for (int bj = 0; bj < 2; ++bj) { f32x4 v0 = acc[ai][bj][m][0] * sc, v1 = acc[ai][bj][m][1] * sc;
                    if (want_nrm) { float sq = dot4(v0) + dot4(v1); sq += __shfl_xor(sq, 16); sq += __shfl_xor(sq, 32); mx[bj] = fmaxf(mx[bj], sq); }
                    if (mode == 2) { v0 = silu4(v0); v1 = silu4(v1); }
                    store8_bf16_nt(rowp + bj * 128, v0, v1); } }
        if (want_nrm) { const int kind = (pn < 2) ? 0 : (pn < 4) ? 1 : (pn < 14) ? 2 : 3; const int pb = (pn < 2) ? 0 : (pn < 4) ? 2 : (pn < 14) ? 12 : 14;
#pragma unroll
            for (int bj = 0; bj < 2; ++bj) { float v = mx[bj];
#pragma unroll
                for (int o = 1; o < 16; o <<= 1) v = fmaxf(v, __shfl_xor(v, o));
                const int col = (pn - pb) * 256 + bj * 128 + wc * 32;
                if ((threadIdx.x & 63) == 0) atomicMax(nrm + ((kind * 8 + (u.pm >> 4)) * 8 + (col >> 6)) * 2 + ((col >> 5) & 1), __float_as_uint(v)); } }
        if (pn == 8 || pn == 9) {
#pragma unroll
            for (int ai = 0; ai < 2; ++ai)
#pragma unroll
                for (int m = 0; m < 4; ++m) { const int rl = ai * 128 + wr * 64 + m * 16 + fr; const float sc = rs[ai][m];
                    float s = (dot4(acc[ai][0][m][0] * sc) + dot4(acc[ai][0][m][1] * sc)) + (dot4(acc[ai][1][m][0] * sc) + dot4(acc[ai][1][m][1] * sc));
                    if (pn == 9 && (wc == 0 || wc == 3)) s = 0.f;
                    s += __shfl_xor(s, 16); s += __shfl_xor(s, 32);
                    if (fq == 0) side[rl * 4 + wc] = s; }
            asm volatile("s_waitcnt lgkmcnt(0)" ::: "memory"); __builtin_amdgcn_s_barrier(); asm volatile("" ::: "memory");
            if (threadIdx.x < 256) { const int rl = threadIdx.x; const f32x4 v = *(const LAS f32x4*)(side + rl * 4);
                float* RS = (float*)(ws + (pn == 8 ? WS_RSCQ : WS_RSCKV)); RS[u.pm * 256 + rl] = rsqrtf(sum4(v) * (pn == 8 ? 1.0f / 256.0f : 1.0f / 128.0f) + EPS); }
        }
        if (pn == 9 && wc == 0) {
            bf16_t* KR = (bf16_t*)(ws + WS_KR); const float* COS = (const float*)(ws + WS_ROPE); const float* SIN = COS + SEQ * 32;
#pragma unroll
            for (int ai = 0; ai < 2; ++ai)
#pragma unroll
                for (int m = 0; m < 4; ++m) { const int row = u.pm * 256 + ai * 128 + wr * 64 + m * 16 + fr; const float sc = rs[ai][m]; const int tpos = row & (SEQ - 1);
                    const float* cp = COS + (size_t)tpos * 32 + 8 * fq; const float* sp = SIN + (size_t)tpos * 32 + 8 * fq;
                    const f32x4 c0 = *(const f32x4*)cp, c1 = *(const f32x4*)(cp + 4), s0 = *(const f32x4*)sp, s1 = *(const f32x4*)(sp + 4);
                    const f32x4 x10 = acc[ai][0][m][0] * sc, x11 = acc[ai][0][m][1] * sc, x20 = acc[ai][1][m][0] * sc, x21 = acc[ai][1][m][1] * sc;
                    bf16_t* p = KR + (size_t)row * 64 + 8 * fq;
                    store8_bf16(p, x10 * c0 - x20 * s0, x11 * c1 - x21 * s1);
                    store8_bf16(p + 32, x20 * c0 + x10 * s0, x21 * c1 + x11 * s1);
                    if (m & 1) asm volatile("" ::: "memory"); }
        }
        if (pn == 9 && wc == 3 && fq == 0) {
            float* FFL = (float*)(ws + WS_FFL); const f32x4 b0 = *(const f32x4*)bfp, b1 = *(const f32x4*)(bfp + 4);
#pragma unroll
            for (int ai = 0; ai < 2; ++ai)
#pragma unroll
                for (int m = 0; m < 4; ++m) { const int row = u.pm * 256 + ai * 128 + wr * 64 + m * 16 + fr; const float sc = rs[ai][m];
                    const f32x4 v0 = acc[ai][0][m][0] * sc, v1 = acc[ai][0][m][1] * sc; f32x4 l0, l1;
#pragma unroll
                    for (int e = 0; e < 4; ++e) { l0[e] = log_sigmoid_fast(v0[e] + b0[e]); l1[e] = log_sigmoid_fast(v1[e] + b1[e]); }
                    float* p = FFL + (size_t)row * 8; *(f32x4*)p = l0; *(f32x4*)(p + 4) = l1; }
        }
        if (pn == 14 || pn == 15) {
            float* KP = (float*)(ws + WS_KPART) + ((size_t)(u.pm * 2 + wr)) * 512 + (pn - 14) * 256;
#pragma unroll
            for (int bj = 0; bj < 2; ++bj)
#pragma unroll
                for (int n = 0; n < 2; ++n) { f32x4 s = (f32x4){0.f, 0.f, 0.f, 0.f};
#pragma unroll
                    for (int ai = 0; ai < 2; ++ai)
#pragma unroll
                        for (int m = 0; m < 4; ++m) s += acc[ai][bj][m][n] * rs[ai][m];
#pragma unroll
                    for (int o = 1; o < 16; o <<= 1) { s[0] += __shfl_xor(s[0], o); s[1] += __shfl_xor(s[1], o); s[2] += __shfl_xor(s[2], o); s[3] += __shfl_xor(s[3], o); }
                    if (fr == 0) *(f32x4*)(KP + bj * 128 + cw + 4 * n) = s; }
        }
    }
};

struct EpiQ {
    static constexpr bool PERM = true;
    unsigned char* ws;
    __device__ __forceinline__ void operator()(const f32x4 (&acc)[2][2][4][2], const pg8::Unit& u, int wr, int wc, int fr, int fq) const {
        const float* RS = (const float*)(ws + WS_RSCQ); bf16_t* QM = (bf16_t*)(ws + WS_QM);
        const float* COS = (const float*)(ws + WS_ROPE); const float* SIN = COS + SEQ * 32;
        const int pn = u.pn, cw = wc * 32 + 8 * fq;
#pragma unroll
        for (int ai = 0; ai < 2; ++ai)
#pragma unroll
            for (int m = 0; m < 4; ++m) { const int row = u.pm * 256 + ai * 128 + wr * 64 + m * 16 + fr;
                const float sc = RS[row] * C2_192;
                if (pn < 2) {
#pragma unroll
                    for (int bj = 0; bj < 2; ++bj) { const int head = pn * 2 + bj; store8_bf16(QM + (size_t)row * 768 + head * 192 + cw, acc[ai][bj][m][0] * sc, acc[ai][bj][m][1] * sc); }
                } else {
                    const int tpos = row & (SEQ - 1); const float* cp = COS + (size_t)tpos * 32 + 8 * fq; const float* sp = SIN + (size_t)tpos * 32 + 8 * fq;
                    const f32x4 c0 = *(const f32x4*)cp, c1 = *(const f32x4*)(cp + 4), s0 = *(const f32x4*)sp, s1 = *(const f32x4*)(sp + 4);
                    const f32x4 x10 = acc[ai][0][m][0] * sc, x11 = acc[ai][0][m][1] * sc, x20 = acc[ai][1][m][0] * sc, x21 = acc[ai][1][m][1] * sc;
                    bf16_t* p = QM + (size_t)row * 768 + wc * 192 + 128 + 8 * fq;
                    store8_bf16(p, x10 * c0 - x20 * s0, x11 * c1 - x21 * s1);
                    store8_bf16(p + 32, x20 * c0 + x10 * s0, x21 * c1 + x11 * s1);
                    if (m & 1) asm volatile("" ::: "memory");
                } }
    }
};
struct EpiKV {
    static constexpr bool PERM = true;
    unsigned char* ws;
    __device__ __forceinline__ void operator()(const f32x4 (&acc)[2][2][4][2], const pg8::Unit& u, int wr, int wc, int fr, int fq) const {
        const float* RS = (const float*)(ws + WS_RSCKV);
        const int pn = u.pn, cw = wc * 32 + 8 * fq;
        bf16_t* base = (pn < 2) ? (bf16_t*)(ws + WS_KM) + pn * 256 + cw : (bf16_t*)(ws + WS_VM) + (pn - 2) * 256 + cw;
        const int pitch = 512, bjs = 128;
#pragma unroll
        for (int ai = 0; ai < 2; ++ai)
#pragma unroll
            for (int m = 0; m < 4; ++m) { const int row = u.pm * 256 + ai * 128 + wr * 64 + m * 16 + fr; const float sc = RS[row]; bf16_t* rowp = base + (size_t)row * pitch;
#pragma unroll
                for (int bj = 0; bj < 2; ++bj) store8_bf16(rowp + bj * bjs, acc[ai][bj][m][0] * sc, acc[ai][bj][m][1] * sc); }
    }
};
struct EpiC {
    static constexpr bool PERM = true;
    const float* xin; const bf16_t* xbin; bf16_t* xbout; unsigned char* ws; int last;
    __device__ __forceinline__ void fill(const pg8::Unit& u, LAS float* dst, int tid) const {
        if (tid < 256) { const size_t m = (size_t)u.pm * 256 + tid; const float* SA = (const float*)(ws + WS_SSQA); const float* SB = (const float*)(ws + WS_SSQB); const float* SC = (const float*)(ws + WS_SSQC);
            const f32x4 a0 = *(const f32x4*)(SA + m * 8), a1 = *(const f32x4*)(SA + m * 8 + 4), b0 = *(const f32x4*)(SB + m * 4), c0 = *(const f32x4*)(SC + m * 8), c1 = *(const f32x4*)(SC + m * 8 + 4);
            const float ra = rsqrtf((sum4(a0) + sum4(a1)) * (1.0f / 512.0f) + EPS), rb = rsqrtf(sum4(b0) * (1.0f / 512.0f) + EPS), rc = rsqrtf((sum4(c0) + sum4(c1)) * (1.0f / 512.0f) + EPS);
            *(LAS f32x4*)(dst + tid * 4) = (f32x4){ra / rb, rb / rc, rc, 0.f}; }
    }
    __device__ __forceinline__ void scaled(const f32x4 (&acc)[2][2][4][2], const pg8::Unit& u, int wr, int wc, int fr, int fq, const LAS float* tab) const {
        float* SSX = (float*)(ws + WS_SSX);
#pragma unroll
        for (int ai = 0; ai < 2; ++ai)
#pragma unroll
            for (int m = 0; m < 4; ++m) { const int rl = ai * 128 + wr * 64 + m * 16 + fr; const int row = u.pm * 256 + rl; const float rc = tab[rl * 4 + 2];
                const size_t off = (size_t)row * DM + u.pn * 256 + wc * 32 + 8 * fq; float ss = 0.f;
#pragma unroll
                for (int bj = 0; bj < 2; ++bj) { const size_t o = off + bj * 128; f32x4 r0, r1;
                    if (xin) { r0 = *(const f32x4*)(xin + o); r1 = *(const f32x4*)(xin + o + 4); }
                    else { const u32x4 w = *(const u32x4*)(xbin + o); r0[0] = __uint_as_float(w.x << 16); r0[1] = __uint_as_float(w.x & 0xffff0000u); r0[2] = __uint_as_float(w.y << 16); r0[3] = __uint_as_float(w.y & 0xffff0000u);
                        r1[0] = __uint_as_float(w.z << 16); r1[1] = __uint_as_float(w.z & 0xffff0000u); r1[2] = __uint_as_float(w.w << 16); r1[3] = __uint_as_float(w.w & 0xffff0000u); }
                    const f32x4 v0 = acc[ai][bj][m][0] * rc + r0, v1 = acc[ai][bj][m][1] * rc + r1; ss += dot4(v0) + dot4(v1);
                    store8_bf16(xbout + o, v0, v1); }
                if (!last) { ss += __shfl_xor(ss, 16); ss += __shfl_xor(ss, 32); if (fq == 0) SSX[(size_t)row * 16 + u.pn * 4 + wc] = ss; } }
    }
    __device__ __forceinline__ void operator()(const f32x4 (&acc)[2][2][4][2], const pg8::Unit& u, int wr, int wc, int fr, int fq) const {}
};

#define SBAR() __builtin_amdgcn_sched_barrier(0)
__device__ __forceinline__ int crow(int r, int hi) { return (r & 3) + 8 * (r >> 2) + 4 * hi; }
template <int OFF> __device__ __forceinline__ s16x4 tr_read(int vb) { s16x4 r; asm volatile("ds_read_b64_tr_b16 %0, %1 offset:%2" : "=&v"(r) : "v"(vb), "i"(OFF) : "memory"); return r; }
__device__ __forceinline__ int v_rd_base(int lane) { return ((lane & 3) << 3) | (((lane >> 2) & 3) << 6) | (((lane >> 4) & 1) << 5) | (((lane >> 5) & 1) << 8); }
template <int NCB> __device__ __forceinline__ int v_st(int k, int c) { const int kk = (k & ~0xC) | ((k & 4) << 1) | ((k & 8) >> 1); return ((kk >> 3) * NCB + (c >> 5)) * 512 + ((kk & 7) * 32 + (c & 31)) * 2; }
template <int NCB, int D0> __device__ __forceinline__ void pv_one(f32x16& od, int vb, bf16x8 pa0, bf16x8 pa1, bf16x8 pa2, bf16x8 pa3) {
#define VOFF(ks, half) (((2 * (ks) + (half)) * NCB + D0) * 512)
    const s16x4 l0 = tr_read<VOFF(0, 0)>(vb), h0 = tr_read<VOFF(0, 1)>(vb), l1 = tr_read<VOFF(1, 0)>(vb), h1 = tr_read<VOFF(1, 1)>(vb);
    const s16x4 l2 = tr_read<VOFF(2, 0)>(vb), h2 = tr_read<VOFF(2, 1)>(vb), l3 = tr_read<VOFF(3, 0)>(vb), h3 = tr_read<VOFF(3, 1)>(vb);
#undef VOFF
    asm volatile("s_waitcnt lgkmcnt(0)" ::: "memory"); SBAR();
#define PK(L, H) (bf16x8){L[0], L[1], L[2], L[3], H[0], H[1], H[2], H[3]}
    od = __builtin_amdgcn_mfma_f32_32x32x16_bf16(pa0, PK(l0, h0), od, 0, 0, 0);
    od = __builtin_amdgcn_mfma_f32_32x32x16_bf16(pa1, PK(l1, h1), od, 0, 0, 0);
    od = __builtin_amdgcn_mfma_f32_32x32x16_bf16(pa2, PK(l2, h2), od, 0, 0, 0);
    od = __builtin_amdgcn_mfma_f32_32x32x16_bf16(pa3, PK(l3, h3), od, 0, 0, 0);
#undef PK
}
template <int OFF> __device__ __forceinline__ bf16x8 k_read(unsigned a) { bf16x8 r; asm volatile("ds_read_b128 %0, %1 offset:%2" : "=v"(r) : "v"(a), "i"(OFF) : "memory"); return r; }
template <int N> __device__ __forceinline__ void lgkm_wait(bf16x8& x) { asm volatile("s_waitcnt lgkmcnt(%1)" : "+v"(x) : "i"(N) : "memory"); }
template <int N> __device__ __forceinline__ void lgkm_wait2(s16x4& x, s16x4& y) { asm volatile("s_waitcnt lgkmcnt(%2)" : "+v"(x), "+v"(y) : "i"(N) : "memory"); }
template <int I, int ND0, int KRB, bool AUG, int R>
__device__ __forceinline__ void qk_chain(f32x16& p0, f32x16& p1, bf16x8& f0, bf16x8& f1, bf16x8& f2, bf16x8& f3, const bf16x8 (&qr)[ND0], const bf16x8& qaug, const unsigned ka, const unsigned kaa) {
    constexpr int NF = 2 * ND0 + (AUG ? 2 : 0);
    if constexpr (I < NF) {
        bf16x8& cur = (I % R == 0) ? f0 : (I % R == 1) ? f1 : (I % R == 2) ? f2 : f3;
        lgkm_wait<((NF - 1 - I) < (R - 1) ? (NF - 1 - I) : (R - 1))>(cur);
        if constexpr (I < 2 * ND0) { if constexpr (I & 1) p1 = __builtin_amdgcn_mfma_f32_32x32x16_bf16(cur, qr[I >> 1], p1, 0, 0, 0); else p0 = __builtin_amdgcn_mfma_f32_32x32x16_bf16(cur, qr[I >> 1], p0, 0, 0, 0); }
        else { if constexpr (I & 1) p1 = __builtin_amdgcn_mfma_f32_32x32x16_bf16(cur, qaug, p1, 0, 0, 0); else p0 = __builtin_amdgcn_mfma_f32_32x32x16_bf16(cur, qaug, p0, 0, 0, 0); }
        SBAR();
        constexpr int J = I + R;
        if constexpr (J < NF) { if constexpr (J < 2 * ND0) cur = k_read<(J & 1) * 32 * KRB + (J >> 1) * 32>(ka); else cur = k_read<(J & 1) * 32 * KRB>(kaa); }
        qk_chain<I + 1, ND0, KRB, AUG, R>(p0, p1, f0, f1, f2, f3, qr, qaug, ka, kaa);
    }
}
template <int ND0, int KRB, bool AUG>
__device__ __forceinline__ void qk_all(f32x16& p0, f32x16& p1, const bf16x8 (&qr)[ND0], const bf16x8& qaug, const unsigned ka, const unsigned kaa) {
    constexpr int R = (ND0 > 4) ? 3 : 4;
    bf16x8 f0 = k_read<0>(ka), f1 = k_read<32 * KRB>(ka), f2 = k_read<32>(ka), f3;
    if constexpr (R == 4) f3 = k_read<32 * KRB + 32>(ka);
    qk_chain<0, ND0, KRB, AUG, R>(p0, p1, f0, f1, f2, f3, qr, qaug, ka, kaa);
}
template <int S, int NCB>
__device__ __forceinline__ void pv_chain(f32x16 (&o)[NCB], const int vb, const bf16x8& pa0, const bf16x8& pa1, const bf16x8& pa2, const bf16x8& pa3,
                                         s16x4& l0, s16x4& h0, s16x4& l1, s16x4& h1, s16x4& l2, s16x4& h2, s16x4& l3, s16x4& h3) {
    constexpr int NE = 4 * NCB;
    if constexpr (S < NE) {
        constexpr int k = S & 3, n = S >> 2;
        s16x4& L = (k == 0) ? l0 : (k == 1) ? l1 : (k == 2) ? l2 : l3; s16x4& H = (k == 0) ? h0 : (k == 1) ? h1 : (k == 2) ? h2 : h3;
        const bf16x8& pa = (k == 0) ? pa0 : (k == 1) ? pa1 : (k == 2) ? pa2 : pa3;
        lgkm_wait2<2 * ((NE - 1 - S) < 3 ? (NE - 1 - S) : 3)>(L, H);
        o[n] = __builtin_amdgcn_mfma_f32_32x32x16_bf16(pa, (bf16x8){L[0], L[1], L[2], L[3], H[0], H[1], H[2], H[3]}, o[n], 0, 0, 0);
        SBAR();
        if constexpr (S + 4 < NE) { constexpr int n2 = (S + 4) >> 2; L = tr_read<((2 * k + 0) * NCB + n2) * 512>(vb); H = tr_read<((2 * k + 1) * NCB + n2) * 512>(vb); }
        pv_chain<S + 1, NCB>(o, vb, pa0, pa1, pa2, pa3, l0, h0, l1, h1, l2, h2, l3, h3);
    }
}
template <int NCB>
__device__ __forceinline__ void pv_all(f32x16 (&o)[NCB], const int vb, const bf16x8& pa0, const bf16x8& pa1, const bf16x8& pa2, const bf16x8& pa3) {
    s16x4 l0 = tr_read<(0 * NCB) * 512>(vb), h0 = tr_read<(1 * NCB) * 512>(vb), l1 = tr_read<(2 * NCB) * 512>(vb), h1 = tr_read<(3 * NCB) * 512>(vb);
    s16x4 l2 = tr_read<(4 * NCB) * 512>(vb), h2 = tr_read<(5 * NCB) * 512>(vb), l3 = tr_read<(6 * NCB) * 512>(vb), h3 = tr_read<(7 * NCB) * 512>(vb);
    pv_chain<0, NCB>(o, vb, pa0, pa1, pa2, pa3, l0, h0, l1, h1, l2, h2, l3, h3);
}
template <int V> struct ic_t { static constexpr int value = V; };
template <int I, int N, class F> __device__ __forceinline__ void static_for(F&& f) { if constexpr (I < N) { f(ic_t<I>{}); static_for<I + 1, N>(f); } }
template <int S, int NCB, class F>
__device__ __forceinline__ void pv_chain_f(f32x16 (&o)[NCB], const int vb, const bf16x8& pa0, const bf16x8& pa1, const bf16x8& pa2, const bf16x8& pa3,
                                           s16x4& l0, s16x4& h0, s16x4& l1, s16x4& h1, s16x4& l2, s16x4& h2, F&& fill) {
    constexpr int NE = 4 * NCB, KF = 16 / NE, R = 3;
    if constexpr (S < NE) {
        constexpr int k = S & 3, n = S >> 2, sl = S % R;
        s16x4& L = (sl == 0) ? l0 : (sl == 1) ? l1 : l2; s16x4& H = (sl == 0) ? h0 : (sl == 1) ? h1 : h2;
        const bf16x8& pa = (k == 0) ? pa0 : (k == 1) ? pa1 : (k == 2) ? pa2 : pa3;
        lgkm_wait2<2 * ((NE - 1 - S) < (R - 1) ? (NE - 1 - S) : (R - 1))>(L, H);
        o[n] = __builtin_amdgcn_mfma_f32_32x32x16_bf16(pa, (bf16x8){L[0], L[1], L[2], L[3], H[0], H[1], H[2], H[3]}, o[n], 0, 0, 0);
        SBAR();
        if constexpr (S + R < NE) { constexpr int k2 = (S + R) & 3, n2 = (S + R) >> 2; L = tr_read<((2 * k2 + 0) * NCB + n2) * 512>(vb); H = tr_read<((2 * k2 + 1) * NCB + n2) * 512>(vb); }
        static_for<S * KF, S * KF + KF>(fill);
        SBAR();
        pv_chain_f<S + 1, NCB>(o, vb, pa0, pa1, pa2, pa3, l0, h0, l1, h1, l2, h2, fill);
    }
}
template <int NCB, class F>
__device__ __forceinline__ void pv_all_f(f32x16 (&o)[NCB], const int vb, const bf16x8& pa0, const bf16x8& pa1, const bf16x8& pa2, const bf16x8& pa3, F&& fill) {
    s16x4 l0 = tr_read<(0 * NCB) * 512>(vb), h0 = tr_read<(1 * NCB) * 512>(vb), l1 = tr_read<(2 * NCB) * 512>(vb), h1 = tr_read<(3 * NCB) * 512>(vb);
    s16x4 l2 = tr_read<(4 * NCB) * 512>(vb), h2 = tr_read<(5 * NCB) * 512>(vb);
    pv_chain_f<0, NCB>(o, vb, pa0, pa1, pa2, pa3, l0, h0, l1, h1, l2, h2, fill);
}
struct AttnP {
    const bf16_t* Q; int ldq;
    const bf16_t* K; int ldk;
    const bf16_t* K2;
    const bf16_t* V; int ldv;
    bf16_t* O; int ldo;
    const bf16_t* G; int ldg;
    float* SSQ; int nh;
    const float* bias;
    const unsigned* sel;
    const float* nrm;
    const unsigned char* jstart;
    const bf16_t* kaug;
    void* tctl = nullptr;
};
template <int DK, int DV, int MODE>
__device__ __forceinline__ void attn_unit(const AttnP& P, int b, int h, int qb, char* lds) {
    constexpr int NKL = DK / 64, NVL = DV / 64, NCB = DV / 32, ND0 = DK / 16, KRB = DK * 2 + 16  , KB = 64 * KRB, VB = 64 * DV * 2;
    constexpr float THR = 8.0f;
    int tid_ = threadIdx.x; asm volatile("" : "+v"(tid_));
    const int tid = tid_, lane = tid & 63, r32 = lane & 31, hi = lane >> 5; const int wid = __builtin_amdgcn_readfirstlane(tid >> 6);
    char* Kl = lds; char* Vl = lds + 3 * KB; float* wsf = (float*)(lds + 3 * KB + 3 * VB) + wid * 64;
    const int q0 = qb * 256; const size_t row0 = (size_t)b * SEQ;
    const int qrow = q0 + wid * 32 + r32;
    const int qlast = q0 + wid * 32 + 31;
    bf16x8 qr[ND0];
    { const bf16_t* Qw = P.Q + (row0 + qrow) * P.ldq + h * DK + hi * 8;
#pragma unroll
      for (int d0 = 0; d0 < ND0; ++d0) qr[d0] = *(const bf16x8*)(Qw + d0 * 16); }
    const int sr = tid >> 3, sc = (tid & 7) * 8;
    const unsigned kofs = (unsigned)((sr * P.ldk + h * (DK > 128 ? 128 : DK) + sc) * 2), k2ofs = (unsigned)((sr * 64 + sc) * 2), vofs = (unsigned)((sr * P.ldv + h * DV + sc) * 2);
    const char* const Kg0 = (const char*)(P.K + row0 * P.ldk); const char* const Kg20 = (DK > 128) ? (const char*)(P.K2 + row0 * 64) : nullptr; const char* const Vg0 = (const char*)(P.V + row0 * P.ldv);
    const int vb0 = (int)(uintptr_t)Vl + v_rd_base(lane);
    const int NT = 4 * (qb + 1);
    int jskip = 0;
    unsigned selw = 0u; float alpha_b = 0.f;
    if (MODE == 2) { selw = P.sel[(row0 + qrow) * 8 + h]; alpha_b = LOG2E * __builtin_amdgcn_exp2f(-(float)(h + 1));
        const float* nq = P.nrm + (((2 * 8 + b) * 8 + h) * 2); const float* nk = P.nrm + (((3 * 8 + b) * 8 + h) * 2);
        const float smax = 1.02f * sqrtf((nq[0] + nq[1]) * (nk[0] + nk[1]));
        const float dist = (40.0f + 2.0f * smax) / alpha_b;
        const float jf = ((float)(q0 - 63) - dist) * (1.0f / 64.0f);
        int js = (jf < 0.f) ? 0 : (int)jf + 1; if (js > 4 * qb) js = 4 * qb; jskip = __builtin_amdgcn_readfirstlane(js); }
    if (MODE == 0) { jskip = __builtin_amdgcn_readfirstlane((int)P.jstart[(b * 8 + h) * 16 + qb]); }
    const bf16_t* kaugp = (MODE == 0) ? P.kaug + (size_t)(b * 8 + h) * SEQ * 8 : (MODE == 2) ? P.kaug + (size_t)h * SEQ * 8 : nullptr;
    u32x4 qa = (u32x4){0u, 0u, 0u, 0u}; if (MODE != 1 && hi == 0) { qa.x = 0x3F803F80u; qa.y = 0x00003F80u; }
    const int NS = NT - jskip;
#define JOF(s_) ((MODE == 2) ? (((s_) < 4) ? 3 - (s_) : NT + 3 - (s_)) : (MODE == 0) ? NT - 1 - (s_) : (s_) + jskip)
#define KEY0(j) ((MODE == 2) ? (((j) < 4) ? q0 + 64 * (j) : 64 * ((j) - 4)) : 64 * (j))
    bf16x8 ks[NKL], vs[NVL], ksa = bf16x8{};
#define SLOAD(k0) do { if (MODE != 1 && tid < 64) ksa = *(const bf16x8*)(kaugp + (size_t)((k0) + tid) * 8); \
 _Pragma("unroll") for (int i_ = 0; i_ < NKL; ++i_) ks[i_] = (i_ < 2) ? *(const bf16x8*)(Kg0 + (size_t)(k0) * P.ldk * 2 + kofs + 128 * i_) : *(const bf16x8*)(Kg20 + (size_t)(k0) * 128 + k2ofs); \
                       _Pragma("unroll") for (int i_ = 0; i_ < NVL; ++i_) vs[i_] = *(const bf16x8*)(Vg0 + (size_t)(k0) * P.ldv * 2 + vofs + 128 * i_); } while (0)
#define SWRITE(bsel) do { if (MODE != 1 && tid < 64) *(bf16x8*)(Kl + (bsel) * KB + tid * KRB + DK * 2) = ksa; \
                          _Pragma("unroll") for (int i_ = 0; i_ < NKL; ++i_) *(bf16x8*)(Kl + (bsel) * KB + sr * KRB + (sc + 64 * i_) * 2) = ks[i_]; \
                          _Pragma("unroll") for (int i_ = 0; i_ < NVL; ++i_) *(bf16x8*)(Vl + (bsel) * VB + v_st<NCB>(sr, sc + 64 * i_)) = vs[i_]; } while (0)
    float l_reg = 0.f; bool first_row = true;
    float negm = 0.f; f32x16 o[NCB];
#pragma unroll
    for (int d = 0; d < NCB; ++d) o[d] = f32x16{};
    const bool late = wid >= 4; bool pend = false; int bprev = 0;
    bf16x8 pa0, pa1, pa2, pa3;
#define PVALL(bsel_) do { const int vb_ = vb0 + (bsel_) * VB; __builtin_amdgcn_s_setprio(1); pv_all_f<NCB>(o, vb_, pa0, pa1, pa2, pa3, [](auto) {}); __builtin_amdgcn_s_setprio(0); } while (0)
    unsigned long long tp_sec = 0ull, tp_a = 0ull, tp_b = 0ull; const unsigned long long tp_u0 = (MODE == 1 && TPROBE) ? __builtin_readcyclecounter() : 0ull;
#define TPA() do { if (MODE == 1 && TPROBE) tp_a = __builtin_readcyclecounter(); } while (0)
#define TPB(k_) do { if (MODE == 1 && TPROBE) { tp_b = __builtin_readcyclecounter(); if (TPROBE == (k_)) tp_sec += tp_b - tp_a; tp_a = tp_b; } } while (0)
    SLOAD(KEY0(JOF(0))); SWRITE(0);
    int bsel = 0;
    const unsigned long long tp_l0 = (MODE == 1 && TPROBE) ? __builtin_readcyclecounter() : 0ull;
    for (int st = 0; st < NS; ++st) { const int j = JOF(st);
        TPA();
        __syncthreads();
        TPB(1);
        const int key0 = KEY0(j);
        if (st + 1 < NS) SLOAD(KEY0(JOF(st + 1)));
        TPB(2);
        bool active = true;
        if (MODE == 2 && j >= 4) { active = __any((int)((selw >> ((j - 4) >> 2)) & 1u)); }
        else { active = key0 <= qlast; }
        if (active) {
            f32x16 p0, p1;
#pragma unroll
            for (int r = 0; r < 16; ++r) { p0[r] = negm; p1[r] = negm; }
            const char* Kb = Kl + bsel * KB;
            __builtin_amdgcn_s_setprio(1);
            if (MODE == 2 && hi == 0) qa.y = (j < 4 || ((selw >> ((j - 4) >> 2)) & 1u)) ? 0x00003F80u : 0xC3803F80u;
            { const unsigned ka = (unsigned)(uintptr_t)(Kb + r32 * KRB + hi * 16), kaa = (unsigned)(uintptr_t)(Kb + r32 * KRB + DK * 2);
              qk_all<ND0, KRB, MODE != 1>(p0, p1, qr, __builtin_bit_cast(bf16x8, qa), ka, kaa); }
            __builtin_amdgcn_s_setprio(0);
            TPB(3);
            if (key0 + 63 > q0 + wid * 32 && (MODE != 2 || j < 4)) { const int kb = key0 + 4 * hi;
#pragma unroll
                for (int r = 0; r < 16; ++r) { const int kv = kb + (r & 3) + 8 * (r >> 2); if (kv > qrow) p0[r] = -INFINITY; if (kv + 32 > qrow) p1[r] = -INFINITY; } }
            float pmax = p0[0];
#pragma unroll
            for (int r = 1; r < 16; ++r) pmax = fmaxf(pmax, p0[r]);
#pragma unroll
            for (int r = 0; r < 16; ++r) pmax = fmaxf(pmax, p1[r]);
            { auto rr = __builtin_amdgcn_permlane32_swap(__float_as_uint(pmax), __float_as_uint(pmax), false, false); pmax = fmaxf(__uint_as_float(rr[0]), __uint_as_float(rr[1])); }
            const bool need = first_row ? (pmax > -INFINITY) : (pmax > THR);
            if (__any(need)) {
                if (pend) { PVALL(bprev); pend = false; }
                const float d = first_row ? (need ? pmax : 0.f) : fmaxf(pmax, 0.f);
                const float al = first_row ? 1.f : __builtin_amdgcn_exp2f(-d);
                first_row = first_row && !need;
                negm -= d; l_reg *= al;
#pragma unroll
                for (int r = 0; r < 16; ++r) { p0[r] -= d; p1[r] -= d; }
                if (hi == 0) wsf[r32] = al; asm volatile("s_waitcnt lgkmcnt(0)" ::: "memory");
#pragma unroll
                for (int r = 0; r < 16; ++r) { const float a = wsf[crow(r, hi)];
#pragma unroll
                    for (int d_ = 0; d_ < NCB; ++d_) o[d_][r] *= a; }
            }
            float ps0 = 0.f, ps1 = 0.f; unsigned pk[16]; bf16x8 pn0, pn1, pn2, pn3;
            auto chunk = [&](auto mc) { constexpr int m = decltype(mc)::value, G = m >> 2, q = m & 3, B = (G & 1) * 8 + 2 * q;
                const float e0 = __builtin_amdgcn_exp2f((G < 2) ? p0[B] : p1[B]), e1 = __builtin_amdgcn_exp2f((G < 2) ? p0[B + 1] : p1[B + 1]);
                ps0 += e0; ps1 += e1; pk[m] = cvt_pk_bf16(e0, e1);
                if constexpr (q == 3) { auto r0 = __builtin_amdgcn_permlane32_swap(pk[4 * G], pk[4 * G + 2], false, false); auto r1 = __builtin_amdgcn_permlane32_swap(pk[4 * G + 1], pk[4 * G + 3], false, false);
                    u32x4 w = {r0[0], r1[0], r0[1], r1[1]}; bf16x8& dst = (G == 0) ? pn0 : (G == 1) ? pn1 : (G == 2) ? pn2 : pn3; dst = __builtin_bit_cast(bf16x8, w); } };
            if (pend) { PVALL(bprev); } static_for<0, 16>(chunk);
            pa0 = pn0; pa1 = pn1; pa2 = pn2; pa3 = pn3; pend = true; bprev = bsel;
            float ps = ps0 + ps1;
            { auto rr = __builtin_amdgcn_permlane32_swap(__float_as_uint(ps), __float_as_uint(ps), false, false); ps = __uint_as_float(rr[0]) + __uint_as_float(rr[1]); }
            l_reg += ps;
            TPB(4);
        } else if (pend) { PVALL(bprev); pend = false; }
        const int bnext = (bsel == 2) ? 0 : bsel + 1;
        if (st + 1 < NS) SWRITE(bnext);
        TPB(6);
        bsel = bnext;
    }
    const unsigned long long tp_l1 = (MODE == 1 && TPROBE) ? __builtin_readcyclecounter() : 0ull;
    if (pend) PVALL(bprev);
#undef PVALL
    if (hi == 0) wsf[32 + r32] = l_reg; asm volatile("s_waitcnt lgkmcnt(0)" ::: "memory");
    const size_t orow0 = row0 + q0 + wid * 32;
    __syncthreads();
    bf16_t* stg = (bf16_t*)lds + wid * (32 * DV);
#pragma unroll
    for (int r = 0; r < 16; ++r) { const int orow = crow(r, hi); const float rl = __builtin_amdgcn_rcpf(wsf[32 + orow]); float ss = 0.f;
#pragma unroll
        for (int d = 0; d < NCB; ++d) { const float y = o[d][r] * rl; ss += y * y; stg[orow * DV + d * 32 + r32] = (bf16_t)(cvt_pk_bf16(y, 0.f) & 0xffffu); }
#pragma unroll
        for (int sh = 1; sh < 32; sh <<= 1) ss += __shfl_xor(ss, sh);
        if (r32 == 0) P.SSQ[(orow0 + orow) * P.nh + h] = ss; }
    asm volatile("s_waitcnt lgkmcnt(0)" ::: "memory");
    { constexpr int CPR = DV / 8, NIT = 32 * CPR / 64;
#pragma unroll
      for (int it = 0; it < NIT; ++it) { const int ci = it * 64 + lane, row = ci / CPR, ch = ci % CPR;
          const u32x4 yv = *(const u32x4*)(stg + row * DV + ch * 8);
          const u32x4 gv = *(const u32x4*)(P.G + (orow0 + row) * P.ldg + h * DV + ch * 8); u32x4 ov;
#pragma unroll
          for (int e = 0; e < 4; ++e) ov[e] = cvt_pk_bf16(__uint_as_float(yv[e] << 16) * __uint_as_float(gv[e] << 16), __uint_as_float(yv[e] & 0xffff0000u) * __uint_as_float(gv[e] & 0xffff0000u));
          *(u32x4*)(P.O + (orow0 + row) * P.ldo + h * DV + ch * 8) = ov; } }
    __syncthreads();
    if (MODE == 1 && TPROBE) { const unsigned long long tp_u1 = __builtin_readcyclecounter();
        if (tid == TWAVE * 64) { unsigned long long* tc = (unsigned long long*)P.tctl;
            if (TPROBE == 7) tp_sec = (tp_u1 - tp_u0) - (tp_l1 - tp_l0);
            const unsigned long long tot = (TPROBE == 7) ? (tp_u1 - tp_u0) : (tp_l1 - tp_l0);
            __hip_atomic_fetch_add(tc + 0, tp_sec, __ATOMIC_RELAXED, __HIP_MEMORY_SCOPE_AGENT); __hip_atomic_fetch_add(tc + 1, tot, __ATOMIC_RELAXED, __HIP_MEMORY_SCOPE_AGENT);
            __hip_atomic_fetch_add(tc + 2, (unsigned long long)NS, __ATOMIC_RELAXED, __HIP_MEMORY_SCOPE_AGENT); } }
#undef TPA
#undef TPB
#undef KEY0
#undef JOF
#undef SLOAD
#undef SWRITE
}


#define XB_TMO      128
#define XB_XCNT(j)  (256  + 64 * (j))
#define XB_XSUB(j)  (1280 + 64 * (j))
#define XB_XGEN(j)  (2304 + 64 * (j))
#define XB_TOP      3328
#define XB_TOPGEN   3392
#define XCD_BAR_WORDS 3456
#define XB_SPIN_CAP (1u << 18)
__device__ __forceinline__ unsigned xb_ld(unsigned* p)              { return __hip_atomic_load(p, __ATOMIC_RELAXED, __HIP_MEMORY_SCOPE_AGENT); }
__device__ __forceinline__ unsigned xb_add(unsigned* p, unsigned v) { return __hip_atomic_fetch_add(p, v, __ATOMIC_RELAXED, __HIP_MEMORY_SCOPE_AGENT); }
__device__ __forceinline__ unsigned xb_xcc_id() { return (unsigned)__builtin_amdgcn_s_getreg((3 << 11) | 20) & 0xFu; }
#define XB_SPIN(cond, bar) do { unsigned _sp = 0; while (cond) { __builtin_amdgcn_s_sleep(1); \
    if ((++_sp & 255u) == 0u) { if (xb_ld(&(bar)[XB_TMO])) break; if (_sp > XB_SPIN_CAP) { atomicAdd(&(bar)[XB_TMO], 1u); break; } } } } while (0)
struct XcdBarrier { unsigned* bar; unsigned x; volatile LAS unsigned* st; };
__device__ __forceinline__ XcdBarrier xcd_barrier_post(unsigned* bar, volatile LAS unsigned* st) {
    XcdBarrier b; b.bar = bar; b.x = xb_xcc_id(); b.st = st;
    if (threadIdx.x == 0) (void)xb_add(&bar[XB_XCNT(b.x)], 1u);
    return b;
}
__device__ __forceinline__ void xcd_barrier_complete(unsigned* bar, unsigned x, unsigned& nloc, unsigned& nx) {
    const unsigned G = gridDim.x * gridDim.y * gridDim.z;
    unsigned sum, cnt, mine, sp = 0u;
    for (;;) {
        sum = 0u; cnt = 0u; mine = 0u;
#pragma unroll
        for (unsigned j = 0; j < 16; ++j) { const unsigned c = xb_ld(&bar[XB_XCNT(j)]); sum += c; cnt += (c > 0u) ? 1u : 0u; mine = (j == x) ? c : mine; }
        if (sum == G) break;
        __builtin_amdgcn_s_sleep(1);
        if ((++sp & 255u) == 0u) { if (xb_ld(&bar[XB_TMO])) break; if (sp > XB_SPIN_CAP) { atomicAdd(&bar[XB_TMO], 1u); break; } }
    }
    nloc = mine > 0u ? mine : 1u; nx = cnt > 0u ? cnt : 1u;
}
__device__ __forceinline__ void xcd_barrier(const XcdBarrier& b) {
    asm volatile("s_waitcnt vmcnt(0)" ::: "memory");
    __syncthreads();
    if (threadIdx.x == 0) {
        unsigned* bar = b.bar;
        __builtin_amdgcn_s_waitcnt(0);
        unsigned nloc = b.st[0], nx = b.st[1];
        if (nloc == 0u) { xcd_barrier_complete(bar, b.x, nloc, nx); b.st[0] = nloc; b.st[1] = nx; }
        const unsigned old = xb_add(&bar[XB_XSUB(b.x)], 1u);
        const unsigned gen = old / nloc;
        if (old + 1u == (gen + 1u) * nloc) {
            __builtin_amdgcn_fence(__ATOMIC_RELEASE, "agent");
            asm volatile("s_waitcnt vmcnt(0)" ::: "memory");
            const unsigned og = xb_add(&bar[XB_TOP], 1u);
            const unsigned tg = og / nx;
            if (og + 1u == (tg + 1u) * nx) xb_add(&bar[XB_TOPGEN], 1u);
            else XB_SPIN(xb_ld(&bar[XB_TOPGEN]) == tg, bar);
            __builtin_amdgcn_fence(__ATOMIC_ACQUIRE, "agent");
            xb_add(&bar[XB_XGEN(b.x)], 1u);
            asm volatile("s_waitcnt vmcnt(0)" ::: "memory");
        } else {
            XB_SPIN(xb_ld(&bar[XB_XGEN(b.x)]) == gen, bar);
            __builtin_amdgcn_fence(__ATOMIC_ACQUIRE, "agent");
            asm volatile("s_waitcnt vmcnt(0)" ::: "memory");
        }
    }
    __syncthreads();
}
constexpr int CW_BAR = 4096;

struct UTab { unsigned short v[320]; };
constexpr UTab make_utab() {
    UTab t{}; int k = 0;
    for (int c = 80; c >= 1; --c) {
        if (c % 5 == 0 && c / 5 <= 16) { const int qb = c / 5 - 1; for (int h = 0; h < 4; ++h) t.v[k++] = (unsigned short)((1 << 12) | (h << 4) | qb); }
        if (c % 2 == 0 && c / 2 <= 16) { const int qb = c / 2 - 1; for (int ty = 0; ty <= 2; ty += 2) for (int h = 0; h < 8; ++h) t.v[k++] = (unsigned short)((ty << 12) | (h << 4) | qb); }
    }
    return t;
}
__device__ const UTab g_utab = make_utab();
constexpr int N_UNITS_PER_BATCH = 320;

struct Args { const float* in[11]; float* out; unsigned char* ws; int ph_lo, ph_hi, coop, pad; };
#ifndef PHM
#define PHM 127
#endif
#ifndef B1M
#define B1M 31
#endif
#ifndef DBL
#define DBL 0
#endif
constexpr int NPHASES = 13;

__device__ __forceinline__ int src_in(int n) {
    const int t = n >> 8, j = n & 255;
    if (t < 6) return n;
    if (t < 8) return 1544 + (n - 1536);
    if (t == 8) return 2056 + j;
    if (t == 9) {
        if (j < 32) return 2440 + j; if (j < 96) return 2312 + (j - 32); if (j < 104) return 1536 + (j - 96); if (j < 128) return -1;
        if (j < 160) return 2440 + 32 + (j - 128); if (j < 224) return 2312 + 64 + (j - 160); return -1; }
    if (t < 12) return 2504 + (n - 2560);
    return 3016 + (n - 3072);
}
__device__ __forceinline__ int src_uq(int n) {
    if (n < 512) return (n >> 7) * 192 + (n & 127);
    const int p = n - 512; return p < 128 ? (p >> 5) * 192 + 128 + (p & 31) : ((p - 128) >> 5) * 192 + 160 + ((p - 128) & 31);
}
__device__ __forceinline__ int src_ukv(int n) {
    return n < 512 ? (n >> 7) * 256 + (n & 127) : ((n - 512) >> 7) * 256 + 128 + ((n - 512) & 127);
}
__device__ __forceinline__ void transpose_item(const float* W, int Ksrc, int Nsrc, const float* gain, bf16_t* WT, int Kdst, int mat, LAS float* scr, int kb, int nb, int lane) {
    const int k0 = 64 * kb, n0 = 32 * nb; const int nn = n0 + (lane & 31);
    const int sc = (mat == 0) ? src_in(nn) : (mat == 1) ? src_uq(nn) : (mat == 2) ? src_ukv(nn) : nn;
    float vv[32];
#pragma unroll
    for (int i = 0; i < 32; ++i) { const int kk = 2 * i + (lane >> 5); const int k = k0 + kk;
        int ks = k; if (mat == 2) ks = (k >= 32 && k < 96) ? k - 32 : (k >= 160 && k < 224) ? k - 96 : -1;
        const bool ok = sc >= 0 && ks >= 0 && ks < Ksrc; const int kc = ok ? ks : 0; const int cc = sc >= 0 ? sc : 0;
        const float w = W[(size_t)kc * Nsrc + cc] * gain[kc]; vv[i] = ok ? w : 0.f; }
#pragma unroll
    for (int i = 0; i < 32; ++i) { const int kk = 2 * i + (lane >> 5); scr[kk * 33 + (lane & 31)] = vv[i]; }
    asm volatile("s_waitcnt lgkmcnt(0)" ::: "memory");
    const int c = lane & 7;
#pragma unroll
    for (int j = 0; j < 4; ++j) { const int n = (lane >> 3) + 8 * j; const LAS float* s = scr + (8 * c) * 33 + n;
        u32x4 o; o.x = cvt_pk_bf16(s[0 * 33], s[1 * 33]); o.y = cvt_pk_bf16(s[2 * 33], s[3 * 33]); o.z = cvt_pk_bf16(s[4 * 33], s[5 * 33]); o.w = cvt_pk_bf16(s[6 * 33], s[7 * 33]);
        *(u32x4*)(WT + (size_t)(n0 + n) * Kdst + k0 + 8 * c) = o; }
    asm volatile("s_waitcnt lgkmcnt(0)" ::: "memory");
}

__device__ __forceinline__ float log_sigmoid_f(float x) { return fminf(x, 0.f) - log1pf(expf(-fabsf(x))); }

__device__ __forceinline__ void phase_p0(const Args& args, const int layer, LAS unsigned char* lds, unsigned char* lds_raw, const int G, const int bid) {
    unsigned char* ws = args.ws; asm volatile("" : "+s"(ws));
    int tid = threadIdx.x; asm volatile("" : "+v"(tid));
    const int lane = tid & 63, wave = __builtin_amdgcn_readfirstlane(tid >> 6);
    const int gw = bid * NWAVES + wave, NGW = G * NWAVES;
    unsigned char* wl = ws + WS_W + (size_t)layer * W_LAYER;
    (void)lane; (void)gw; (void)NGW; (void)wl; (void)lds_raw;
            LAS float* scr = (LAS float*)(lds + wave * 16384);
            constexpr int I_IN = 16 * 160, I_UQ = 4 * 24, I_UKV = 4 * 32, I_OUT = 24 * 32, I_L = I_IN + I_UQ + I_UKV + I_OUT;
            for (int it = gw; it < 2 * I_L; it += NGW) {
                const int l = it / I_L; int r = it % I_L; unsigned char* w = ws + WS_W + (size_t)l * W_LAYER;
                if (r < I_IN) { transpose_item(args.in[2] + (size_t)l * DM * D_IN, DM, D_IN, args.in[1] + l * DM, (bf16_t*)(w + W_IN_OFF), DM, 0, scr, r / 160, r % 160, lane); continue; } r -= I_IN;
                if (r < I_UQ) { transpose_item(args.in[5] + (size_t)l * 256 * 768, 256, 768, args.in[4] + l * 256, (bf16_t*)(w + W_UQ_OFF), 256, 1, scr, r / 24, r % 24, lane); continue; } r -= I_UQ;
                if (r < I_UKV) { transpose_item(args.in[7] + (size_t)l * 128 * 1024, 128, 1024, args.in[6] + l * 128, (bf16_t*)(w + W_UKV_OFF), 256, 2, scr, r / 32, r % 32, lane); continue; } r -= I_UKV;
                transpose_item(args.in[9] + (size_t)l * DMIX * DM, DMIX, DM, args.in[8] + l * DMIX, (bf16_t*)(w + W_OUT_OFF), DMIX, 3, scr, r / 32, r % 32, lane);
            }
            { const float* x = args.in[0]; bf16_t* XB = (bf16_t*)(ws + WS_XB); float* RSX = (float*)(ws + WS_RSX);
              for (int m = gw; m < T; m += NGW) { const f32x4* xr = (const f32x4*)(x + (size_t)m * DM) + 2 * lane; f32x4 v[4]; float s = 0.f;
#pragma unroll
                  for (int j = 0; j < 2; ++j) { v[2 * j] = xr[128 * j]; v[2 * j + 1] = xr[128 * j + 1]; s += dot4(v[2 * j]) + dot4(v[2 * j + 1]); }
                  s = wave_sum(s);
#pragma unroll
                  for (int j = 0; j < 2; ++j) store8_bf16(XB + (size_t)m * DM + 512 * j + 8 * lane, v[2 * j], v[2 * j + 1]);
                  if (lane == 0) RSX[m] = rsqrtf(s * (1.0f / 1024.0f) + EPS); } }
            { u32x4* KA = (u32x4*)(ws + WS_KAUGM);
              for (int i = bid * NTHREADS + tid; i < 8 * SEQ; i += G * NTHREADS) { const int hh = i >> 12, kp = i & (SEQ - 1);
                  KA[i] = kaug_pack(LOG2E * __builtin_amdgcn_exp2f(-(float)(hh + 1)) * (float)kp); } }
            { float* COS = (float*)(ws + WS_ROPE); float* SIN = COS + SEQ * 32;
              for (int i = bid * NTHREADS + tid; i < SEQ * 32; i += G * NTHREADS) { const int t = i >> 5, f = i & 31;
                  const float inv = powf(10000.0f, -(float)(2 * f) / 64.0f); const float ang = (float)t * inv;
                  COS[i] = (float)cos((double)ang); SIN[i] = (float)sin((double)ang); } }
}

__device__ __forceinline__ void phase_a(const Args& args, const int layer, LAS unsigned char* lds, unsigned char* lds_raw, const int G, const int bid) {
    unsigned char* ws = args.ws; asm volatile("" : "+s"(ws));
    int tid = threadIdx.x; asm volatile("" : "+v"(tid));
    const int lane = tid & 63, wave = __builtin_amdgcn_readfirstlane(tid >> 6);
    const int gw = bid * NWAVES + wave, NGW = G * NWAVES;
    unsigned char* wl = ws + WS_W + (size_t)layer * W_LAYER;
    (void)lane; (void)gw; (void)NGW; (void)wl; (void)lds_raw;
            pg8::Gemm g{layer == 0 ? (const bf16_t*)(ws + WS_XB) : (const bf16_t*)args.out, (const bf16_t*)(wl + W_IN_OFF), T, NIN, DM, DM}; pg8::StaticOrder S; S.init(T, NIN, G, bid);
            EpiA E{ws, (LAS float*)(lds + SIDE_OFF), args.in[3] + layer * 8, (unsigned*)(ws + WS_CTL) + CW_NRM + layer * 512};
            pg8::gemm_phase<EpiA, true>(lds, g, S, E);
}

__device__ __forceinline__ void phase_b1(const Args& args, const int layer, LAS unsigned char* lds, unsigned char* lds_raw, const int G, const int bid) {
    unsigned char* ws = args.ws; asm volatile("" : "+s"(ws));
    int tid = threadIdx.x; asm volatile("" : "+v"(tid));
    const int lane = tid & 63, wave = __builtin_amdgcn_readfirstlane(tid >> 6);
    const int gw = bid * NWAVES + wave, NGW = G * NWAVES;
    unsigned char* wl = ws + WS_W + (size_t)layer * W_LAYER;
    (void)lane; (void)gw; (void)NGW; (void)wl; (void)lds_raw;
            if (B1M & 1) { pg8::Gemm g{(const bf16_t*)(ws + WS_QG) + 512, (const bf16_t*)(wl + W_UQ_OFF), T, 768, 256, 1536}; pg8::StaticOrder S; S.init(T, 768, G, bid);
              EpiQ E{ws}; pg8::gemm_phase<EpiQ, true>(lds, g, S, E); }
            if (B1M & 2) { pg8::Gemm g{(const bf16_t*)(ws + WS_QG) + 768, (const bf16_t*)(wl + W_UKV_OFF), T, 1024, 256, 1536}; pg8::StaticOrder S; S.init(T, 1024, G, bid);
              EpiKV E{ws}; pg8::gemm_phase<EpiKV, true>(lds, g, S, E); }
            if (B1M & 8) { const float* FFL = (const float*)(ws + WS_FFL); LAS float* xs = (LAS float*)lds;
              for (int b = (G >= 2 * BATCH) ? bid - (G - BATCH) : bid; b >= 0 && b < BATCH; b += G) {
                  const float* src = FFL + ((size_t)b * SEQ + tid * 8) * 8; float v[8][8];
#pragma unroll
                  for (int i = 0; i < 8; ++i) { const f32x4 a = *(const f32x4*)(src + i * 8), c = *(const f32x4*)(src + i * 8 + 4);
#pragma unroll
                      for (int e = 0; e < 4; ++e) { v[i][e] = a[e]; v[i][4 + e] = c[e]; } }
#pragma unroll
                  for (int i = 1; i < 8; ++i)
#pragma unroll
                      for (int h = 0; h < 8; ++h) v[i][h] += v[i - 1][h];
                  float off[8];
#pragma unroll
                  for (int h = 0; h < 8; ++h) { const float tot = v[7][h]; float incl = tot;
#pragma unroll
                      for (int o = 1; o < 64; o <<= 1) { const float n = __shfl_up(incl, o); if (lane >= o) incl += n; }
                      off[h] = incl - tot; if (lane == 63) xs[wave * 8 + h] = incl; }
                  __syncthreads();
#pragma unroll
                  for (int h = 0; h < 8; ++h) { float wo = 0.f; for (int w = 0; w < wave; ++w) wo += xs[w * 8 + h]; off[h] += wo; }
#pragma unroll
                  for (int h = 0; h < 8; ++h) { u32x4* dst = (u32x4*)(ws + WS_KAUGF) + (size_t)(b * 8 + h) * SEQ + tid * 8; f32x4 o0, o1;
#pragma unroll
                      for (int e = 0; e < 4; ++e) { o0[e] = -LOG2E * (v[e][h] + off[h]); o1[e] = -LOG2E * (v[4 + e][h] + off[h]); }
#pragma unroll
                      for (int e = 0; e < 4; ++e) { dst[e] = kaug_pack(o0[e]); dst[4 + e] = kaug_pack(o1[e]); }
                      if ((tid & 7) == 7) xs[64 + h * 64 + (tid >> 3)] = o1[3];
                      if ((tid & 31) == 0) xs[64 + 512 + h * 16 + (tid >> 5)] = o0[0]; }
                  __syncthreads();
                  if (tid < 128) { const int h = tid >> 4, qb = tid & 15; const float* nq = (const float*)(ws + WS_CTL) + CW_NRM + layer * 512 + ((0 * 8 + b) * 8 + h) * 2; const float* nk = nq + 8 * 8 * 2;
                      const float smax = 1.02f * sqrtf((nq[0] + nq[1]) * (nk[0] + nk[1])); const float thr = -(40.0f + 2.0f * smax); const float bq0 = xs[64 + 512 + h * 16 + qb];
                      int j = 4 * qb - 1; while (j >= 0 && xs[64 + h * 64 + j] - bq0 > thr) --j;
                      ((unsigned char*)(ws + WS_JSTART))[(b * 8 + h) * 16 + qb] = (unsigned char)(j + 1); }
                  __syncthreads(); } }
            if (B1M & 16) { const float* KP = (const float*)(ws + WS_KPART); const bf16_t* QG = (const bf16_t*)(ws + WS_QG); unsigned* SEL = (unsigned*)(ws + WS_SEL);
              LAS float* km = (LAS float*)lds;
              const bool bal = (G == 256); const int njn = bal ? 4 : (512 + G - 1) / G;
              for (int jn = 0; jn < njn; ++jn) { int job = -1;
                  if (bal) { if (bid >= 128) { const int i = bid - 128; if (jn == 0 || i < 120) job = i + 128 * jn; } else if (bid < 24 && jn == 0) job = 120 + (bid & 7) + 128 * (1 + (bid >> 3)); }
                  else { job = bid + jn * G; if (job >= 512) job = -1; }
                  if (job < 0) continue;
                  const int b = job >> 6, h = (job >> 3) & 7, tb = job & 7;
                  __syncthreads();
                  for (int i = tid; i < 1024; i += NTHREADS) { const int n = i >> 6, d = i & 63; const float* p = KP + ((size_t)((b * 16 + n) * 2)) * 512 + h * 64 + d; km[i] = (p[0] + p[512]) * (1.0f / 256.0f); }
                  __syncthreads();
                  const int t = tb * 512 + tid; const int cur = t >> 8; const size_t row = (size_t)b * SEQ + t;
                  float q[64];
                  { const bf16x8* qp = (const bf16x8*)(QG + row * 1536 + 1024 + h * 64);
#pragma unroll
                    for (int c = 0; c < 8; ++c) { const bf16x8 v = qp[c];
#pragma unroll
                        for (int e = 0; e < 8; ++e) q[c * 8 + e] = bf2f((unsigned short)v[e]); } }
                  float g1 = -INFINITY, g2 = -INFINITY, g3 = -INFINITY; int i1 = -1, i2 = -1, i3 = -1;
                  for (int n = 0; n < cur; ++n) { float gsum = 0.f;
#pragma unroll
                      for (int d = 0; d < 64; ++d) gsum = __builtin_fmaf(q[d], km[n * 64 + d], gsum);
                      if (gsum > g1) { g3 = g2; i3 = i2; g2 = g1; i2 = i1; g1 = gsum; i1 = n; }
                      else if (gsum > g2) { g3 = g2; i3 = i2; g2 = gsum; i2 = n; }
                      else if (gsum > g3) { g3 = gsum; i3 = n; } }
                  unsigned m = 0u; if (i1 >= 0) m |= 1u << i1; if (i2 >= 0) m |= 1u << i2; if (i3 >= 0) m |= 1u << i3;
                  SEL[row * 8 + h] = m; }
              __syncthreads(); }
}

__device__ __forceinline__ void phase_b2(const Args& args, const int layer, LAS unsigned char* lds, unsigned char* lds_raw, const int G, const int bid) {
    unsigned char* ws = args.ws; asm volatile("" : "+s"(ws));
    int tid = threadIdx.x; asm volatile("" : "+v"(tid));
    const int lane = tid & 63, wave = __builtin_amdgcn_readfirstlane(tid >> 6);
    const int gw = bid * NWAVES + wave, NGW = G * NWAVES;
    unsigned char* wl = ws + WS_W + (size_t)layer * W_LAYER;
    (void)lane; (void)gw; (void)NGW; (void)wl; (void)lds_raw;
    volatile LAS unsigned* MISC = (volatile LAS unsigned*)(lds + MISC_OFF); unsigned* ctl = (unsigned*)(ws + WS_CTL);
            unsigned* qbase = ctl + CW_QCTR + layer * 8 * 64;
            const int x0 = (int)(xb_xcc_id() & 7u); int qx = 0;
            for (;;) {
                unsigned k = 0u;
                for (;;) {
                    if (tid == 0) MISC[0] = __hip_atomic_fetch_add(qbase + ((x0 + qx) & 7) * 64, 1u, __ATOMIC_RELAXED, __HIP_MEMORY_SCOPE_AGENT);
                    __syncthreads();
                    k = MISC[0];
                    __syncthreads();
                    if (k < (unsigned)N_UNITS_PER_BATCH || ++qx >= 8) break;
                }
                if (qx >= 8) break;
                const int b = (x0 + qx) & 7;
                const unsigned e = g_utab.v[k]; const int ty = e >> 12, h = (e >> 4) & 7, qb = e & 15;
                if (ty == 0) { const AttnP PF{(const bf16_t*)(ws + WS_QG), 1536, (const bf16_t*)(ws + WS_FK), 512, nullptr, (const bf16_t*)(ws + WS_FV), 512, (bf16_t*)(ws + WS_QG), 1536,
                                   (const bf16_t*)(ws + WS_GATE), 1536, (float*)(ws + WS_SSQA), 8, nullptr, nullptr, nullptr, (const unsigned char*)(ws + WS_JSTART), (const bf16_t*)(ws + WS_KAUGF)};
                    attn_unit<64, 64, 0>(PF, b, h, qb, (char*)lds_raw); }
                else if (ty == 1) { const AttnP PM{(const bf16_t*)(ws + WS_QM), 768, (const bf16_t*)(ws + WS_KM), 512, (const bf16_t*)(ws + WS_KR), (const bf16_t*)(ws + WS_VM), 512, (bf16_t*)(ws + WS_QG) + 512, 1536,
                                   (const bf16_t*)(ws + WS_GATE) + 512, 1536, (float*)(ws + WS_SSQB), 4, nullptr, nullptr, nullptr, nullptr, nullptr, (void*)(ctl + CW_T)};
                    attn_unit<192, 128, 1>(PM, b, h, qb, (char*)lds_raw); }
                else { const AttnP PB{(const bf16_t*)(ws + WS_QG) + 1024, 1536, (const bf16_t*)(ws + WS_BK), 512, nullptr, (const bf16_t*)(ws + WS_BV), 512, (bf16_t*)(ws + WS_QG) + 1024, 1536,
                                   (const bf16_t*)(ws + WS_GATE) + 1024, 1536, (float*)(ws + WS_SSQC), 8, nullptr, (const unsigned*)(ws + WS_SEL), (const float*)(ws + WS_CTL) + CW_NRM + layer * 512, nullptr, (const bf16_t*)(ws + WS_KAUGM)};
                    attn_unit<64, 64, 2>(PB, b, h, qb, (char*)lds_raw); }
            }
}

__device__ __forceinline__ void phase_n(const Args& args, const int layer, LAS unsigned char* lds, unsigned char* lds_raw, const int G, const int bid) {
    unsigned char* ws = args.ws; asm volatile("" : "+s"(ws));
    int tid = threadIdx.x; asm volatile("" : "+v"(tid));
    const int lane = tid & 63, wave = __builtin_amdgcn_readfirstlane(tid >> 6);
    const int gw = bid * NWAVES + wave, NGW = G * NWAVES;
    unsigned char* wl = ws + WS_W + (size_t)layer * W_LAYER;
    (void)lane; (void)gw; (void)NGW; (void)wl; (void)lds_raw;
            bf16_t* Y = (bf16_t*)(ws + WS_QG); const float* SA = (const float*)(ws + WS_SSQA); const float* SB = (const float*)(ws + WS_SSQB); const float* SC = (const float*)(ws + WS_SSQC);
            for (int m = gw; m < T; m += NGW) {
                const f32x4 a0 = *(const f32x4*)(SA + (size_t)m * 8), a1 = *(const f32x4*)(SA + (size_t)m * 8 + 4), b0 = *(const f32x4*)(SB + (size_t)m * 4);
                const f32x4 c0 = *(const f32x4*)(SC + (size_t)m * 8), c1 = *(const f32x4*)(SC + (size_t)m * 8 + 4);
                const float ra = rsqrtf((sum4(a0) + sum4(a1)) * (1.0f / 512.0f) + EPS), rb = rsqrtf(sum4(b0) * (1.0f / 512.0f) + EPS), rc = rsqrtf((sum4(c0) + sum4(c1)) * (1.0f / 512.0f) + EPS);
                u32x4* yp = (u32x4*)(Y + (size_t)m * 1536);
#pragma unroll
                for (int j = 0; j < 3; ++j) { const float r = (j == 0) ? ra : (j == 1) ? rb : rc; u32x4 v = yp[64 * j + lane]; u32x4 o;
#pragma unroll
                    for (int e = 0; e < 4; ++e) { const unsigned w = v[e]; o[e] = cvt_pk_bf16(__uint_as_float(w << 16) * r, __uint_as_float(w & 0xffff0000u) * r); }
                    yp[64 * j + lane] = o; }
            }
}

__device__ __forceinline__ void phase_c(const Args& args, const int layer, LAS unsigned char* lds, unsigned char* lds_raw, const int G, const int bid) {
    unsigned char* ws = args.ws; asm volatile("" : "+s"(ws));
    int tid = threadIdx.x; asm volatile("" : "+v"(tid));
    const int lane = tid & 63, wave = __builtin_amdgcn_readfirstlane(tid >> 6);
    const int gw = bid * NWAVES + wave, NGW = G * NWAVES;
    unsigned char* wl = ws + WS_W + (size_t)layer * W_LAYER;
    (void)lane; (void)gw; (void)NGW; (void)wl; (void)lds_raw;
            pg8::Gemm g{(const bf16_t*)(ws + WS_QG), (const bf16_t*)(wl + W_OUT_OFF), T, DM, DMIX, DMIX}; pg8::StaticOrder S; S.init(T, DM, G, bid);
            EpiC E{layer == 0 ? args.in[0] : (const float*)nullptr, (const bf16_t*)args.out, layer == 0 ? (bf16_t*)args.out : (bf16_t*)(ws + WS_FK), ws, layer == DEPTH - 1 ? 1 : 0};
            pg8::gemm_phase<EpiC, true, true>(lds, g, S, E, (LAS float*)(lds + SIDE_OFF));
}

__device__ __forceinline__ void phase_r(const Args& args, const int layer, LAS unsigned char* lds, unsigned char* lds_raw, const int G, const int bid) {
    unsigned char* ws = args.ws; asm volatile("" : "+s"(ws));
    int tid = threadIdx.x; asm volatile("" : "+v"(tid));
    const int lane = tid & 63, wave = __builtin_amdgcn_readfirstlane(tid >> 6);
    const int gw = bid * NWAVES + wave, NGW = G * NWAVES;
    unsigned char* wl = ws + WS_W + (size_t)layer * W_LAYER;
    (void)lane; (void)gw; (void)NGW; (void)wl; (void)lds_raw;
            const float* SSX = (const float*)(ws + WS_SSX); float* RSX = (float*)(ws + WS_RSX);
            for (int m = bid * NTHREADS + tid; m < T; m += G * NTHREADS) { const f32x4* p = (const f32x4*)(SSX + (size_t)m * 16);
                const float sm = (sum4(p[0]) + sum4(p[1])) + (sum4(p[2]) + sum4(p[3])); RSX[m] = rsqrtf(sm * (1.0f / 1024.0f) + EPS); }
}

__device__ __forceinline__ void phase_f(const Args& args, const int layer, LAS unsigned char* lds, unsigned char* lds_raw, const int G, const int bid) {
    unsigned char* ws = args.ws; asm volatile("" : "+s"(ws));
    int tid = threadIdx.x; asm volatile("" : "+v"(tid));
    const int lane = tid & 63, wave = __builtin_amdgcn_readfirstlane(tid >> 6);
    const int gw = bid * NWAVES + wave, NGW = G * NWAVES;
    unsigned char* wl = ws + WS_W + (size_t)layer * W_LAYER;
    (void)lane; (void)gw; (void)NGW; (void)wl; (void)lds_raw;
            float* X = args.out; const float* gf = args.in[10]; const bf16_t* XB = (const bf16_t*)(ws + WS_FK);
            for (int m = gw; m < T; m += NGW) { const u32x4* xr = (const u32x4*)(XB + (size_t)m * DM) + lane; float v[16]; float s = 0.f;
#pragma unroll
                for (int j = 0; j < 2; ++j) { const u32x4 w = xr[64 * j];
#pragma unroll
                    for (int e = 0; e < 4; ++e) { v[j * 8 + 2 * e] = __uint_as_float(w[e] << 16); v[j * 8 + 2 * e + 1] = __uint_as_float(w[e] & 0xffff0000u); } }
#pragma unroll
                for (int e = 0; e < 16; ++e) s += v[e] * v[e];
                const float r = rsqrtf(wave_sum(s) * (1.0f / 1024.0f) + EPS);
#pragma unroll
                for (int j = 0; j < 2; ++j) { const int c0 = (64 * j + lane) * 8; const f32x4 g0 = *(const f32x4*)(gf + c0), g1 = *(const f32x4*)(gf + c0 + 4);
                    f32x4 o0, o1;
#pragma unroll
                    for (int e = 0; e < 4; ++e) { o0[e] = v[j * 8 + e] * r * g0[e]; o1[e] = v[j * 8 + 4 + e] * r * g1[e]; }
                    float* op = X + (size_t)m * DM + c0; *(f32x4*)op = o0; *(f32x4*)(op + 4) = o1; } }
}

__global__ void __launch_bounds__(NTHREADS, 2) fwd_kernel(Args args) {
    extern __shared__ __attribute__((aligned(16))) unsigned char lds_raw[];
    LAS unsigned char* lds = (LAS unsigned char*)lds_raw;
    const int G = gridDim.x, bid = blockIdx.x;
    const int lo = args.ph_lo, hi = args.ph_hi;
    volatile LAS unsigned* MISCW = (volatile LAS unsigned*)(lds + MISC_OFF);
    if (args.pad == 0x5eed) cg::this_grid().sync();
    XcdBarrier xbar; xbar.bar = (unsigned*)(args.ws + WS_CTL) + CW_BAR; xbar.x = 0; xbar.st = MISCW + 8;
    if (args.coop) { if (threadIdx.x == 0) { MISCW[8] = 0u; MISCW[9] = 0u; } __syncthreads(); xbar = xcd_barrier_post((unsigned*)(args.ws + WS_CTL) + CW_BAR, MISCW + 8); }
#define IN(k) (lo <= (k) && (k) < hi)
#define SEAM(k) do { if (IN(k) && args.coop) xcd_barrier(xbar); } while (0)
    if (IN(0) && (PHM & 1)) phase_p0(args, 0, lds, lds_raw, G, bid);
    if (DBL & 1) { __syncthreads(); phase_p0(args, 0, lds, lds_raw, G, bid); }
    SEAM(0);
    if (IN(1) && (PHM & 2)) phase_a(args, 0, lds, lds_raw, G, bid);
    if (DBL & 2) { __syncthreads(); phase_a(args, 0, lds, lds_raw, G, bid); }
    SEAM(1);
    if (IN(2) && (PHM & 4)) phase_b1(args, 0, lds, lds_raw, G, bid);
    if (DBL & 4) { __syncthreads(); phase_b1(args, 0, lds, lds_raw, G, bid); }
    SEAM(2);
    if (IN(3) && (PHM & 8)) phase_b2(args, 0, lds, lds_raw, G, bid);
    SEAM(3);
    if (IN(5) && (PHM & 32)) phase_c(args, 0, lds, lds_raw, G, bid);
    if (DBL & 32) { __syncthreads(); phase_c(args, 0, lds, lds_raw, G, bid); }
    SEAM(5);
    if (IN(6)) phase_r(args, 0, lds, lds_raw, G, bid);
    SEAM(6);
    if (IN(7) && (PHM & 2)) phase_a(args, 1, lds, lds_raw, G, bid);
    SEAM(7);
    if (IN(8) && (PHM & 4)) phase_b1(args, 1, lds, lds_raw, G, bid);
    SEAM(8);
    if (IN(9) && (PHM & 8)) phase_b2(args, 1, lds, lds_raw, G, bid);
    SEAM(9);
    if (IN(11) && (PHM & 32)) phase_c(args, 1, lds, lds_raw, G, bid);
    SEAM(11);
    if (IN(12) && (PHM & 64)) phase_f(args, 0, lds, lds_raw, G, bid);
    if (TPROBE && bid == 0 && threadIdx.x == 0) {
        unsigned long long* tc = (unsigned long long*)((unsigned*)(args.ws + WS_CTL) + CW_T);
        const float t0 = (float)__hip_atomic_load(tc + 0, __ATOMIC_RELAXED, __HIP_MEMORY_SCOPE_AGENT), t1 = (float)__hip_atomic_load(tc + 1, __ATOMIC_RELAXED, __HIP_MEMORY_SCOPE_AGENT), t2 = (float)__hip_atomic_load(tc + 2, __ATOMIC_RELAXED, __HIP_MEMORY_SCOPE_AGENT);
        const float us = (TPROBE == 8) ? t1 / (t2 * 16.0f) : 1000.0f * t0 / t1;
        const unsigned long long w0 = __builtin_amdgcn_s_memrealtime(), dw = (unsigned long long)(us * 100.0f);
        while (__builtin_amdgcn_s_memrealtime() - w0 < dw) { __builtin_amdgcn_s_sleep(8); } }
#undef IN
#undef SEAM
}

extern "C" void kernel_launch(void* const* d_in, const int* in_sizes, int n_in, void* d_out, int out_size, void* d_ws, size_t ws_size, hipStream_t stream) {
    static int grid = 0;
    if (grid == 0) {
        if (n_in != 11 || in_sizes[0] != T * DM || out_size != T * DM || ws_size < WS_END) {
            fprintf(stderr, "kernel_launch: shape mismatch (n_in %d, in0 %d, out %d, ws %zu; need ws >= %zu)\n", n_in, n_in > 0 ? in_sizes[0] : -1, out_size, ws_size, (size_t)WS_END); grid = -1; return; }
        int dev = 0, cus = 0, per_cu = 0;
        hipGetDevice(&dev); hipDeviceGetAttribute(&cus, hipDeviceAttributeMultiprocessorCount, dev);
        if (hipFuncSetAttribute((const void*)fwd_kernel, hipFuncAttributeMaxDynamicSharedMemorySize, LDS_BYTES) != hipSuccess) { fprintf(stderr, "kernel_launch: hipFuncSetAttribute failed\n"); grid = -1; return; }
        hipOccupancyMaxActiveBlocksPerMultiprocessor(&per_cu, (const void*)fwd_kernel, NTHREADS, LDS_BYTES);
        (void)hipGetLastError();
        if (per_cu < 1) { fprintf(stderr, "kernel_launch: occupancy query says %d blocks/CU\n", per_cu); per_cu = 1; }
        grid = cus * 1;
    }
    if (grid < 0) return;
    hipMemsetAsync((char*)d_ws + WS_CTL, 0, CTL_ZERO_BYTES, stream);
    Args a{};
    for (int i = 0; i < 11; ++i) a.in[i] = (const float*)d_in[i];
    a.out = (float*)d_out; a.ws = (unsigned char*)d_ws;
#ifndef ONE_LAUNCH
#define ONE_LAUNCH 1
#endif
    if (ONE_LAUNCH) {
        a.ph_lo = 0; a.ph_hi = NPHASES; a.coop = 1;
        void* kargs[] = {&a};
        hipError_t e = hipLaunchCooperativeKernel((const void*)fwd_kernel, dim3(grid), dim3(NTHREADS), kargs, LDS_BYTES, stream);
        if (e != hipSuccess) fprintf(stderr, "kernel_launch: cooperative launch failed: %s (grid %d)\n", hipGetErrorString(e), grid);
    } else {
        for (int ph = 0; ph < NPHASES; ++ph) { a.ph_lo = ph; a.ph_hi = ph + 1; a.coop = 0;
            hipLaunchKernelGGL(fwd_kernel, dim3(grid), dim3(NTHREADS), LDS_BYTES, stream, a); }
    }
}
```

```cpp
#include <hip/hip_runtime.h>
#include <hip/hip_cooperative_groups.h>
#include <cstdio>
#include <cstdint>
#include <cmath>
namespace cg = cooperative_groups;

#define LAS __attribute__((address_space(3)))
typedef unsigned short bf16_t;
typedef short bf16x8 __attribute__((ext_vector_type(8)));
typedef short s16x4 __attribute__((ext_vector_type(4)));
typedef float f32x4 __attribute__((ext_vector_type(4)));
typedef float f32x2 __attribute__((ext_vector_type(2)));
typedef float f32x16 __attribute__((ext_vector_type(16)));
typedef unsigned u32x4 __attribute__((ext_vector_type(4)));
typedef unsigned u32x2 __attribute__((ext_vector_type(2)));

constexpr int BATCH = 8, SEQ = 4096, T = BATCH * SEQ, DM = 1024, DEPTH = 2;
constexpr int D_IN = 5064, NIN = 5120, DMIX = 1536;
constexpr float EPS = 1e-6f, LOG2E = 1.4426950408889634f;
constexpr float C2_64 = 0.125f * LOG2E;
constexpr float C2_192 = 0.07216878364870323f * LOG2E;
constexpr int NWAVES = 8, NTHREADS = 512;

constexpr size_t MiB = 1u << 20;
constexpr size_t WS_CTL = 0, CTL_ZERO_BYTES = 1 * MiB;
constexpr size_t WS_SSX = 1 * MiB;
constexpr size_t WS_KAUGF = 3 * MiB;
constexpr size_t WS_KAUGM = 7 * MiB;
constexpr size_t WS_FFL = 11 * MiB;
constexpr size_t WS_RSCQ = 12 * MiB;
constexpr size_t WS_RSCKV = 12 * MiB + 256 * 1024;
constexpr size_t WS_RSX = 12 * MiB + 512 * 1024;
constexpr size_t WS_KPART = 13 * MiB;
constexpr size_t WS_BIASF = 14 * MiB;
constexpr size_t WS_SEL = 15 * MiB;
constexpr size_t WS_SSQA = 16 * MiB;
constexpr size_t WS_SSQB = 17 * MiB;
constexpr size_t WS_SSQC = 18 * MiB;
constexpr size_t WS_JSTART = 20 * MiB;
constexpr size_t WS_ROPE = 19 * MiB;
constexpr size_t WS_W = 24 * MiB, W_LAYER = 14 * MiB;
constexpr size_t W_IN_OFF = 0, W_UQ_OFF = 10 * MiB, W_UKV_OFF = 10 * MiB + 512 * 1024, W_OUT_OFF = 11 * MiB;
constexpr size_t WS_QG = 56 * MiB;
constexpr size_t WS_GATE = 152 * MiB;
constexpr size_t WS_FK = 248 * MiB, WS_FV = 280 * MiB, WS_BK = 312 * MiB, WS_BV = 344 * MiB;
constexpr size_t WS_R2 = 376 * MiB;
constexpr size_t WS_XB = WS_R2, WS_QM = WS_R2, WS_KM = WS_R2 + 48 * MiB, WS_VM = WS_R2 + 80 * MiB, WS_KR = WS_R2 + 112 * MiB;
constexpr size_t WS_END = 504 * MiB;
constexpr int CW_NRM = 8192;
#ifndef TPROBE
#define TPROBE 0
#endif
#ifndef TWAVE
#define TWAVE 0
#endif
constexpr int CW_T = 24576;
constexpr int CW_QCTR = 16384;

constexpr int RING_BYTES = 131072, MISC_OFF = RING_BYTES + 256, SIDE_OFF = RING_BYTES + 1024  , LDS_BYTES = 147456;

__device__ __forceinline__ unsigned cvt_pk_bf16(float lo, float hi) { unsigned r; asm volatile("v_cvt_pk_bf16_f32 %0, %1, %2" : "=v"(r) : "v"(lo), "v"(hi)); return r; }
__device__ __forceinline__ float bf2f(unsigned short b) { return __uint_as_float(((unsigned)b) << 16); }
__device__ __forceinline__ void store8_bf16(bf16_t* p, f32x4 a, f32x4 b) {
    u32x4 w; w.x = cvt_pk_bf16(a[0], a[1]); w.y = cvt_pk_bf16(a[2], a[3]); w.z = cvt_pk_bf16(b[0], b[1]); w.w = cvt_pk_bf16(b[2], b[3]); *(u32x4*)p = w; }
__device__ __forceinline__ void store8_bf16_nt(bf16_t* p, f32x4 a, f32x4 b) {
    u32x4 w; w.x = cvt_pk_bf16(a[0], a[1]); w.y = cvt_pk_bf16(a[2], a[3]); w.z = cvt_pk_bf16(b[0], b[1]); w.w = cvt_pk_bf16(b[2], b[3]); __builtin_nontemporal_store(w, (u32x4*)p); }
__device__ __forceinline__ float silu_f(float v) { return v * __builtin_amdgcn_rcpf(1.0f + __builtin_amdgcn_exp2f(-v * LOG2E)); }
__device__ __forceinline__ f32x4 silu4(f32x4 v) { f32x4 o; o[0] = silu_f(v[0]); o[1] = silu_f(v[1]); o[2] = silu_f(v[2]); o[3] = silu_f(v[3]); return o; }
__device__ __forceinline__ float wave_sum(float v) {
#pragma unroll
    for (int o = 1; o < 64; o <<= 1) v += __shfl_xor(v, o);
    return v;
}
__device__ __forceinline__ float log_sigmoid_fast(float x) { return -0.6931471805599453f * __builtin_amdgcn_logf(1.0f + __builtin_amdgcn_exp2f(-x * LOG2E)); }
__device__ __forceinline__ void split3_bf16(float x, unsigned& p1, unsigned& p2, unsigned& p3) {
    p1 = cvt_pk_bf16(x, 0.f) & 0xffffu; const float r1 = x - __uint_as_float(p1 << 16);
    p2 = cvt_pk_bf16(r1, 0.f) & 0xffffu; const float r2 = r1 - __uint_as_float(p2 << 16);
    p3 = cvt_pk_bf16(r2, 0.f) & 0xffffu; }
__device__ __forceinline__ u32x4 kaug_pack(float bias) { unsigned a, b, c; split3_bf16(bias, a, b, c); return (u32x4){a | (b << 16), c | (0x3F80u << 16), 0u, 0u}; }
__device__ __forceinline__ float sum4(f32x4 a) { return (a[0] + a[1]) + (a[2] + a[3]); }
__device__ __forceinline__ float dot4(f32x4 a) { return (a[0] * a[0] + a[1] * a[1]) + (a[2] * a[2] + a[3] * a[3]); }

namespace pg8 {
constexpr int BM = 256, BK = 64, HALF = 128, HTB = HALF * BK * 2, STAGE_BYTES = 8 * HTB, NXCD = 8, WGM = 8;
__host__ __device__ __forceinline__ int lds_byte(int r, int c) { const int st = (r >> 4) * 2 + (c >> 5), rr = r & 15, cc = c & 31, ob = rr * 64 + cc * 2; return st * 1024 + (ob ^ (((ob >> 9) & 1) << 5)); }
__host__ __device__ __forceinline__ void stage_rc(int b, int& R, int& C) { const int st = b / 1024, sb = b % 1024, swz = sb ^ (((sb >> 9) & 1) << 5); R = (st >> 1) * 16 + swz / 64; C = (st & 1) * 32 + (swz % 64) / 2; }
__host__ __device__ __forceinline__ int perm32(int rho) { const int n = rho >> 4, i = rho & 15; return 8 * (i >> 2) + 4 * n + (i & 3); }

struct Unit { int pm, pn; };
struct Gemm { const bf16_t* A; const bf16_t* Bt; int M, N, K, lda; };

struct StaticOrder {
    int nM, nN, nwg, G, c;
    __host__ __device__ void init(int M, int N, int G_, int c_) { nM = M / BM; nN = N / BM; nwg = nM * nN; G = G_; c = c_; }
    __host__ __device__ bool next(int i, Unit& u) const {
        const long L = (long)i * G + c; if (L >= nwg) return false;
        int wgid = (int)L; { const int q = nwg / NXCD, r = nwg % NXCD, xcd = wgid % NXCD, off = wgid / NXCD; wgid = (xcd < r ? xcd * (q + 1) : r * (q + 1) + (xcd - r) * q) + off; }
        const int nig = WGM * nN, gid = wgid / nig, fm = gid * WGM, gsz = (nM - fm) < WGM ? (nM - fm) : WGM;
        u.pm = fm + ((wgid % nig) % gsz); u.pn = (wgid % nig) / gsz; return true;
    }
};

template <class Epi, bool ALIGN_EPI, bool KSC = false>
__device__ __forceinline__ void gemm_phase(LAS unsigned char* lds, const Gemm g, const StaticOrder& S, const Epi& E, LAS float* side = nullptr) {
    int tid_ = threadIdx.x; asm volatile("" : "+v"(tid_));
    const int tid = tid_, wid = __builtin_amdgcn_readfirstlane(tid >> 6), lane = tid & 63, wr = wid >> 2, wc = wid & 3, fr = lane & 15, fq = lane >> 4;
    const int K = g.K, nt = K / BK, lda = g.lda;
    unsigned voffA[2], voffB[2];
#pragma unroll
    for (int i = 0; i < 2; ++i) { int R, C; stage_rc(tid * 16 + i * 8192, R, C); const int Rb = Epi::PERM ? ((R & ~31) + perm32(R & 31)) : R;
        voffA[i] = (unsigned)(R * lda + C) * 2u; voffB[i] = (unsigned)(Rb * K + C) * 2u; }
    const size_t kstep = (size_t)(BK * 2);
    const size_t hstepA = (size_t)HALF * lda * 2, hstepB = (size_t)HALF * K * 2;
    const size_t tstepA = 2 * hstepA, tstepB = 2 * hstepB;
    const unsigned ldsw = (unsigned)wid * 1024u;
    const int aoff = lds_byte(wr * 64 + fr, fq * 8), boff = lds_byte(wc * 32 + fr, fq * 8);
#define PG8_SA(b, h) (((b) * 2 + (h)) * HTB)
#define PG8_SB(b, h) ((4 + (b) * 2 + (h)) * HTB)
#define PG8_STAGE(bufoff, gbase, voff) do { _Pragma("unroll") for (int _i = 0; _i < 2; ++_i) \
        __builtin_amdgcn_global_load_lds((const unsigned*)((const char*)(gbase) + (voff)[_i]), (LAS unsigned*)(lds + (bufoff) + ldsw + _i * 8192), 16, 0, 0); } while (0)
#define PG8_LDA(dst, b, h) do { _Pragma("unroll") for (int m = 0; m < 4; ++m) _Pragma("unroll") for (int k = 0; k < 2; ++k) dst[m][k] = *(const LAS bf16x8*)(lds + PG8_SA(b, h) + aoff + m * 2048 + k * 1024); } while (0)
#define PG8_LDB(dst, b, h) do { _Pragma("unroll") for (int n = 0; n < 2; ++n) _Pragma("unroll") for (int k = 0; k < 2; ++k) dst[n][k] = *(const LAS bf16x8*)(lds + PG8_SB(b, h) + boff + n * 2048 + k * 1024); } while (0)
#define PG8_MMA(ai, bj, At, Bt) do { __builtin_amdgcn_s_setprio(1); _Pragma("unroll") for (int m = 0; m < 4; ++m) _Pragma("unroll") for (int n = 0; n < 2; ++n) _Pragma("unroll") for (int k = 0; k < 2; ++k) \
        acc[ai][bj][m][n] = __builtin_amdgcn_mfma_f32_16x16x32_bf16(Bt[n][k], At[m][k], acc[ai][bj][m][n], 0, 0, 0); __builtin_amdgcn_s_setprio(0); } while (0)
#define PG8_WAIT_V(n) asm volatile("s_waitcnt vmcnt(" #n ")" ::: "memory")
#define PG8_WAIT_L(n) asm volatile("s_waitcnt lgkmcnt(" #n ")" ::: "memory")
#define PG8_BAR __builtin_amdgcn_s_barrier()
#define PG8_SCHED __builtin_amdgcn_sched_barrier(0)
    Unit cur, nxt; int ui = 0;
    if (!S.next(0, cur)) return;
    f32x4 acc[2][2][4][2];
#pragma unroll
    for (int a = 0; a < 2; ++a)
#pragma unroll
        for (int b = 0; b < 2; ++b)
#pragma unroll
            for (int m = 0; m < 4; ++m)
#pragma unroll
                for (int n = 0; n < 2; ++n) acc[a][b][m][n] = (f32x4){0.f, 0.f, 0.f, 0.f};
    bf16x8 At[4][2], B0[2][2], B1[2][2];
    const char* cA = (const char*)g.A + (size_t)cur.pm * tstepA; const char* cB = (const char*)g.Bt + (size_t)cur.pn * tstepB;
    if constexpr (KSC) E.fill(cur, side, tid);
    PG8_STAGE(PG8_SB(0, 0), cB, voffB); PG8_STAGE(PG8_SB(0, 1), cB + hstepB, voffB); PG8_STAGE(PG8_SA(0, 0), cA, voffA); PG8_STAGE(PG8_SA(0, 1), cA + hstepA, voffA);
    if (wr == 1) PG8_BAR;
    PG8_WAIT_V(2); PG8_BAR;
    PG8_STAGE(PG8_SB(1, 0), cB + kstep, voffB); PG8_STAGE(PG8_SA(1, 0), cA + kstep, voffA); PG8_STAGE(PG8_SB(1, 1), cB + hstepB + kstep, voffB);
    PG8_WAIT_V(6); PG8_BAR;
    for (;;) {
        const bool has_next = S.next(ui + 1, nxt);
        const char* nA = has_next ? (const char*)g.A + (size_t)nxt.pm * tstepA : cA; const char* nB = has_next ? (const char*)g.Bt + (size_t)nxt.pn * tstepB : cB;
#pragma unroll 1
        for (int t = 0; t < nt; t += 2) {
            const bool last = (t == nt - 2);
            if constexpr (KSC) { if (t == 8 || t == 16) {
                const LAS float* sp = side + (ui & 1) * 1024 + (t == 16 ? 1 : 0);
#pragma unroll
                for (int a = 0; a < 2; ++a)
#pragma unroll
                    for (int m = 0; m < 4; ++m) { const float f = sp[(a * 128 + wr * 64 + m * 16 + fr) * 4];
#pragma unroll
                        for (int b = 0; b < 2; ++b)
#pragma unroll
                            for (int n = 0; n < 2; ++n) acc[a][b][m][n] *= f; } } }
            const char* a1 = cA + (size_t)(t + 1) * kstep;
            const char* a2 = last ? nA : cA + (size_t)(t + 2) * kstep; const char* b2 = last ? nB : cB + (size_t)(t + 2) * kstep;
            const char* a3 = a2 + kstep; const char* b3 = b2 + kstep;
            PG8_LDB(B0, 0, 0); PG8_LDB(B1, 0, 1); PG8_SCHED; PG8_LDA(At, 0, 0); PG8_STAGE(PG8_SA(1, 1), a1 + hstepA, voffA);
            PG8_WAIT_V(8); PG8_WAIT_L(0); PG8_BAR; PG8_MMA(0, 0, At, B0); PG8_MMA(0, 1, At, B1); PG8_BAR; PG8_SCHED;
            PG8_LDA(At, 0, 1); PG8_STAGE(PG8_SB(0, 0), b2, voffB); PG8_STAGE(PG8_SB(0, 1), b2 + hstepB, voffB); PG8_STAGE(PG8_SA(0, 0), a2, voffA);
            PG8_WAIT_V(8); PG8_WAIT_L(0); PG8_BAR; PG8_MMA(1, 0, At, B0); PG8_MMA(1, 1, At, B1); PG8_BAR; PG8_SCHED;
            PG8_LDB(B0, 1, 0); PG8_LDB(B1, 1, 1); PG8_SCHED; PG8_LDA(At, 1, 0); PG8_STAGE(PG8_SA(0, 1), a2 + hstepA, voffA);
            PG8_WAIT_V(8); PG8_WAIT_L(0); PG8_BAR; PG8_MMA(0, 0, At, B0); PG8_MMA(0, 1, At, B1); PG8_BAR; PG8_SCHED;
            PG8_LDA(At, 1, 1); PG8_STAGE(PG8_SB(1, 0), b3, voffB); PG8_STAGE(PG8_SB(1, 1), b3 + hstepB, voffB); PG8_STAGE(PG8_SA(1, 0), a3, voffA);
            PG8_WAIT_V(8); PG8_WAIT_L(0); PG8_BAR; PG8_MMA(1, 0, At, B0); PG8_MMA(1, 1, At, B1); PG8_BAR; PG8_SCHED;
        }
        if constexpr (ALIGN_EPI) { if (wr == 0) PG8_BAR; }
        if constexpr (KSC) { E.scaled(acc, cur, wr, wc, fr, fq, side + (ui & 1) * 1024); if (has_next) E.fill(nxt, side + ((ui + 1) & 1) * 1024, tid); }
        else E(acc, cur, wr, wc, fr, fq);
        if (!has_next) break;
#pragma unroll
        for (int a = 0; a < 2; ++a)
#pragma unroll
            for (int b = 0; b < 2; ++b)
#pragma unroll
                for (int m = 0; m < 4; ++m)
#pragma unroll
                    for (int n = 0; n < 2; ++n) acc[a][b][m][n] = (f32x4){0.f, 0.f, 0.f, 0.f};
        cur = nxt; cA = nA; cB = nB; ++ui;
        if constexpr (ALIGN_EPI) { if (wr == 1) PG8_BAR; }
    }
    PG8_WAIT_V(0);
    if constexpr (!ALIGN_EPI) { if (wr == 0) PG8_BAR; }
    PG8_BAR;
#undef PG8_SA
#undef PG8_SB
#undef PG8_STAGE
#undef PG8_LDA
#undef PG8_LDB
#undef PG8_MMA
#undef PG8_WAIT_V
#undef PG8_WAIT_L
#undef PG8_BAR
#undef PG8_SCHED
}
}

struct EpiA {
    static constexpr bool PERM = true;
    unsigned char* ws; LAS float* side; const float* bfp; unsigned* nrm;
    __device__ __forceinline__ void operator()(const f32x4 (&acc)[2][2][4][2], const pg8::Unit& u, int wr, int wc, int fr, int fq) const {
        const float* RSX = (const float*)(ws + WS_RSX);
        float rs[2][4];
#pragma unroll
        for (int ai = 0; ai < 2; ++ai)
#pragma unroll
            for (int m = 0; m < 4; ++m) rs[ai][m] = RSX[u.pm * 256 + ai * 128 + wr * 64 + m * 16 + fr];
        const int pn = u.pn, cw = wc * 32 + 8 * fq;
        bf16_t* dst; int pitch, coff, mode;
        if (pn < 2)       { dst = (bf16_t*)(ws + WS_QG);   pitch = 1536; coff = pn * 256;               mode = 1; }
        else if (pn < 4)  { dst = (bf16_t*)(ws + WS_FK);   pitch = 512;  coff = (pn - 2) * 256;         mode = 0; }
        else if (pn < 6)  { dst = (bf16_t*)(ws + WS_FV);   pitch = 512;  coff = (pn - 4) * 256;         mode = 0; }
        else if (pn < 8)  { dst = (bf16_t*)(ws + WS_GATE); pitch = 1536; coff = (pn - 6) * 256;         mode = 2; }
        else if (pn == 8) { dst = (bf16_t*)(ws + WS_QG);   pitch = 1536; coff = 512;                    mode = 0; }
        else if (pn == 9) { dst = (bf16_t*)(ws + WS_QG);   pitch = 1536; coff = 768;                    mode = 0; }
        else if (pn < 12) { dst = (bf16_t*)(ws + WS_GATE); pitch = 1536; coff = 512 + (pn - 10) * 256;  mode = 2; }
        else if (pn < 14) { dst = (bf16_t*)(ws + WS_QG);   pitch = 1536; coff = 1024 + (pn - 12) * 256; mode = 1; }
        else if (pn < 16) { dst = (bf16_t*)(ws + WS_BK);   pitch = 512;  coff = (pn - 14) * 256;        mode = 0; }
        else if (pn < 18) { dst = (bf16_t*)(ws + WS_BV);   pitch = 512;  coff = (pn - 16) * 256;        mode = 0; }
        else              { dst = (bf16_t*)(ws + WS_GATE); pitch = 1536; coff = 1024 + (pn - 18) * 256; mode = 2; }
        const float msc = (mode == 1) ? C2_64 : 1.0f;
        const bool want_nrm = pn < 4 || (pn >= 12 && pn < 16);
        float mx[2] = {0.f, 0.f};
#pragma unroll
        for (int ai = 0; ai < 2; ++ai)
#pragma unroll
            for (int m = 0; m < 4; ++m) { const int row = u.pm * 256 + ai * 128 + wr * 64 + m * 16 + fr; bf16_t* rowp = dst + (size_t)row * pitch + coff + cw; const float sc = rs[ai][m] * msc;
#pragma unroll
                for (int bj = 0; bj < 2; ++bj) { f32x4 v0 = acc[ai][bj][m][0] * sc, v1 = acc[ai][bj][m][1] * sc;
                    if (want_nrm) { float sq = dot4(v0) + dot4(v1); sq += __shfl_xor(sq, 16); sq += __shfl_xor(sq, 32); mx[bj] = fmaxf(mx[bj], sq); }
                    if (mode == 2) { v0 = silu4(v0); v1 = silu4(v1); }
                    store8_bf16_nt(rowp + bj * 128, v0, v1); } }
        if (want_nrm) { const int kind = (pn < 2) ? 0 : (pn < 4) ? 1 : (pn < 14) ? 2 : 3; const int pb = (pn < 2) ? 0 : (pn < 4) ? 2 : (pn < 14) ? 12 : 14;
#pragma unroll
            for (int bj = 0; bj < 2; ++bj) { float v = mx[bj];
#pragma unroll
                for (int o = 1; o < 16; o <<= 1) v = fmaxf(v, __shfl_xor(v, o));
                const int col = (pn - pb) * 256 + bj * 128 + wc * 32;
                if ((threadIdx.x & 63) == 0) atomicMax(nrm + ((kind * 8 + (u.pm >> 4)) * 8 + (col >> 6)) * 2 + ((col >> 5) & 1), __float_as_uint(v)); } }
        if (pn == 8 || pn == 9) {
#pragma unroll
            for (int ai = 0; ai < 2; ++ai)
#pragma unroll
                for (int m = 0; m < 4; ++m) { const int rl = ai * 128 + wr * 64 + m * 16 + fr; const float sc = rs[ai][m];
                    float s = (dot4(acc[ai][0][m][0] * sc) + dot4(acc[ai][0][m][1] * sc)) + (dot4(acc[ai][1][m][0] * sc) + dot4(acc[ai][1][m][1] * sc));
                    if (pn == 9 && (wc == 0 || wc == 3)) s = 0.f;
                    s += __shfl_xor(s, 16); s += __shfl_xor(s, 32);
                    if (fq == 0) side[rl * 4 + wc] = s; }
            asm volatile("s_waitcnt lgkmcnt(0)" ::: "memory"); __builtin_amdgcn_s_barrier(); asm volatile("" ::: "memory");
            if (threadIdx.x < 256) { const int rl = threadIdx.x; const f32x4 v = *(const LAS f32x4*)(side + rl * 4);
                float* RS = (float*)(ws + (pn == 8 ? WS_RSCQ : WS_RSCKV)); RS[u.pm * 256 + rl] = rsqrtf(sum4(v) * (pn == 8 ? 1.0f / 256.0f : 1.0f / 128.0f) + EPS); }
        }
        if (pn == 9 && wc == 0) {
            bf16_t* KR = (bf16_t*)(ws + WS_KR); const float* COS = (const float*)(ws + WS_ROPE); const float* SIN = COS + SEQ * 32;
#pragma unroll
            for (int ai = 0; ai < 2; ++ai)
#pragma unroll
                for (int m = 0; m < 4; ++m) { const int row = u.pm * 256 + ai * 128 + wr * 64 + m * 16 + fr; const float sc = rs[ai][m]; const int tpos = row & (SEQ - 1);
                    const float* cp = COS + (size_t)tpos * 32 + 8 * fq; const float* sp = SIN + (size_t)tpos * 32 + 8 * fq;
                    const f32x4 c0 = *(const f32x4*)cp, c1 = *(const f32x4*)(cp + 4), s0 = *(const f32x4*)sp, s1 = *(const f32x4*)(sp + 4);
                    const f32x4 x10 = acc[ai][0][m][0] * sc, x11 = acc[ai][0][m][1] * sc, x20 = acc[ai][1][m][0] * sc, x21 = acc[ai][1][m][1] * sc;
                    bf16_t* p = KR + (size_t)row * 64 + 8 * fq;
                    store8_bf16(p, x10 * c0 - x20 * s0, x11 * c1 - x21 * s1);
                    store8_bf16(p + 32, x20 * c0 + x10 * s0, x21 * c1 + x11 * s1);
                    if (m & 1) asm volatile("" ::: "memory"); }
        }
        if (pn == 9 && wc == 3 && fq == 0) {
            float* FFL = (float*)(ws + WS_FFL); const f32x4 b0 = *(const f32x4*)bfp, b1 = *(const f32x4*)(bfp + 4);
#pragma unroll
            for (int ai = 0; ai < 2; ++ai)
#pragma unroll
                for (int m = 0; m < 4; ++m) { const int row = u.pm * 256 + ai * 128 + wr * 64 + m * 16 + fr; const float sc = rs[ai][m];
                    const f32x4 v0 = acc[ai][0][m][0] * sc, v1 = acc[ai][0][m][1] * sc; f32x4 l0, l1;
#pragma unroll
                    for (int e = 0; e < 4; ++e) { l0[e] = log_sigmoid_fast(v0[e] + b0[e]); l1[e] = log_sigmoid_fast(v1[e] + b1[e]); }
                    float* p = FFL + (size_t)row * 8; *(f32x4*)p = l0; *(f32x4*)(p + 4) = l1; }
        }
        if (pn == 14 || pn == 15) {
            float* KP = (float*)(ws + WS_KPART) + ((size_t)(u.pm * 2 + wr)) * 512 + (pn - 14) * 256;
#pragma unroll
            for (int bj = 0; bj < 2; ++bj)
#pragma unroll
                for (int n = 0; n < 2; ++n) { f32x4 s = (f32x4){0.f, 0.f, 0.f, 0.f};
#pragma unroll
                    for (int ai = 0; ai < 2; ++ai)
#pragma unroll
                        for (int m = 0; m < 4; ++m) s += acc[ai][bj][m][n] * rs[ai][m];
#pragma unroll
                    for (int o = 1; o < 16; o <<= 1) { s[0] += __shfl_xor(s[0], o); s[1] += __shfl_xor(s[1], o); s[2] += __shfl_xor(s[2], o); s[3] += __shfl_xor(s[3], o); }
                    if (fr == 0) *(f32x4*)(KP + bj * 128 + cw + 4 * n) = s; }
        }
    }
};

struct EpiQ {
    static constexpr bool PERM = true;
    unsigned char* ws;
    __device__ __forceinline__ void operator()(const f32x4 (&acc)[2][2][4][2], const pg8::Unit& u, int wr, int wc, int fr, int fq) const {
        const float* RS = (const float*)(ws + WS_RSCQ); bf16_t* QM = (bf16_t*)(ws + WS_QM);
        const float* COS = (const float*)(ws + WS_ROPE); const float* SIN = COS + SEQ * 32;
        const int pn = u.pn, cw = wc * 32 + 8 * fq;
#pragma unroll
        for (int ai = 0; ai < 2; ++ai)
#pragma unroll
            for (int m = 0; m < 4; ++m) { const int row = u.pm * 256 + ai * 128 + wr * 64 + m * 16 + fr;
                const float sc = RS[row] * C2_192;
                if (pn < 2) {
#pragma unroll
                    for (int bj = 0; bj < 2; ++bj) { const int head = pn * 2 + bj; store8_bf16(QM + (size_t)row * 768 + head * 192 + cw, acc[ai][bj][m][0] * sc, acc[ai][bj][m][1] * sc); }
                } else {
                    const int tpos = row & (SEQ - 1); const float* cp = COS + (size_t)tpos * 32 + 8 * fq; const float* sp = SIN + (size_t)tpos * 32 + 8 * fq;
                    const f32x4 c0 = *(const f32x4*)cp, c1 = *(const f32x4*)(cp + 4), s0 = *(const f32x4*)sp, s1 = *(const f32x4*)(sp + 4);
                    const f32x4 x10 = acc[ai][0][m][0] * sc, x11 = acc[ai][0][m][1] * sc, x20 = acc[ai][1][m][0] * sc, x21 = acc[ai][1][m][1] * sc;
                    bf16_t* p = QM + (size_t)row * 768 + wc * 192 + 128 + 8 * fq;
                    store8_bf16(p, x10 * c0 - x20 * s0, x11 * c1 - x21 * s1);
                    store8_bf16(p + 32, x20 * c0 + x10 * s0, x21 * c1 + x11 * s1);
                    if (m & 1) asm volatile("" ::: "memory");
                } }
    }
};
struct EpiKV {
    static constexpr bool PERM = true;
    unsigned char* ws;
    __device__ __forceinline__ void operator()(const f32x4 (&acc)[2][2][4][2], const pg8::Unit& u, int wr, int wc, int fr, int fq) const {
        const float* RS = (const float*)(ws + WS_RSCKV);
        const int pn = u.pn, cw = wc * 32 + 8 * fq;
        bf16_t* base = (pn < 2) ? (bf16_t*)(ws + WS_KM) + pn * 256 + cw : (bf16_t*)(ws + WS_VM) + (pn - 2) * 256 + cw;
        const int pitch = 512, bjs = 128;
#pragma unroll
        for (int ai = 0; ai < 2; ++ai)
#pragma unroll
            for (int m = 0; m < 4; ++m) { const int row = u.pm * 256 + ai * 128 + wr * 64 + m * 16 + fr; const float sc = RS[row]; bf16_t* rowp = base + (size_t)row * pitch;
#pragma unroll
                for (int bj = 0; bj < 2; ++bj) store8_bf16(rowp + bj * bjs, acc[ai][bj][m][0] * sc, acc[ai][bj][m][1] * sc); }
    }
};
struct EpiC {
    static constexpr bool PERM = true;
    const float* xin; const bf16_t* xbin; bf16_t* xbout; unsigned char* ws; int last;
    __device__ __forceinline__ void fill(const pg8::Unit& u, LAS float* dst, int tid) const {
        if (tid < 256) { const size_t m = (size_t)u.pm * 256 + tid; const float* SA = (const float*)(ws + WS_SSQA); const float* SB = (const float*)(ws + WS_SSQB); const float* SC = (const float*)(ws + WS_SSQC);
            const f32x4 a0 = *(const f32x4*)(SA + m * 8), a1 = *(const f32x4*)(SA + m * 8 + 4), b0 = *(const f32x4*)(SB + m * 4), c0 = *(const f32x4*)(SC + m * 8), c1 = *(const f32x4*)(SC + m * 8 + 4);
            const float ra = rsqrtf((sum4(a0) + sum4(a1)) * (1.0f / 512.0f) + EPS), rb = rsqrtf(sum4(b0) * (1.0f / 512.0f) + EPS), rc = rsqrtf((sum4(c0) + sum4(c1)) * (1.0f / 512.0f) + EPS);
            *(LAS f32x4*)(dst + tid * 4) = (f32x4){ra / rb, rb / rc, rc, 0.f}; }
    }
    __device__ __forceinline__ void scaled(const f32x4 (&acc)[2][2][4][2], const pg8::Unit& u, int wr, int wc, int fr, int fq, const LAS float* tab) const {
        float* SSX = (float*)(ws + WS_SSX);
#pragma unroll
        for (int ai = 0; ai < 2; ++ai)
#pragma unroll
            for (int m = 0; m < 4; ++m) { const int rl = ai * 128 + wr * 64 + m * 16 + fr; const int row = u.pm * 256 + rl; const float rc = tab[rl * 4 + 2];
                const size_t off = (size_t)row * DM + u.pn * 256 + wc * 32 + 8 * fq; float ss = 0.f;
#pragma unroll
                for (int bj = 0; bj < 2; ++bj) { const size_t o = off + bj * 128; f32x4 r0, r1;
                    if (xin) { r0 = *(const f32x4*)(xin + o); r1 = *(const f32x4*)(xin + o + 4); }
                    else { const u32x4 w = *(const u32x4*)(xbin + o); r0[0] = __uint_as_float(w.x << 16); r0[1] = __uint_as_float(w.x & 0xffff0000u); r0[2] = __uint_as_float(w.y << 16); r0[3] = __uint_as_float(w.y & 0xffff0000u);
                        r1[0] = __uint_as_float(w.z << 16); r1[1] = __uint_as_float(w.z & 0xffff0000u); r1[2] = __uint_as_float(w.w << 16); r1[3] = __uint_as_float(w.w & 0xffff0000u); }
                    const f32x4 v0 = acc[ai][bj][m][0] * rc + r0, v1 = acc[ai][bj][m][1] * rc + r1; ss += dot4(v0) + dot4(v1);
                    store8_bf16(xbout + o, v0, v1); }
                if (!last) { ss += __shfl_xor(ss, 16); ss += __shfl_xor(ss, 32); if (fq == 0) SSX[(size_t)row * 16 + u.pn * 4 + wc] = ss; } }
    }
    __device__ __forceinline__ void operator()(const f32x4 (&acc)[2][2][4][2], const pg8::Unit& u, int wr, int wc, int fr, int fq) const {}
};

#define SBAR() __builtin_amdgcn_sched_barrier(0)
__device__ __forceinline__ int crow(int r, int hi) { return (r & 3) + 8 * (r >> 2) + 4 * hi; }
template <int OFF> __device__ __forceinline__ s16x4 tr_read(int vb) { s16x4 r; asm volatile("ds_read_b64_tr_b16 %0, %1 offset:%2" : "=&v"(r) : "v"(vb), "i"(OFF) : "memory"); return r; }
__device__ __forceinline__ int v_rd_base(int lane) { return ((lane & 3) << 3) | (((lane >> 2) & 3) << 6) | (((lane >> 4) & 1) << 5) | (((lane >> 5) & 1) << 8); }
template <int NCB> __device__ __forceinline__ int v_st(int k, int c) { const int kk = (k & ~0xC) | ((k & 4) << 1) | ((k & 8) >> 1); return ((kk >> 3) * NCB + (c >> 5)) * 512 + ((kk & 7) * 32 + (c & 31)) * 2; }
template <int NCB, int D0> __device__ __forceinline__ void pv_one(f32x16& od, int vb, bf16x8 pa0, bf16x8 pa1, bf16x8 pa2, bf16x8 pa3) {
#define VOFF(ks, half) (((2 * (ks) + (half)) * NCB + D0) * 512)
    const s16x4 l0 = tr_read<VOFF(0, 0)>(vb), h0 = tr_read<VOFF(0, 1)>(vb), l1 = tr_read<VOFF(1, 0)>(vb), h1 = tr_read<VOFF(1, 1)>(vb);
    const s16x4 l2 = tr_read<VOFF(2, 0)>(vb), h2 = tr_read<VOFF(2, 1)>(vb), l3 = tr_read<VOFF(3, 0)>(vb), h3 = tr_read<VOFF(3, 1)>(vb);
#undef VOFF
    asm volatile("s_waitcnt lgkmcnt(0)" ::: "memory"); SBAR();
#define PK(L, H) (bf16x8){L[0], L[1], L[2], L[3], H[0], H[1], H[2], H[3]}
    od = __builtin_amdgcn_mfma_f32_32x32x16_bf16(pa0, PK(l0, h0), od, 0, 0, 0);
    od = __builtin_amdgcn_mfma_f32_32x32x16_bf16(pa1, PK(l1, h1), od, 0, 0, 0);
    od = __builtin_amdgcn_mfma_f32_32x32x16_bf16(pa2, PK(l2, h2), od, 0, 0, 0);
    od = __builtin_amdgcn_mfma_f32_32x32x16_bf16(pa3, PK(l3, h3), od, 0, 0, 0);
#undef PK
}
template <int OFF> __device__ __forceinline__ bf16x8 k_read(unsigned a) { bf16x8 r; asm volatile("ds_read_b128 %0, %1 offset:%2" : "=v"(r) : "v"(a), "i"(OFF) : "memory"); return r; }
template <int N> __device__ __forceinline__ void lgkm_wait(bf16x8& x) { asm volatile("s_waitcnt lgkmcnt(%1)" : "+v"(x) : "i"(N) : "memory"); }
template <int N> __device__ __forceinline__ void lgkm_wait2(s16x4& x, s16x4& y) { asm volatile("s_waitcnt lgkmcnt(%2)" : "+v"(x), "+v"(y) : "i"(N) : "memory"); }
template <int I, int ND0, int KRB, bool AUG, int R>
__device__ __forceinline__ void qk_chain(f32x16& p0, f32x16& p1, bf16x8& f0, bf16x8& f1, bf16x8& f2, bf16x8& f3, const bf16x8 (&qr)[ND0], const bf16x8& qaug, const unsigned ka, const unsigned kaa) {
    constexpr int NF = 2 * ND0 + (AUG ? 2 : 0);
    if constexpr (I < NF) {
        bf16x8& cur = (I % R == 0) ? f0 : (I % R == 1) ? f1 : (I % R == 2) ? f2 : f3;
        lgkm_wait<((NF - 1 - I) < (R - 1) ? (NF - 1 - I) : (R - 1))>(cur);
        if constexpr (I < 2 * ND0) { if constexpr (I & 1) p1 = __builtin_amdgcn_mfma_f32_32x32x16_bf16(cur, qr[I >> 1], p1, 0, 0, 0); else p0 = __builtin_amdgcn_mfma_f32_32x32x16_bf16(cur, qr[I >> 1], p0, 0, 0, 0); }
        else { if constexpr (I & 1) p1 = __builtin_amdgcn_mfma_f32_32x32x16_bf16(cur, qaug, p1, 0, 0, 0); else p0 = __builtin_amdgcn_mfma_f32_32x32x16_bf16(cur, qaug, p0, 0, 0, 0); }
        SBAR();
        constexpr int J = I + R;
        if constexpr (J < NF) { if constexpr (J < 2 * ND0) cur = k_read<(J & 1) * 32 * KRB + (J >> 1) * 32>(ka); else cur = k_read<(J & 1) * 32 * KRB>(kaa); }
        qk_chain<I + 1, ND0, KRB, AUG, R>(p0, p1, f0, f1, f2, f3, qr, qaug, ka, kaa);
    }
}
template <int ND0, int KRB, bool AUG>
__device__ __forceinline__ void qk_all(f32x16& p0, f32x16& p1, const bf16x8 (&qr)[ND0], const bf16x8& qaug, const unsigned ka, const unsigned kaa) {
    constexpr int R = (ND0 > 4) ? 3 : 4;
    bf16x8 f0 = k_read<0>(ka), f1 = k_read<32 * KRB>(ka), f2 = k_read<32>(ka), f3;
    if constexpr (R == 4) f3 = k_read<32 * KRB + 32>(ka);
    qk_chain<0, ND0, KRB, AUG, R>(p0, p1, f0, f1, f2, f3, qr, qaug, ka, kaa);
}
template <int S, int NCB>
__device__ __forceinline__ void pv_chain(f32x16 (&o)[NCB], const int vb, const bf16x8& pa0, const bf16x8& pa1, const bf16x8& pa2, const bf16x8& pa3,
                                         s16x4& l0, s16x4& h0, s16x4& l1, s16x4& h1, s16x4& l2, s16x4& h2, s16x4& l3, s16x4& h3) {
    constexpr int NE = 4 * NCB;
    if constexpr (S < NE) {
        constexpr int k = S & 3, n = S >> 2;
        s16x4& L = (k == 0) ? l0 : (k == 1) ? l1 : (k == 2) ? l2 : l3; s16x4& H = (k == 0) ? h0 : (k == 1) ? h1 : (k == 2) ? h2 : h3;
        const bf16x8& pa = (k == 0) ? pa0 : (k == 1) ? pa1 : (k == 2) ? pa2 : pa3;
        lgkm_wait2<2 * ((NE - 1 - S) < 3 ? (NE - 1 - S) : 3)>(L, H);
        o[n] = __builtin_amdgcn_mfma_f32_32x32x16_bf16(pa, (bf16x8){L[0], L[1], L[2], L[3], H[0], H[1], H[2], H[3]}, o[n], 0, 0, 0);
        SBAR();
        if constexpr (S + 4 < NE) { constexpr int n2 = (S + 4) >> 2; L = tr_read<((2 * k + 0) * NCB + n2) * 512>(vb); H = tr_read<((2 * k + 1) * NCB + n2) * 512>(vb); }
        pv_chain<S + 1, NCB>(o, vb, pa0, pa1, pa2, pa3, l0, h0, l1, h1, l2, h2, l3, h3);
    }
}
template <int NCB>
__device__ __forceinline__ void pv_all(f32x16 (&o)[NCB], const int vb, const bf16x8& pa0, const bf16x8& pa1, const bf16x8& pa2, const bf16x8& pa3) {
    s16x4 l0 = tr_read<(0 * NCB) * 512>(vb), h0 = tr_read<(1 * NCB) * 512>(vb), l1 = tr_read<(2 * NCB) * 512>(vb), h1 = tr_read<(3 * NCB) * 512>(vb);
    s16x4 l2 = tr_read<(4 * NCB) * 512>(vb), h2 = tr_read<(5 * NCB) * 512>(vb), l3 = tr_read<(6 * NCB) * 512>(vb), h3 = tr_read<(7 * NCB) * 512>(vb);
    pv_chain<0, NCB>(o, vb, pa0, pa1, pa2, pa3, l0, h0, l1, h1, l2, h2, l3, h3);
}
template <int V> struct ic_t { static constexpr int value = V; };
template <int I, int N, class F> __device__ __forceinline__ void static_for(F&& f) { if constexpr (I < N) { f(ic_t<I>{}); static_for<I + 1, N>(f); } }
template <int S, int NCB, class F>
__device__ __forceinline__ void pv_chain_f(f32x16 (&o)[NCB], const int vb, const bf16x8& pa0, const bf16x8& pa1, const bf16x8& pa2, const bf16x8& pa3,
                                           s16x4& l0, s16x4& h0, s16x4& l1, s16x4& h1, s16x4& l2, s16x4& h2, F&& fill) {
    constexpr int NE = 4 * NCB, KF = 16 / NE, R = 3;
    if constexpr (S < NE) {
        constexpr int k = S & 3, n = S >> 2, sl = S % R;
        s16x4& L = (sl == 0) ? l0 : (sl == 1) ? l1 : l2; s16x4& H = (sl == 0) ? h0 : (sl == 1) ? h1 : h2;
        const bf16x8& pa = (k == 0) ? pa0 : (k == 1) ? pa1 : (k == 2) ? pa2 : pa3;
        lgkm_wait2<2 * ((NE - 1 - S) < (R - 1) ? (NE - 1 - S) : (R - 1))>(L, H);
        o[n] = __builtin_amdgcn_mfma_f32_32x32x16_bf16(pa, (bf16x8){L[0], L[1], L[2], L[3], H[0], H[1], H[2], H[3]}, o[n], 0, 0, 0);
        SBAR();
        if constexpr (S + R < NE) { constexpr int k2 = (S + R) & 3, n2 = (S + R) >> 2; L = tr_read<((2 * k2 + 0) * NCB + n2) * 512>(vb); H = tr_read<((2 * k2 + 1) * NCB + n2) * 512>(vb); }
        static_for<S * KF, S * KF + KF>(fill);
        SBAR();
        pv_chain_f<S + 1, NCB>(o, vb, pa0, pa1, pa2, pa3, l0, h0, l1, h1, l2, h2, fill);
    }
}
template <int NCB, class F>
__device__ __forceinline__ void pv_all_f(f32x16 (&o)[NCB], const int vb, const bf16x8& pa0, const bf16x8& pa1, const bf16x8& pa2, const bf16x8& pa3, F&& fill) {
    s16x4 l0 = tr_read<(0 * NCB) * 512>(vb), h0 = tr_read<(1 * NCB) * 512>(vb), l1 = tr_read<(2 * NCB) * 512>(vb), h1 = tr_read<(3 * NCB) * 512>(vb);
    s16x4 l2 = tr_read<(4 * NCB) * 512>(vb), h2 = tr_read<(5 * NCB) * 512>(vb);
    pv_chain_f<0, NCB>(o, vb, pa0, pa1, pa2, pa3, l0, h0, l1, h1, l2, h2, fill);
}
struct AttnP {
    const bf16_t* Q; int ldq;
    const bf16_t* K; int ldk;
    const bf16_t* K2;
    const bf16_t* V; int ldv;
    bf16_t* O; int ldo;
    const bf16_t* G; int ldg;
    float* SSQ; int nh;
    const float* bias;
    const unsigned* sel;
    const float* nrm;
    const unsigned char* jstart;
    const bf16_t* kaug;
    void* tctl = nullptr;
};
template <int DK, int DV, int MODE>
__device__ __forceinline__ void attn_unit(const AttnP& P, int b, int h, int qb, char* lds) {
    constexpr int NKL = DK / 64, NVL = DV / 64, NCB = DV / 32, ND0 = DK / 16, KRB = DK * 2 + 16  , KB = 64 * KRB, VB = 64 * DV * 2;
    constexpr float THR = 8.0f;
    int tid_ = threadIdx.x; asm volatile("" : "+v"(tid_));
    const int tid = tid_, lane = tid & 63, r32 = lane & 31, hi = lane >> 5; const int wid = __builtin_amdgcn_readfirstlane(tid >> 6);
    char* Kl = lds; char* Vl = lds + 3 * KB; float* wsf = (float*)(lds + 3 * KB + 3 * VB) + wid * 64;
    const int q0 = qb * 256; const size_t row0 = (size_t)b * SEQ;
    const int qrow = q0 + wid * 32 + r32;
    const int qlast = q0 + wid * 32 + 31;
    bf16x8 qr[ND0];
    { const bf16_t* Qw = P.Q + (row0 + qrow) * P.ldq + h * DK + hi * 8;
#pragma unroll
      for (int d0 = 0; d0 < ND0; ++d0) qr[d0] = *(const bf16x8*)(Qw + d0 * 16); }
    const int sr = tid >> 3, sc = (tid & 7) * 8;
    const unsigned kofs = (unsigned)((sr * P.ldk + h * (DK > 128 ? 128 : DK) + sc) * 2), k2ofs = (unsigned)((sr * 64 + sc) * 2), vofs = (unsigned)((sr * P.ldv + h * DV + sc) * 2);
    const char* const Kg0 = (const char*)(P.K + row0 * P.ldk); const char* const Kg20 = (DK > 128) ? (const char*)(P.K2 + row0 * 64) : nullptr; const char* const Vg0 = (const char*)(P.V + row0 * P.ldv);
    const int vb0 = (int)(uintptr_t)Vl + v_rd_base(lane);
    const int NT = 4 * (qb + 1);
    int jskip = 0;
    unsigned selw = 0u; float alpha_b = 0.f;
    if (MODE == 2) { selw = P.sel[(row0 + qrow) * 8 + h]; alpha_b = LOG2E * __builtin_amdgcn_exp2f(-(float)(h + 1));
        const float* nq = P.nrm + (((2 * 8 + b) * 8 + h) * 2); const float* nk = P.nrm + (((3 * 8 + b) * 8 + h) * 2);
        const float smax = 1.02f * sqrtf((nq[0] + nq[1]) * (nk[0] + nk[1]));
        const float dist = (40.0f + 2.0f * smax) / alpha_b;
        const float jf = ((float)(q0 - 63) - dist) * (1.0f / 64.0f);
        int js = (jf < 0.f) ? 0 : (int)jf + 1; if (js > 4 * qb) js = 4 * qb; jskip = __builtin_amdgcn_readfirstlane(js); }
    if (MODE == 0) { jskip = __builtin_amdgcn_readfirstlane((int)P.jstart[(b * 8 + h) * 16 + qb]); }
    const bf16_t* kaugp = (MODE == 0) ? P.kaug + (size_t)(b * 8 + h) * SEQ * 8 : (MODE == 2) ? P.kaug + (size_t)h * SEQ * 8 : nullptr;
    u32x4 qa = (u32x4){0u, 0u, 0u, 0u}; if (MODE != 1 && hi == 0) { qa.x = 0x3F803F80u; qa.y = 0x00003F80u; }
    const int NS = NT - jskip;
#define JOF(s_) ((MODE == 2) ? (((s_) < 4) ? 3 - (s_) : NT + 3 - (s_)) : (MODE == 0) ? NT - 1 - (s_) : (s_) + jskip)
#define KEY0(j) ((MODE == 2) ? (((j) < 4) ? q0 + 64 * (j) : 64 * ((j) - 4)) : 64 * (j))
    bf16x8 ks[NKL], vs[NVL], ksa = bf16x8{};
#define SLOAD(k0) do { if (MODE != 1 && tid < 64) ksa = *(const bf16x8*)(kaugp + (size_t)((k0) + tid) * 8); \
 _Pragma("unroll") for (int i_ = 0; i_ < NKL; ++i_) ks[i_] = (i_ < 2) ? *(const bf16x8*)(Kg0 + (size_t)(k0) * P.ldk * 2 + kofs + 128 * i_) : *(const bf16x8*)(Kg20 + (size_t)(k0) * 128 + k2ofs); \
                       _Pragma("unroll") for (int i_ = 0; i_ < NVL; ++i_) vs[i_] = *(const bf16x8*)(Vg0 + (size_t)(k0) * P.ldv * 2 + vofs + 128 * i_); } while (0)
#define SWRITE(bsel) do { if (MODE != 1 && tid < 64) *(bf16x8*)(Kl + (bsel) * KB + tid * KRB + DK * 2) = ksa; \
                          _Pragma("unroll") for (int i_ = 0; i_ < NKL; ++i_) *(bf16x8*)(Kl + (bsel) * KB + sr * KRB + (sc + 64 * i_) * 2) = ks[i_]; \
                          _Pragma("unroll") for (int i_ = 0; i_ < NVL; ++i_) *(bf16x8*)(Vl + (bsel) * VB + v_st<NCB>(sr, sc + 64 * i_)) = vs[i_]; } while (0)
    float l_reg = 0.f; bool first_row = true;
    float negm = 0.f; f32x16 o[NCB];
#pragma unroll
    for (int d = 0; d < NCB; ++d) o[d] = f32x16{};
    const bool late = wid >= 4; bool pend = false; int bprev = 0;
    bf16x8 pa0, pa1, pa2, pa3;
#define PVALL(bsel_) do { const int vb_ = vb0 + (bsel_) * VB; __builtin_amdgcn_s_setprio(1); pv_all_f<NCB>(o, vb_, pa0, pa1, pa2, pa3, [](auto) {}); __builtin_amdgcn_s_setprio(0); } while (0)
    unsigned long long tp_sec = 0ull, tp_a = 0ull, tp_b = 0ull; const unsigned long long tp_u0 = (MODE == 1 && TPROBE) ? __builtin_readcyclecounter() : 0ull;
#define TPA() do { if (MODE == 1 && TPROBE) tp_a = __builtin_readcyclecounter(); } while (0)
#define TPB(k_) do { if (MODE == 1 && TPROBE) { tp_b = __builtin_readcyclecounter(); if (TPROBE == (k_)) tp_sec += tp_b - tp_a; tp_a = tp_b; } } while (0)
    SLOAD(KEY0(JOF(0))); SWRITE(0);
    int bsel = 0;
    const unsigned long long tp_l0 = (MODE == 1 && TPROBE) ? __builtin_readcyclecounter() : 0ull;
    for (int st = 0; st < NS; ++st) { const int j = JOF(st);
        TPA();
        __syncthreads();
        TPB(1);
        const int key0 = KEY0(j);
        if (st + 1 < NS) SLOAD(KEY0(JOF(st + 1)));
        TPB(2);
        bool active = true;
        if (MODE == 2 && j >= 4) { active = __any((int)((selw >> ((j - 4) >> 2)) & 1u)); }
        else { active = key0 <= qlast; }
        if (active) {
            f32x16 p0, p1;
#pragma unroll
            for (int r = 0; r < 16; ++r) { p0[r] = negm; p1[r] = negm; }
            const char* Kb = Kl + bsel * KB;
            __builtin_amdgcn_s_setprio(1);
            if (MODE == 2 && hi == 0) qa.y = (j < 4 || ((selw >> ((j - 4) >> 2)) & 1u)) ? 0x00003F80u : 0xC3803F80u;
            { const unsigned ka = (unsigned)(uintptr_t)(Kb + r32 * KRB + hi * 16), kaa = (unsigned)(uintptr_t)(Kb + r32 * KRB + DK * 2);
              qk_all<ND0, KRB, MODE != 1>(p0, p1, qr, __builtin_bit_cast(bf16x8, qa), ka, kaa); }
            __builtin_amdgcn_s_setprio(0);
            TPB(3);
            if (key0 + 63 > q0 + wid * 32 && (MODE != 2 || j < 4)) { const int kb = key0 + 4 * hi;
#pragma unroll
                for (int r = 0; r < 16; ++r) { const int kv = kb + (r & 3) + 8 * (r >> 2); if (kv > qrow) p0[r] = -INFINITY; if (kv + 32 > qrow) p1[r] = -INFINITY; } }
            float pmax = p0[0];
#pragma unroll
            for (int r = 1; r < 16; ++r) pmax = fmaxf(pmax, p0[r]);
#pragma unroll
            for (int r = 0; r < 16; ++r) pmax = fmaxf(pmax, p1[r]);
            { auto rr = __builtin_amdgcn_permlane32_swap(__float_as_uint(pmax), __float_as_uint(pmax), false, false); pmax = fmaxf(__uint_as_float(rr[0]), __uint_as_float(rr[1])); }
            const bool need = first_row ? (pmax > -INFINITY) : (pmax > THR);
            if (__any(need)) {
                if (pend) { PVALL(bprev); pend = false; }
                const float d = first_row ? (need ? pmax : 0.f) : fmaxf(pmax, 0.f);
                const float al = first_row ? 1.f : __builtin_amdgcn_exp2f(-d);
                first_row = first_row && !need;
                negm -= d; l_reg *= al;
#pragma unroll
                for (int r = 0; r < 16; ++r) { p0[r] -= d; p1[r] -= d; }
                if (hi == 0) wsf[r32] = al; asm volatile("s_waitcnt lgkmcnt(0)" ::: "memory");
#pragma unroll
                for (int r = 0; r < 16; ++r) { const float a = wsf[crow(r, hi)];
#pragma unroll
                    for (int d_ = 0; d_ < NCB; ++d_) o[d_][r] *= a; }
            }
            float ps0 = 0.f, ps1 = 0.f; unsigned pk[16]; bf16x8 pn0, pn1, pn2, pn3;
            auto chunk = [&](auto mc) { constexpr int m = decltype(mc)::value, G = m >> 2, q = m & 3, B = (G & 1) * 8 + 2 * q;
                const float e0 = __builtin_amdgcn_exp2f((G < 2) ? p0[B] : p1[B]), e1 = __builtin_amdgcn_exp2f((G < 2) ? p0[B + 1] : p1[B + 1]);
                ps0 += e0; ps1 += e1; pk[m] = cvt_pk_bf16(e0, e1);
                if constexpr (q == 3) { auto r0 = __builtin_amdgcn_permlane32_swap(pk[4 * G], pk[4 * G + 2], false, false); auto r1 = __builtin_amdgcn_permlane32_swap(pk[4 * G + 1], pk[4 * G + 3], false, false);
                    u32x4 w = {r0[0], r1[0], r0[1], r1[1]}; bf16x8& dst = (G == 0) ? pn0 : (G == 1) ? pn1 : (G == 2) ? pn2 : pn3; dst = __builtin_bit_cast(bf16x8, w); } };
            if (pend) { PVALL(bprev); } static_for<0, 16>(chunk);
            pa0 = pn0; pa1 = pn1; pa2 = pn2; pa3 = pn3; pend = true; bprev = bsel;
            float ps = ps0 + ps1;
            { auto rr = __builtin_amdgcn_permlane32_swap(__float_as_uint(ps), __float_as_uint(ps), false, false); ps = __uint_as_float(rr[0]) + __uint_as_float(rr[1]); }
            l_reg += ps;
            TPB(4);
        } else if (pend) { PVALL(bprev); pend = false; }
        const int bnext = (bsel == 2) ? 0 : bsel + 1;
        if (st + 1 < NS) SWRITE(bnext);
        TPB(6);
        bsel = bnext;
    }
    const unsigned long long tp_l1 = (MODE == 1 && TPROBE) ? __builtin_readcyclecounter() : 0ull;
    if (pend) PVALL(bprev);
#undef PVALL
    if (hi == 0) wsf[32 + r32] = l_reg; asm volatile("s_waitcnt lgkmcnt(0)" ::: "memory");
    const size_t orow0 = row0 + q0 + wid * 32;
    __syncthreads();
    bf16_t* stg = (bf16_t*)lds + wid * (32 * DV);
#pragma unroll
    for (int r = 0; r < 16; ++r) { const int orow = crow(r, hi); const float rl = __builtin_amdgcn_rcpf(wsf[32 + orow]); float ss = 0.f;
#pragma unroll
        for (int d = 0; d < NCB; ++d) { const float y = o[d][r] * rl; ss += y * y; stg[orow * DV + d * 32 + r32] = (bf16_t)(cvt_pk_bf16(y, 0.f) & 0xffffu); }
#pragma unroll
        for (int sh = 1; sh < 32; sh <<= 1) ss += __shfl_xor(ss, sh);
        if (r32 == 0) P.SSQ[(orow0 + orow) * P.nh + h] = ss; }
    asm volatile("s_waitcnt lgkmcnt(0)" ::: "memory");
    { constexpr int CPR = DV / 8, NIT = 32 * CPR / 64;
#pragma unroll
      for (int it = 0; it < NIT; ++it) { const int ci = it * 64 + lane, row = ci / CPR, ch = ci % CPR;
          const u32x4 yv = *(const u32x4*)(stg + row * DV + ch * 8);
          const u32x4 gv = *(const u32x4*)(P.G + (orow0 + row) * P.ldg + h * DV + ch * 8); u32x4 ov;
#pragma unroll
          for (int e = 0; e < 4; ++e) ov[e] = cvt_pk_bf16(__uint_as_float(yv[e] << 16) * __uint_as_float(gv[e] << 16), __uint_as_float(yv[e] & 0xffff0000u) * __uint_as_float(gv[e] & 0xffff0000u));
          *(u32x4*)(P.O + (orow0 + row) * P.ldo + h * DV + ch * 8) = ov; } }
    __syncthreads();
    if (MODE == 1 && TPROBE) { const unsigned long long tp_u1 = __builtin_readcyclecounter();
        if (tid == TWAVE * 64) { unsigned long long* tc = (unsigned long long*)P.tctl;
            if (TPROBE == 7) tp_sec = (tp_u1 - tp_u0) - (tp_l1 - tp_l0);
            const unsigned long long tot = (TPROBE == 7) ? (tp_u1 - tp_u0) : (tp_l1 - tp_l0);
            __hip_atomic_fetch_add(tc + 0, tp_sec, __ATOMIC_RELAXED, __HIP_MEMORY_SCOPE_AGENT); __hip_atomic_fetch_add(tc + 1, tot, __ATOMIC_RELAXED, __HIP_MEMORY_SCOPE_AGENT);
            __hip_atomic_fetch_add(tc + 2, (unsigned long long)NS, __ATOMIC_RELAXED, __HIP_MEMORY_SCOPE_AGENT); } }
#undef TPA
#undef TPB
#undef KEY0
#undef JOF
#undef SLOAD
#undef SWRITE
}


#define XB_TMO      128
#define XB_XCNT(j)  (256  + 64 * (j))
#define XB_XSUB(j)  (1280 + 64 * (j))
#define XB_XGEN(j)  (2304 + 64 * (j))
#define XB_TOP      3328
#define XB_TOPGEN   3392
#define XCD_BAR_WORDS 3456
#define XB_SPIN_CAP (1u << 18)
__device__ __forceinline__ unsigned xb_ld(unsigned* p)              { return __hip_atomic_load(p, __ATOMIC_RELAXED, __HIP_MEMORY_SCOPE_AGENT); }
__device__ __forceinline__ unsigned xb_add(unsigned* p, unsigned v) { return __hip_atomic_fetch_add(p, v, __ATOMIC_RELAXED, __HIP_MEMORY_SCOPE_AGENT); }
__device__ __forceinline__ unsigned xb_xcc_id() { return (unsigned)__builtin_amdgcn_s_getreg((3 << 11) | 20) & 0xFu; }
#define XB_SPIN(cond, bar) do { unsigned _sp = 0; while (cond) { __builtin_amdgcn_s_sleep(1); \
    if ((++_sp & 255u) == 0u) { if (xb_ld(&(bar)[XB_TMO])) break; if (_sp > XB_SPIN_CAP) { atomicAdd(&(bar)[XB_TMO], 1u); break; } } } } while (0)
struct XcdBarrier { unsigned* bar; unsigned x; volatile LAS unsigned* st; };
__device__ __forceinline__ XcdBarrier xcd_barrier_post(unsigned* bar, volatile LAS unsigned* st) {
    XcdBarrier b; b.bar = bar; b.x = xb_xcc_id(); b.st = st;
    if (threadIdx.x == 0) (void)xb_add(&bar[XB_XCNT(b.x)], 1u);
    return b;
}
__device__ __forceinline__ void xcd_barrier_complete(unsigned* bar, unsigned x, unsigned& nloc, unsigned& nx) {
    const unsigned G = gridDim.x * gridDim.y * gridDim.z;
    unsigned sum, cnt, mine, sp = 0u;
    for (;;) {
        sum = 0u; cnt = 0u; mine = 0u;
#pragma unroll
        for (unsigned j = 0; j < 16; ++j) { const unsigned c = xb_ld(&bar[XB_XCNT(j)]); sum += c; cnt += (c > 0u) ? 1u : 0u; mine = (j == x) ? c : mine; }
        if (sum == G) break;
        __builtin_amdgcn_s_sleep(1);
        if ((++sp & 255u) == 0u) { if (xb_ld(&bar[XB_TMO])) break; if (sp > XB_SPIN_CAP) { atomicAdd(&bar[XB_TMO], 1u); break; } }
    }
    nloc = mine > 0u ? mine : 1u; nx = cnt > 0u ? cnt : 1u;
}
__device__ __forceinline__ void xcd_barrier(const XcdBarrier& b) {
    asm volatile("s_waitcnt vmcnt(0)" ::: "memory");
    __syncthreads();
    if (threadIdx.x == 0) {
        unsigned* bar = b.bar;
        __builtin_amdgcn_s_waitcnt(0);
        unsigned nloc = b.st[0], nx = b.st[1];
        if (nloc == 0u) { xcd_barrier_complete(bar, b.x, nloc, nx); b.st[0] = nloc; b.st[1] = nx; }
        const unsigned old = xb_add(&bar[XB_XSUB(b.x)], 1u);
        const unsigned gen = old / nloc;
        if (old + 1u == (gen + 1u) * nloc) {
            __builtin_amdgcn_fence(__ATOMIC_RELEASE, "agent");
            asm volatile("s_waitcnt vmcnt(0)" ::: "memory");
            const unsigned og = xb_add(&bar[XB_TOP], 1u);
            const unsigned tg = og / nx;
            if (og + 1u == (tg + 1u) * nx) xb_add(&bar[XB_TOPGEN], 1u);
            else XB_SPIN(xb_ld(&bar[XB_TOPGEN]) == tg, bar);
            __builtin_amdgcn_fence(__ATOMIC_ACQUIRE, "agent");
            xb_add(&bar[XB_XGEN(b.x)], 1u);
            asm volatile("s_waitcnt vmcnt(0)" ::: "memory");
        } else {
            XB_SPIN(xb_ld(&bar[XB_XGEN(b.x)]) == gen, bar);
            __builtin_amdgcn_fence(__ATOMIC_ACQUIRE, "agent");
            asm volatile("s_waitcnt vmcnt(0)" ::: "memory");
        }
    }
    __syncthreads();
}
constexpr int CW_BAR = 4096;

struct UTab { unsigned short v[320]; };
constexpr UTab make_utab() {
    UTab t{}; int k = 0;
    for (int c = 80; c >= 1; --c) {
        if (c % 5 == 0 && c / 5 <= 16) { const int qb = c / 5 - 1; for (int h = 0; h < 4; ++h) t.v[k++] = (unsigned short)((1 << 12) | (h << 4) | qb); }
        if (c % 2 == 0 && c / 2 <= 16) { const int qb = c / 2 - 1; for (int ty = 0; ty <= 2; ty += 2) for (int h = 0; h < 8; ++h) t.v[k++] = (unsigned short)((ty << 12) | (h << 4) | qb); }
    }
    return t;
}
__device__ const UTab g_utab = make_utab();
constexpr int N_UNITS_PER_BATCH = 320;

struct Args { const float* in[11]; float* out; unsigned char* ws; int ph_lo, ph_hi, coop, pad; };
#ifndef PHM
#define PHM 127
#endif
#ifndef B1M
#define B1M 31
#endif
#ifndef DBL
#define DBL 0
#endif
constexpr int NPHASES = 13;

__device__ __forceinline__ int src_in(int n) {
    const int t = n >> 8, j = n & 255;
    if (t < 6) return n;
    if (t < 8) return 1544 + (n - 1536);
    if (t == 8) return 2056 + j;
    if (t == 9) {
        if (j < 32) return 2440 + j; if (j < 96) return 2312 + (j - 32); if (j < 104) return 1536 + (j - 96); if (j < 128) return -1;
        if (j < 160) return 2440 + 32 + (j - 128); if (j < 224) return 2312 + 64 + (j - 160); return -1; }
    if (t < 12) return 2504 + (n - 2560);
    return 3016 + (n - 3072);
}
__device__ __forceinline__ int src_uq(int n) {
    if (n < 512) return (n >> 7) * 192 + (n & 127);
    const int p = n - 512; return p < 128 ? (p >> 5) * 192 + 128 + (p & 31) : ((p - 128) >> 5) * 192 + 160 + ((p - 128) & 31);
}
__device__ __forceinline__ int src_ukv(int n) {
    return n < 512 ? (n >> 7) * 256 + (n & 127) : ((n - 512) >> 7) * 256 + 128 + ((n - 512) & 127);
}
__device__ __forceinline__ void transpose_item(const float* W, int Ksrc, int Nsrc, const float* gain, bf16_t* WT, int Kdst, int mat, LAS float* scr, int kb, int nb, int lane) {
    const int k0 = 64 * kb, n0 = 32 * nb; const int nn = n0 + (lane & 31);
    const int sc = (mat == 0) ? src_in(nn) : (mat == 1) ? src_uq(nn) : (mat == 2) ? src_ukv(nn) : nn;
    float vv[32];
#pragma unroll
    for (int i = 0; i < 32; ++i) { const int kk = 2 * i + (lane >> 5); const int k = k0 + kk;
        int ks = k; if (mat == 2) ks = (k >= 32 && k < 96) ? k - 32 : (k >= 160 && k < 224) ? k - 96 : -1;
        const bool ok = sc >= 0 && ks >= 0 && ks < Ksrc; const int kc = ok ? ks : 0; const int cc = sc >= 0 ? sc : 0;
        const float w = W[(size_t)kc * Nsrc + cc] * gain[kc]; vv[i] = ok ? w : 0.f; }
#pragma unroll
    for (int i = 0; i < 32; ++i) { const int kk = 2 * i + (lane >> 5); scr[kk * 33 + (lane & 31)] = vv[i]; }
    asm volatile("s_waitcnt lgkmcnt(0)" ::: "memory");
    const int c = lane & 7;
#pragma unroll
    for (int j = 0; j < 4; ++j) { const int n = (lane >> 3) + 8 * j; const LAS float* s = scr + (8 * c) * 33 + n;
        u32x4 o; o.x = cvt_pk_bf16(s[0 * 33], s[1 * 33]); o.y = cvt_pk_bf16(s[2 * 33], s[3 * 33]); o.z = cvt_pk_bf16(s[4 * 33], s[5 * 33]); o.w = cvt_pk_bf16(s[6 * 33], s[7 * 33]);
        *(u32x4*)(WT + (size_t)(n0 + n) * Kdst + k0 + 8 * c) = o; }
    asm volatile("s_waitcnt lgkmcnt(0)" ::: "memory");
}

__device__ __forceinline__ float log_sigmoid_f(float x) { return fminf(x, 0.f) - log1pf(expf(-fabsf(x))); }

__device__ __forceinline__ void phase_p0(const Args& args, const int layer, LAS unsigned char* lds, unsigned char* lds_raw, const int G, const int bid) {
    unsigned char* ws = args.ws; asm volatile("" : "+s"(ws));
    int tid = threadIdx.x; asm volatile("" : "+v"(tid));
    const int lane = tid & 63, wave = __builtin_amdgcn_readfirstlane(tid >> 6);
    const int gw = bid * NWAVES + wave, NGW = G * NWAVES;
    unsigned char* wl = ws + WS_W + (size_t)layer * W_LAYER;
    (void)lane; (void)gw; (void)NGW; (void)wl; (void)lds_raw;
            LAS float* scr = (LAS float*)(lds + wave * 16384);
            constexpr int I_IN = 16 * 160, I_UQ = 4 * 24, I_UKV = 4 * 32, I_OUT = 24 * 32, I_L = I_IN + I_UQ + I_UKV + I_OUT;
            for (int it = gw; it < 2 * I_L; it += NGW) {
                const int l = it / I_L; int r = it % I_L; unsigned char* w = ws + WS_W + (size_t)l * W_LAYER;
                if (r < I_IN) { transpose_item(args.in[2] + (size_t)l * DM * D_IN, DM, D_IN, args.in[1] + l * DM, (bf16_t*)(w + W_IN_OFF), DM, 0, scr, r / 160, r % 160, lane); continue; } r -= I_IN;
                if (r < I_UQ) { transpose_item(args.in[5] + (size_t)l * 256 * 768, 256, 768, args.in[4] + l * 256, (bf16_t*)(w + W_UQ_OFF), 256, 1, scr, r / 24, r % 24, lane); continue; } r -= I_UQ;
                if (r < I_UKV) { transpose_item(args.in[7] + (size_t)l * 128 * 1024, 128, 1024, args.in[6] + l * 128, (bf16_t*)(w + W_UKV_OFF), 256, 2, scr, r / 32, r % 32, lane); continue; } r -= I_UKV;
                transpose_item(args.in[9] + (size_t)l * DMIX * DM, DMIX, DM, args.in[8] + l * DMIX, (bf16_t*)(w + W_OUT_OFF), DMIX, 3, scr, r / 32, r % 32, lane);
            }
            { const float* x = args.in[0]; bf16_t* XB = (bf16_t*)(ws + WS_XB); float* RSX = (float*)(ws + WS_RSX);
              for (int m = gw; m < T; m += NGW) { const f32x4* xr = (const f32x4*)(x + (size_t)m * DM) + 2 * lane; f32x4 v[4]; float s = 0.f;
#pragma unroll
                  for (int j = 0; j < 2; ++j) { v[2 * j] = xr[128 * j]; v[2 * j + 1] = xr[128 * j + 1]; s += dot4(v[2 * j]) + dot4(v[2 * j + 1]); }
                  s = wave_sum(s);
#pragma unroll
                  for (int j = 0; j < 2; ++j) store8_bf16(XB + (size_t)m * DM + 512 * j + 8 * lane, v[2 * j], v[2 * j + 1]);
                  if (lane == 0) RSX[m] = rsqrtf(s * (1.0f / 1024.0f) + EPS); } }
            { u32x4* KA = (u32x4*)(ws + WS_KAUGM);
              for (int i = bid * NTHREADS + tid; i < 8 * SEQ; i += G * NTHREADS) { const int hh = i >> 12, kp = i & (SEQ - 1);
                  KA[i] = kaug_pack(LOG2E * __builtin_amdgcn_exp2f(-(float)(hh + 1)) * (float)kp); } }
            { float* COS = (float*)(ws + WS_ROPE); float* SIN = COS + SEQ * 32;
              for (int i = bid * NTHREADS + tid; i < SEQ * 32; i += G * NTHREADS) { const int t = i >> 5, f = i & 31;
                  const float inv = powf(10000.0f, -(float)(2 * f) / 64.0f); const float ang = (float)t * inv;
                  COS[i] = (float)cos((double)ang); SIN[i] = (float)sin((double)ang); } }
}

__device__ __forceinline__ void phase_a(const Args& args, const int layer, LAS unsigned char* lds, unsigned char* lds_raw, const int G, const int bid) {
    unsigned char* ws = args.ws; asm volatile("" : "+s"(ws));
    int tid = threadIdx.x; asm volatile("" : "+v"(tid));
    const int lane = tid & 63, wave = __builtin_amdgcn_readfirstlane(tid >> 6);
    const int gw = bid * NWAVES + wave, NGW = G * NWAVES;
    unsigned char* wl = ws + WS_W + (size_t)layer * W_LAYER;
    (void)lane; (void)gw; (void)NGW; (void)wl; (void)lds_raw;
            pg8::Gemm g{layer == 0 ? (const bf16_t*)(ws + WS_XB) : (const bf16_t*)args.out, (const bf16_t*)(wl + W_IN_OFF), T, NIN, DM, DM}; pg8::StaticOrder S; S.init(T, NIN, G, bid);
            EpiA E{ws, (LAS float*)(lds + SIDE_OFF), args.in[3] + layer * 8, (unsigned*)(ws + WS_CTL) + CW_NRM + layer * 512};
            pg8::gemm_phase<EpiA, true>(lds, g, S, E);
}

__device__ __forceinline__ void phase_b1(const Args& args, const int layer, LAS unsigned char* lds, unsigned char* lds_raw, const int G, const int bid) {
    unsigned char* ws = args.ws; asm volatile("" : "+s"(ws));
    int tid = threadIdx.x; asm volatile("" : "+v"(tid));
    const int lane = tid & 63, wave = __builtin_amdgcn_readfirstlane(tid >> 6);
    const int gw = bid * NWAVES + wave, NGW = G * NWAVES;
    unsigned char* wl = ws + WS_W + (size_t)layer * W_LAYER;
    (void)lane; (void)gw; (void)NGW; (void)wl; (void)lds_raw;
            if (B1M & 1) { pg8::Gemm g{(const bf16_t*)(ws + WS_QG) + 512, (const bf16_t*)(wl + W_UQ_OFF), T, 768, 256, 1536}; pg8::StaticOrder S; S.init(T, 768, G, bid);
              EpiQ E{ws}; pg8::gemm_phase<EpiQ, true>(lds, g, S, E); }
            if (B1M & 2) { pg8::Gemm g{(const bf16_t*)(ws + WS_QG) + 768, (const bf16_t*)(wl + W_UKV_OFF), T, 1024, 256, 1536}; pg8::StaticOrder S; S.init(T, 1024, G, bid);
              EpiKV E{ws}; pg8::gemm_phase<EpiKV, true>(lds, g, S, E); }
            if (B1M & 8) { const float* FFL = (const float*)(ws + WS_FFL); LAS float* xs = (LAS float*)lds;
              for (int cj = (G >= 64) ? bid - (G - 32) : bid; cj >= 0 && cj < 32; cj += G) { const int b = cj >> 2, h0 = (cj & 3) * 2;
                  const float* src = FFL + ((size_t)b * SEQ + tid * 8) * 8 + h0; float v[8][2];
#pragma unroll
                  for (int i = 0; i < 8; ++i) { const f32x2 a = *(const f32x2*)(src + i * 8); v[i][0] = a[0]; v[i][1] = a[1]; }
#pragma unroll
                  for (int i = 1; i < 8; ++i)
#pragma unroll
                      for (int h = 0; h < 2; ++h) v[i][h] += v[i - 1][h];
                  float off[2];
#pragma unroll
                  for (int h = 0; h < 2; ++h) { const float tot = v[7][h]; float incl = tot;
#pragma unroll
                      for (int o = 1; o < 64; o <<= 1) { const float n = __shfl_up(incl, o); if (lane >= o) incl += n; }
                      off[h] = incl - tot; if (lane == 63) xs[wave * 8 + h] = incl; }
                  __syncthreads();
#pragma unroll
                  for (int h = 0; h < 2; ++h) { float wo = 0.f; for (int w = 0; w < wave; ++w) wo += xs[w * 8 + h]; off[h] += wo; }
#pragma unroll
                  for (int h = 0; h < 2; ++h) { u32x4* dst = (u32x4*)(ws + WS_KAUGF) + (size_t)(b * 8 + h0 + h) * SEQ + tid * 8; f32x4 o0, o1;
#pragma unroll
                      for (int e = 0; e < 4; ++e) { o0[e] = -LOG2E * (v[e][h] + off[h]); o1[e] = -LOG2E * (v[4 + e][h] + off[h]); }
#pragma unroll
                      for (int e = 0; e < 4; ++e) { dst[e] = kaug_pack(o0[e]); dst[4 + e] = kaug_pack(o1[e]); }
                      if ((tid & 7) == 7) xs[64 + h * 64 + (tid >> 3)] = o1[3];
                      if ((tid & 31) == 0) xs[64 + 512 + h * 16 + (tid >> 5)] = o0[0]; }
                  __syncthreads();
                  if (tid < 32) { const int hh = tid >> 4, h = h0 + hh, qb = tid & 15; const float* nq = (const float*)(ws + WS_CTL) + CW_NRM + layer * 512 + ((0 * 8 + b) * 8 + h) * 2; const float* nk = nq + 8 * 8 * 2;
                      const float smax = 1.02f * sqrtf((nq[0] + nq[1]) * (nk[0] + nk[1])); const float thr = -(40.0f + 2.0f * smax); const float bq0 = xs[64 + 512 + hh * 16 + qb];
                      int j = 4 * qb - 1; while (j >= 0 && xs[64 + hh * 64 + j] - bq0 > thr) --j;
                      ((unsigned char*)(ws + WS_JSTART))[(b * 8 + h) * 16 + qb] = (unsigned char)(j + 1); }
                  __syncthreads(); } }
            if (B1M & 16) { const float* KP = (const float*)(ws + WS_KPART); const bf16_t* QG = (const bf16_t*)(ws + WS_QG); unsigned* SEL = (unsigned*)(ws + WS_SEL);
              LAS float* km = (LAS float*)lds;
              const bool bal = (G == 256); const int njn = bal ? 3 : (512 + G - 1) / G;
              for (int jn = 0; jn < njn; ++jn) { int job = -1;
                  if (bal) { if (bid >= 224) { if (jn == 0) job = 288 + (bid - 224); } else if (bid >= 128) job = (bid - 128) + 96 * jn; else if (jn == 0) job = 320 + bid; else if (jn == 1 && bid < 64) job = 448 + bid; }
                  else { job = bid + jn * G; if (job >= 512) job = -1; }
                  if (job < 0) continue;
                  const int b = job >> 6, h = (job >> 3) & 7, tb = job & 7;
                  __syncthreads();
                  for (int i = tid; i < 1024; i += NTHREADS) { const int n = i >> 6, d = i & 63; const float* p = KP + ((size_t)((b * 16 + n) * 2)) * 512 + h * 64 + d; km[i] = (p[0] + p[512]) * (1.0f / 256.0f); }
                  __syncthreads();
                  const int t = tb * 512 + tid; const int cur = t >> 8; const size_t row = (size_t)b * SEQ + t;
                  float q[64];
                  { const bf16x8* qp = (const bf16x8*)(QG + row * 1536 + 1024 + h * 64);
#pragma unroll
                    for (int c = 0; c < 8; ++c) { const bf16x8 v = qp[c];
#pragma unroll
                        for (int e = 0; e < 8; ++e) q[c * 8 + e] = bf2f((unsigned short)v[e]); } }
                  float g1 = -INFINITY, g2 = -INFINITY, g3 = -INFINITY; int i1 = -1, i2 = -1, i3 = -1;
                  for (int n = 0; n < cur; ++n) { float gsum = 0.f;
#pragma unroll
                      for (int d4 = 0; d4 < 16; ++d4) { const f32x4 k4 = *(const LAS f32x4*)(km + n * 64 + d4 * 4);
#pragma unroll
                          for (int e = 0; e < 4; ++e) gsum = __builtin_fmaf(q[d4 * 4 + e], k4[e], gsum); }
                      if (gsum > g1) { g3 = g2; i3 = i2; g2 = g1; i2 = i1; g1 = gsum; i1 = n; }
                      else if (gsum > g2) { g3 = g2; i3 = i2; g2 = gsum; i2 = n; }
                      else if (gsum > g3) { g3 = gsum; i3 = n; } }
                  unsigned m = 0u; if (i1 >= 0) m |= 1u << i1; if (i2 >= 0) m |= 1u << i2; if (i3 >= 0) m |= 1u << i3;
                  SEL[row * 8 + h] = m; }
              __syncthreads(); }
}

__device__ __forceinline__ void phase_b2(const Args& args, const int layer, LAS unsigned char* lds, unsigned char* lds_raw, const int G, const int bid) {
    unsigned char* ws = args.ws; asm volatile("" : "+s"(ws));
    int tid = threadIdx.x; asm volatile("" : "+v"(tid));
    const int lane = tid & 63, wave = __builtin_amdgcn_readfirstlane(tid >> 6);
    const int gw = bid * NWAVES + wave, NGW = G * NWAVES;
    unsigned char* wl = ws + WS_W + (size_t)layer * W_LAYER;
    (void)lane; (void)gw; (void)NGW; (void)wl; (void)lds_raw;
    volatile LAS unsigned* MISC = (volatile LAS unsigned*)(lds + MISC_OFF); unsigned* ctl = (unsigned*)(ws + WS_CTL);
            unsigned* qbase = ctl + CW_QCTR + layer * 8 * 64;
            const int x0 = (int)(xb_xcc_id() & 7u); int qx = 0;
            for (;;) {
                unsigned k = 0u;
                for (;;) {
                    if (tid == 0) MISC[0] = __hip_atomic_fetch_add(qbase + ((x0 + qx) & 7) * 64, 1u, __ATOMIC_RELAXED, __HIP_MEMORY_SCOPE_AGENT);
                    __syncthreads();
                    k = MISC[0];
                    __syncthreads();
                    if (k < (unsigned)N_UNITS_PER_BATCH || ++qx >= 8) break;
                }
                if (qx >= 8) break;
                const int b = (x0 + qx) & 7;
                const unsigned e = g_utab.v[k]; const int ty = e >> 12, h = (e >> 4) & 7, qb = e & 15;
                if (ty == 0) { const AttnP PF{(const bf16_t*)(ws + WS_QG), 1536, (const bf16_t*)(ws + WS_FK), 512, nullptr, (const bf16_t*)(ws + WS_FV), 512, (bf16_t*)(ws + WS_QG), 1536,
                                   (const bf16_t*)(ws + WS_GATE), 1536, (float*)(ws + WS_SSQA), 8, nullptr, nullptr, nullptr, (const unsigned char*)(ws + WS_JSTART), (const bf16_t*)(ws + WS_KAUGF)};
                    attn_unit<64, 64, 0>(PF, b, h, qb, (char*)lds_raw); }
                else if (ty == 1) { const AttnP PM{(const bf16_t*)(ws + WS_QM), 768, (const bf16_t*)(ws + WS_KM), 512, (const bf16_t*)(ws + WS_KR), (const bf16_t*)(ws + WS_VM), 512, (bf16_t*)(ws + WS_QG) + 512, 1536,
                                   (const bf16_t*)(ws + WS_GATE) + 512, 1536, (float*)(ws + WS_SSQB), 4, nullptr, nullptr, nullptr, nullptr, nullptr, (void*)(ctl + CW_T)};
                    attn_unit<192, 128, 1>(PM, b, h, qb, (char*)lds_raw); }
                else { const AttnP PB{(const bf16_t*)(ws + WS_QG) + 1024, 1536, (const bf16_t*)(ws + WS_BK), 512, nullptr, (const bf16_t*)(ws + WS_BV), 512, (bf16_t*)(ws + WS_QG) + 1024, 1536,
                                   (const bf16_t*)(ws + WS_GATE) + 1024, 1536, (float*)(ws + WS_SSQC), 8, nullptr, (const unsigned*)(ws + WS_SEL), (const float*)(ws + WS_CTL) + CW_NRM + layer * 512, nullptr, (const bf16_t*)(ws + WS_KAUGM)};
                    attn_unit<64, 64, 2>(PB, b, h, qb, (char*)lds_raw); }
            }
}

__device__ __forceinline__ void phase_n(const Args& args, const int layer, LAS unsigned char* lds, unsigned char* lds_raw, const int G, const int bid) {
    unsigned char* ws = args.ws; asm volatile("" : "+s"(ws));
    int tid = threadIdx.x; asm volatile("" : "+v"(tid));
    const int lane = tid & 63, wave = __builtin_amdgcn_readfirstlane(tid >> 6);
    const int gw = bid * NWAVES + wave, NGW = G * NWAVES;
    unsigned char* wl = ws + WS_W + (size_t)layer * W_LAYER;
    (void)lane; (void)gw; (void)NGW; (void)wl; (void)lds_raw;
            bf16_t* Y = (bf16_t*)(ws + WS_QG); const float* SA = (const float*)(ws + WS_SSQA); const float* SB = (const float*)(ws + WS_SSQB); const float* SC = (const float*)(ws + WS_SSQC);
            for (int m = gw; m < T; m += NGW) {
                const f32x4 a0 = *(const f32x4*)(SA + (size_t)m * 8), a1 = *(const f32x4*)(SA + (size_t)m * 8 + 4), b0 = *(const f32x4*)(SB + (size_t)m * 4);
                const f32x4 c0 = *(const f32x4*)(SC + (size_t)m * 8), c1 = *(const f32x4*)(SC + (size_t)m * 8 + 4);
                const float ra = rsqrtf((sum4(a0) + sum4(a1)) * (1.0f / 512.0f) + EPS), rb = rsqrtf(sum4(b0) * (1.0f / 512.0f) + EPS), rc = rsqrtf((sum4(c0) + sum4(c1)) * (1.0f / 512.0f) + EPS);
                u32x4* yp = (u32x4*)(Y + (size_t)m * 1536);
#pragma unroll
                for (int j = 0; j < 3; ++j) { const float r = (j == 0) ? ra : (j == 1) ? rb : rc; u32x4 v = yp[64 * j + lane]; u32x4 o;
#pragma unroll
                    for (int e = 0; e < 4; ++e) { const unsigned w = v[e]; o[e] = cvt_pk_bf16(__uint_as_float(w << 16) * r, __uint_as_float(w & 0xffff0000u) * r); }
                    yp[64 * j + lane] = o; }
            }
}

__device__ __forceinline__ void phase_c(const Args& args, const int layer, LAS unsigned char* lds, unsigned char* lds_raw, const int G, const int bid) {
    unsigned char* ws = args.ws; asm volatile("" : "+s"(ws));
    int tid = threadIdx.x; asm volatile("" : "+v"(tid));
    const int lane = tid & 63, wave = __builtin_amdgcn_readfirstlane(tid >> 6);
    const int gw = bid * NWAVES + wave, NGW = G * NWAVES;
    unsigned char* wl = ws + WS_W + (size_t)layer * W_LAYER;
    (void)lane; (void)gw; (void)NGW; (void)wl; (void)lds_raw;
            pg8::Gemm g{(const bf16_t*)(ws + WS_QG), (const bf16_t*)(wl + W_OUT_OFF), T, DM, DMIX, DMIX}; pg8::StaticOrder S; S.init(T, DM, G, bid);
            EpiC E{layer == 0 ? args.in[0] : (const float*)nullptr, (const bf16_t*)args.out, layer == 0 ? (bf16_t*)args.out : (bf16_t*)(ws + WS_FK), ws, layer == DEPTH - 1 ? 1 : 0};
            pg8::gemm_phase<EpiC, true, true>(lds, g, S, E, (LAS float*)(lds + SIDE_OFF));
}

__device__ __forceinline__ void phase_r(const Args& args, const int layer, LAS unsigned char* lds, unsigned char* lds_raw, const int G, const int bid) {
    unsigned char* ws = args.ws; asm volatile("" : "+s"(ws));
    int tid = threadIdx.x; asm volatile("" : "+v"(tid));
    const int lane = tid & 63, wave = __builtin_amdgcn_readfirstlane(tid >> 6);
    const int gw = bid * NWAVES + wave, NGW = G * NWAVES;
    unsigned char* wl = ws + WS_W + (size_t)layer * W_LAYER;
    (void)lane; (void)gw; (void)NGW; (void)wl; (void)lds_raw;
            const float* SSX = (const float*)(ws + WS_SSX); float* RSX = (float*)(ws + WS_RSX);
            for (int m = bid * NTHREADS + tid; m < T; m += G * NTHREADS) { const f32x4* p = (const f32x4*)(SSX + (size_t)m * 16);
                const float sm = (sum4(p[0]) + sum4(p[1])) + (sum4(p[2]) + sum4(p[3])); RSX[m] = rsqrtf(sm * (1.0f / 1024.0f) + EPS); }
}

__device__ __forceinline__ void phase_f(const Args& args, const int layer, LAS unsigned char* lds, unsigned char* lds_raw, const int G, const int bid) {
    unsigned char* ws = args.ws; asm volatile("" : "+s"(ws));
    int tid = threadIdx.x; asm volatile("" : "+v"(tid));
    const int lane = tid & 63, wave = __builtin_amdgcn_readfirstlane(tid >> 6);
    const int gw = bid * NWAVES + wave, NGW = G * NWAVES;
    unsigned char* wl = ws + WS_W + (size_t)layer * W_LAYER;
    (void)lane; (void)gw; (void)NGW; (void)wl; (void)lds_raw;
            float* X = args.out; const float* gf = args.in[10]; const bf16_t* XB = (const bf16_t*)(ws + WS_FK);
            for (int m = gw; m < T; m += NGW) { const u32x4* xr = (const u32x4*)(XB + (size_t)m * DM) + lane; float v[16]; float s = 0.f;
#pragma unroll
                for (int j = 0; j < 2; ++j) { const u32x4 w = xr[64 * j];
#pragma unroll
                    for (int e = 0; e < 4; ++e) { v[j * 8 + 2 * e] = __uint_as_float(w[e] << 16); v[j * 8 + 2 * e + 1] = __uint_as_float(w[e] & 0xffff0000u); } }
#pragma unroll
                for (int e = 0; e < 16; ++e) s += v[e] * v[e];
                const float r = rsqrtf(wave_sum(s) * (1.0f / 1024.0f) + EPS);
#pragma unroll
                for (int j = 0; j < 2; ++j) { const int c0 = (64 * j + lane) * 8; const f32x4 g0 = *(const f32x4*)(gf + c0), g1 = *(const f32x4*)(gf + c0 + 4);
                    f32x4 o0, o1;
#pragma unroll
                    for (int e = 0; e < 4; ++e) { o0[e] = v[j * 8 + e] * r * g0[e]; o1[e] = v[j * 8 + 4 + e] * r * g1[e]; }
                    float* op = X + (size_t)m * DM + c0; *(f32x4*)op = o0; *(f32x4*)(op + 4) = o1; } }
}

__global__ void __launch_bounds__(NTHREADS, 2) fwd_kernel(Args args) {
    extern __shared__ __attribute__((aligned(16))) unsigned char lds_raw[];
    LAS unsigned char* lds = (LAS unsigned char*)lds_raw;
    const int G = gridDim.x, bid = blockIdx.x;
    const int lo = args.ph_lo, hi = args.ph_hi;
    volatile LAS unsigned* MISCW = (volatile LAS unsigned*)(lds + MISC_OFF);
    if (args.pad == 0x5eed) cg::this_grid().sync();
    XcdBarrier xbar; xbar.bar = (unsigned*)(args.ws + WS_CTL) + CW_BAR; xbar.x = 0; xbar.st = MISCW + 8;
    if (args.coop) { if (threadIdx.x == 0) { MISCW[8] = 0u; MISCW[9] = 0u; } __syncthreads(); xbar = xcd_barrier_post((unsigned*)(args.ws + WS_CTL) + CW_BAR, MISCW + 8); }
#define IN(k) (lo <= (k) && (k) < hi)
#define SEAM(k) do { if (IN(k) && args.coop) xcd_barrier(xbar); } while (0)
    if (IN(0) && (PHM & 1)) phase_p0(args, 0, lds, lds_raw, G, bid);
    if (DBL & 1) { __syncthreads(); phase_p0(args, 0, lds, lds_raw, G, bid); }
    SEAM(0);
    if (IN(1) && (PHM & 2)) phase_a(args, 0, lds, lds_raw, G, bid);
    if (DBL & 2) { __syncthreads(); phase_a(args, 0, lds, lds_raw, G, bid); }
    SEAM(1);
    if (IN(2) && (PHM & 4)) phase_b1(args, 0, lds, lds_raw, G, bid);
    if (DBL & 4) { __syncthreads(); phase_b1(args, 0, lds, lds_raw, G, bid); }
    SEAM(2);
    if (IN(3) && (PHM & 8)) phase_b2(args, 0, lds, lds_raw, G, bid);
    SEAM(3);
    if (IN(5) && (PHM & 32)) phase_c(args, 0, lds, lds_raw, G, bid);
    if (DBL & 32) { __syncthreads(); phase_c(args, 0, lds, lds_raw, G, bid); }
    SEAM(5);
    if (IN(6)) phase_r(args, 0, lds, lds_raw, G, bid);
    SEAM(6);
    if (IN(7) && (PHM & 2)) phase_a(args, 1, lds, lds_raw, G, bid);
    SEAM(7);
    if (IN(8) && (PHM & 4)) phase_b1(args, 1, lds, lds_raw, G, bid);
    SEAM(8);
    if (IN(9) && (PHM & 8)) phase_b2(args, 1, lds, lds_raw, G, bid);
    SEAM(9);
    if (IN(11) && (PHM & 32)) phase_c(args, 1, lds, lds_raw, G, bid);
    SEAM(11);
    if (IN(12) && (PHM & 64)) phase_f(args, 0, lds, lds_raw, G, bid);
    if (TPROBE && bid == 0 && threadIdx.x == 0) {
        unsigned long long* tc = (unsigned long long*)((unsigned*)(args.ws + WS_CTL) + CW_T);
        const float t0 = (float)__hip_atomic_load(tc + 0, __ATOMIC_RELAXED, __HIP_MEMORY_SCOPE_AGENT), t1 = (float)__hip_atomic_load(tc + 1, __ATOMIC_RELAXED, __HIP_MEMORY_SCOPE_AGENT), t2 = (float)__hip_atomic_load(tc + 2, __ATOMIC_RELAXED, __HIP_MEMORY_SCOPE_AGENT);
        const float us = (TPROBE == 8) ? t1 / (t2 * 16.0f) : 1000.0f * t0 / t1;
        const unsigned long long w0 = __builtin_amdgcn_s_memrealtime(), dw = (unsigned long long)(us * 100.0f);
        while (__builtin_amdgcn_s_memrealtime() - w0 < dw) { __builtin_amdgcn_s_sleep(8); } }
#undef IN
#undef SEAM
}

extern "C" void kernel_launch(void* const* d_in, const int* in_sizes, int n_in, void* d_out, int out_size, void* d_ws, size_t ws_size, hipStream_t stream) {
    static int grid = 0;
    if (grid == 0) {
        if (n_in != 11 || in_sizes[0] != T * DM || out_size != T * DM || ws_size < WS_END) {
            fprintf(stderr, "kernel_launch: shape mismatch (n_in %d, in0 %d, out %d, ws %zu; need ws >= %zu)\n", n_in, n_in > 0 ? in_sizes[0] : -1, out_size, ws_size, (size_t)WS_END); grid = -1; return; }
        int dev = 0, cus = 0, per_cu = 0;
        hipGetDevice(&dev); hipDeviceGetAttribute(&cus, hipDeviceAttributeMultiprocessorCount, dev);
        if (hipFuncSetAttribute((const void*)fwd_kernel, hipFuncAttributeMaxDynamicSharedMemorySize, LDS_BYTES) != hipSuccess) { fprintf(stderr, "kernel_launch: hipFuncSetAttribute failed\n"); grid = -1; return; }
        hipOccupancyMaxActiveBlocksPerMultiprocessor(&per_cu, (const void*)fwd_kernel, NTHREADS, LDS_BYTES);
        (void)hipGetLastError();
        if (per_cu < 1) { fprintf(stderr, "kernel_launch: occupancy query says %d blocks/CU\n", per_cu); per_cu = 1; }
        grid = cus * 1;
    }
    if (grid < 0) return;
    hipMemsetAsync((char*)d_ws + WS_CTL, 0, CTL_ZERO_BYTES, stream);
    Args a{};
    for (int i = 0; i < 11; ++i) a.in[i] = (const float*)d_in[i];
    a.out = (float*)d_out; a.ws = (unsigned char*)d_ws;
#ifndef ONE_LAUNCH
#define ONE_LAUNCH 1
#endif
    if (ONE_LAUNCH) {
        a.ph_lo = 0; a.ph_hi = NPHASES; a.coop = 1;
        void* kargs[] = {&a};
        hipError_t e = hipLaunchCooperativeKernel((const void*)fwd_kernel, dim3(grid), dim3(NTHREADS), kargs, LDS_BYTES, stream);
        if (e != hipSuccess) fprintf(stderr, "kernel_launch: cooperative launch failed: %s (grid %d)\n", hipGetErrorString(e), grid);
    } else {
        for (int ph = 0; ph < NPHASES; ++ph) { a.ph_lo = ph; a.ph_hi = ph + 1; a.coop = 0;
            hipLaunchKernelGGL(fwd_kernel, dim3(grid), dim3(NTHREADS), LDS_BYTES, stream, a); }
    }
}
```
